# Optimizing an MI355X kernel written in HIP

```python
import math
import jax
import jax.numpy as jnp
from jax import lax
import numpy as np

D_MODEL = 1024
BATCH = 4
SEQ = 4096
DEPTH = 4

GRID_W = 64
CTX_LEN = 256
N_MIXERS = 3
N_LAYERS_A = (DEPTH + 2) // 3
N_LAYERS_B = (DEPTH + 1) // 3
N_LAYERS_C = DEPTH // 3
DEEPNORM_ALPHA = (2 * DEPTH) ** 0.25
DEEPNORM_BETA = (8 * DEPTH) ** -0.25
LN_EPS = 1e-5
RMS_EPS = 1e-6
ROPE_THETA = 10000.0
Q_BLOCK = 128
MLA_HEADS = 8
MLA_Q_RANK = 768
MLA_KV_RANK = 256
MLA_NOPE = 128
MLA_ROPE = 64
MLA_V = 128
HY_ORDER = 2
HY_EMB = 33
HY_BANDS = (HY_EMB - 1) // 2
HY_FILTER_HIDDEN = 64
HY_SHORT = 3
HY_FAST_DECAY = 0.3
HY_SLOW_DECAY = 1.5
HY_TARGET = 1e-2
HY_SHIFT = 0.05
GQA_Q_HEADS = 8
GQA_KV_HEADS = 2
GQA_HEAD_DIM = 128
PEER_HEADS = 8
PEER_N_KEYS = 128
PEER_N_EXPERTS = PEER_N_KEYS ** 2
PEER_TOPK = 16
PEER_D_KEY = 256
PEER_CHUNK = 128

kernel_name = "hybrid_mla_hyena_gqa_peer_diffusion_block"


def layer_norm(x, g, b):
    xf = x.astype(jnp.float32)
    mu = xf.mean(-1, keepdims=True)
    var = jnp.square(xf - mu).mean(-1, keepdims=True)
    return ((xf - mu) * lax.rsqrt(var + LN_EPS) * g + b).astype(x.dtype)


def rms_norm(x, g):
    xf = x.astype(jnp.float32)
    return (xf * lax.rsqrt(jnp.square(xf).mean(-1, keepdims=True) + RMS_EPS) * g).astype(x.dtype)


def modulate(x, shift, scale):
    return x * (1.0 + scale) + shift


def axial_rope_tables(n_tokens, rot_dim):
    rows = n_tokens // GRID_W
    row = jnp.repeat(jnp.arange(rows, dtype=jnp.float32), GRID_W)
    col = jnp.tile(jnp.arange(GRID_W, dtype=jnp.float32), rows)
    quarter = rot_dim // 4
    inv_freq = ROPE_THETA ** (-jnp.arange(quarter, dtype=jnp.float32) / quarter)
    ang = jnp.concatenate([row[:, None] * inv_freq, col[:, None] * inv_freq], -1)
    return jnp.cos(ang), jnp.sin(ang)


def apply_rope(x, cos, sin):
    xf = x.astype(jnp.float32).reshape(x.shape[:-1] + (x.shape[-1] // 2, 2))
    c = cos[None, :, None, :]
    s = sin[None, :, None, :]
    x0, x1 = xf[..., 0], xf[..., 1]
    out = jnp.stack([x0 * c - x1 * s, x0 * s + x1 * c], -1)
    return out.reshape(x.shape).astype(x.dtype)


def attention(q, k, v, scale):
    b, lq, hk, g, dq = q.shape
    nb = lq // Q_BLOCK
    qb = jnp.moveaxis(q.reshape(b, nb, Q_BLOCK, hk, g, dq), 1, 0)

    def one_block(qi):
        s = jnp.einsum('bqhgd,bkhd->bhgqk', qi, k, preferred_element_type=jnp.float32) * scale
        p = jax.nn.softmax(s, axis=-1)
        return jnp.einsum('bhgqk,bkhe->bqhge', p.astype(v.dtype), v)

    o = lax.map(one_block, qb)
    return jnp.moveaxis(o, 0, 1).reshape(b, lq, hk * g * v.shape[-1])


def mla_mixer(h_c, h_l, cos, sin, w_dq, q_norm, w_uq, w_dkv, kv_norm, w_ukv, w_o, ctx_out):
    scale = (MLA_NOPE + MLA_ROPE) ** -0.5

    def queries(h, rope):
        b, l, _ = h.shape
        cq = rms_norm(h @ w_dq, q_norm)
        q = (cq @ w_uq).reshape(b, l, MLA_HEADS, MLA_NOPE + MLA_ROPE)
        if rope:
            q = jnp.concatenate([q[..., :MLA_NOPE], apply_rope(q[..., MLA_NOPE:], cos, sin)], -1)
        return q[:, :, :, None, :]

    def keys_values(h, rope):
        b, l, _ = h.shape
        ckv = h @ w_dkv
        c_kv = rms_norm(ckv[..., :MLA_KV_RANK], kv_norm)
        k_pe = ckv[..., MLA_KV_RANK:][:, :, None, :]
        if rope:
            k_pe = apply_rope(k_pe, cos, sin)
        kv = (c_kv @ w_ukv).reshape(b, l, MLA_HEADS, MLA_NOPE + MLA_V)
        k = jnp.concatenate([kv[..., :MLA_NOPE], jnp.broadcast_to(k_pe, (b, l, MLA_HEADS, MLA_ROPE))], -1)
        return k, kv[..., MLA_NOPE:]

    k_c, v_c = keys_values(h_c, False)
    k_l, v_l = keys_values(h_l, True)
    k_all = jnp.concatenate([k_c, k_l], 1)
    v_all = jnp.concatenate([v_c, v_l], 1)
    y_l = attention(queries(h_l, True), k_all, v_all, scale) @ w_o
    y_c = attention(queries(h_c, False), k_c, v_c, scale) @ w_o if ctx_out else None
    return y_c, y_l


def gqa_mixer(h_c, h_l, cos, sin, w_qkv, q_norm, k_norm, w_o, ctx_out):
    g = GQA_Q_HEADS // GQA_KV_HEADS
    nq = GQA_Q_HEADS * GQA_HEAD_DIM
    nk = GQA_KV_HEADS * GQA_HEAD_DIM
    scale = GQA_HEAD_DIM ** -0.5

    def project(h, rope):
        b, l, _ = h.shape
        qkv = h @ w_qkv
        q = rms_norm(qkv[..., :nq].reshape(b, l, GQA_Q_HEADS, GQA_HEAD_DIM), q_norm)
        k = rms_norm(qkv[..., nq:nq + nk].reshape(b, l, GQA_KV_HEADS, GQA_HEAD_DIM), k_norm)
        v = qkv[..., nq + nk:].reshape(b, l, GQA_KV_HEADS, GQA_HEAD_DIM)
        if rope:
            q = apply_rope(q, cos, sin)
            k = apply_rope(k, cos, sin)
        return q.reshape(b, l, GQA_KV_HEADS, g, GQA_HEAD_DIM), k, v

    q_c, k_c, v_c = project(h_c, False)
    q_l, k_l, v_l = project(h_l, True)
    k_all = jnp.concatenate([k_c, k_l], 1)
    v_all = jnp.concatenate([v_c, v_l], 1)
    y_l = attention(q_l, k_all, v_all, scale) @ w_o
    y_c = attention(q_c, k_c, v_c, scale) @ w_o if ctx_out else None
    return y_c, y_l


def hyena_filter_spectrum(length, w1, b1, fr1, w2, b2, fr2, w3):
    t01 = jnp.linspace(0.0, 1.0, length, dtype=jnp.float32)[:, None]
    w = 2.0 * math.pi * jnp.arange(length, dtype=jnp.float32)[:, None] / length
    f = jnp.linspace(1e-4, HY_BANDS - 1, HY_BANDS, dtype=jnp.float32)[None, :]
    emb = jnp.concatenate([t01, jnp.cos(f * w), -jnp.sin(f * w)], -1)
    hdn = jnp.sin(fr1 * (emb @ w1 + b1))
    hdn = jnp.sin(fr2 * (hdn @ w2 + b2))
    filt = (hdn @ w3).astype(jnp.float32).reshape(length, HY_ORDER, 2, D_MODEL)
    deltas = jnp.abs(jnp.linspace(math.log(HY_TARGET) / HY_SLOW_DECAY, math.log(HY_TARGET) / HY_FAST_DECAY,
                                  D_MODEL, dtype=jnp.float32))
    window = jnp.exp(-t01 * deltas[None, :]) + HY_SHIFT
    filt = filt * window[:, None, None, :]
    kernel = jnp.concatenate([filt[:, :, 0], jnp.zeros((1, HY_ORDER, D_MODEL), jnp.float32),
                              filt[:0:-1, :, 1]], 0)
    return jnp.fft.rfft(kernel, axis=0)


def long_conv(u, spec, bias):
    length = u.shape[1]
    uf = u.astype(jnp.float32)
    y = jnp.fft.irfft(jnp.fft.rfft(uf, n=2 * length, axis=1) * spec[None], n=2 * length, axis=1)[:, :length]
    return (y + uf * bias).astype(u.dtype)


def short_conv(z, w, b):
    length = z.shape[1]
    pad = HY_SHORT // 2
    zp = jnp.pad(z, ((0, 0), (pad, pad), (0, 0)))
    out = b
    for j in range(HY_SHORT):
        out = out + zp[:, j:j + length] * w[j]
    return out


def hyena_sequence(h, w_in, b_in, conv_w, conv_b, f_w1, f_b1, f_fr1, f_w2, f_b2, f_fr2, f_w3, bias, w_out, b_out):
    length = h.shape[1]
    z = short_conv(h @ w_in + b_in, conv_w, conv_b)
    x1, x2, v = jnp.split(z, 3, axis=-1)
    spec = hyena_filter_spectrum(length, f_w1, f_b1, f_fr1, f_w2, f_b2, f_fr2, f_w3)
    y = x1 * long_conv(v, spec[:, 0], bias[0])
    y = x2 * long_conv(y, spec[:, 1], bias[1])
    return y @ w_out + b_out


def peer_ffn(h, w_q, keys1, keys2, u, v):
    t, d = h.shape
    half = PEER_D_KEY // 2
    hb = h.reshape(t // PEER_CHUNK, PEER_CHUNK, d)

    def one_chunk(hc):
        q = (hc @ w_q).reshape(PEER_CHUNK, PEER_HEADS, 2, half)
        s1 = jnp.einsum('thd,hkd->thk', q[:, :, 0], keys1, preferred_element_type=jnp.float32)
        s2 = jnp.einsum('thd,hkd->thk', q[:, :, 1], keys2, preferred_element_type=jnp.float32)
        v1, i1 = lax.top_k(s1, PEER_TOPK)
        v2, i2 = lax.top_k(s2, PEER_TOPK)
        cand = (v1[..., :, None] + v2[..., None, :]).reshape(PEER_CHUNK, PEER_HEADS, PEER_TOPK * PEER_TOPK)
        sv, pos = lax.top_k(cand, PEER_TOPK)
        e1 = jnp.take_along_axis(i1, pos // PEER_TOPK, axis=-1)
        e2 = jnp.take_along_axis(i2, pos % PEER_TOPK, axis=-1)
        idx = e1 * PEER_N_KEYS + e2
        gate = jax.nn.softmax(sv, axis=-1)
        act = jax.nn.gelu(jnp.einsum('td,thkd->thk', hc, u[idx]), approximate=False)
        return jnp.einsum('thk,thkd->td', (gate * act).astype(hc.dtype), v[idx])

    return lax.map(one_chunk, hb).reshape(t, d)


def setup_inputs(seed: int = 0) -> dict:
    key = jax.random.key(seed)
    ks = iter(jax.random.split(key, 64))
    D = D_MODEL
    beta = DEEPNORM_BETA

    def nrm(shape, std):
        return std * jax.random.normal(next(ks), shape, jnp.float32)

    def gain(shape):
        return 1.0 + nrm(shape, 0.02)

    nA, nB, nC = N_LAYERS_A, N_LAYERS_B, N_LAYERS_C
    return {
        "x": nrm((BATCH, SEQ, D), 1.0),
        "c": nrm((BATCH, D), 1.0),
        "ctx": nrm((BATCH, CTX_LEN, D), 1.0),
        "c_ctx": nrm((D,), 1.0),
        "ada_w": nrm((DEPTH, D, 6 * D), D ** -0.5),
        "ada_b": nrm((DEPTH, 6 * D), 0.02),
        "ln_g": gain((DEPTH, 2, D)),
        "ln_b": nrm((DEPTH, 2, D), 0.02),
        "mla_w_dq": nrm((nA, D, MLA_Q_RANK), D ** -0.5),
        "mla_q_norm": gain((nA, MLA_Q_RANK)),
        "mla_w_uq": nrm((nA, MLA_Q_RANK, MLA_HEADS * (MLA_NOPE + MLA_ROPE)), MLA_Q_RANK ** -0.5),
        "mla_w_dkv": nrm((nA, D, MLA_KV_RANK + MLA_ROPE), D ** -0.5),
        "mla_kv_norm": gain((nA, MLA_KV_RANK)),
        "mla_w_ukv": nrm((nA, MLA_KV_RANK, MLA_HEADS * (MLA_NOPE + MLA_V)), MLA_KV_RANK ** -0.5),
        "mla_w_o": nrm((nA, MLA_HEADS * MLA_V, D), beta * (MLA_HEADS * MLA_V) ** -0.5),
        "hy_w_in": nrm((nB, D, 3 * D), D ** -0.5),
        "hy_b_in": nrm((nB, 3 * D), 0.02),
        "hy_conv_w": nrm((nB, HY_SHORT, 3 * D), HY_SHORT ** -0.5),
        "hy_conv_b": nrm((nB, 3 * D), 0.02),
        "hy_f_w1": nrm((nB, HY_EMB, HY_FILTER_HIDDEN), HY_EMB ** -0.5),
        "hy_f_b1": nrm((nB, HY_FILTER_HIDDEN), 0.02),
        "hy_f_fr1": gain((nB, HY_FILTER_HIDDEN)),
        "hy_f_w2": nrm((nB, HY_FILTER_HIDDEN, HY_FILTER_HIDDEN), HY_FILTER_HIDDEN ** -0.5),
        "hy_f_b2": nrm((nB, HY_FILTER_HIDDEN), 0.02),
        "hy_f_fr2": gain((nB, HY_FILTER_HIDDEN)),
        "hy_f_w3": nrm((nB, HY_FILTER_HIDDEN, HY_ORDER * 2 * D), 0.05 * HY_FILTER_HIDDEN ** -0.5),
        "hy_bias": nrm((nB, HY_ORDER, D), 0.1),
        "hy_w_out": nrm((nB, D, D), beta * D ** -0.5),
        "hy_b_out": nrm((nB, D), 0.02),
        "gqa_w_qkv": nrm((nC, D, (GQA_Q_HEADS + 2 * GQA_KV_HEADS) * GQA_HEAD_DIM), D ** -0.5),
        "gqa_q_norm": gain((nC, GQA_HEAD_DIM)),
        "gqa_k_norm": gain((nC, GQA_HEAD_DIM)),
        "gqa_w_o": nrm((nC, GQA_Q_HEADS * GQA_HEAD_DIM, D), beta * (GQA_Q_HEADS * GQA_HEAD_DIM) ** -0.5),
        "peer_w_q": nrm((DEPTH, D, PEER_HEADS * PEER_D_KEY), D ** -0.5),
        "peer_keys1": nrm((DEPTH, PEER_HEADS, PEER_N_KEYS, PEER_D_KEY // 2), (PEER_D_KEY // 2) ** -0.5),
        "peer_keys2": nrm((DEPTH, PEER_HEADS, PEER_N_KEYS, PEER_D_KEY // 2), (PEER_D_KEY // 2) ** -0.5),
        "peer_u": nrm((DEPTH, PEER_N_EXPERTS, D), D ** -0.5),
        "peer_v": nrm((DEPTH, PEER_N_EXPERTS, D), beta),
    }


def reference(x, c, ctx, c_ctx, ada_w, ada_b, ln_g, ln_b,
              mla_w_dq, mla_q_norm, mla_w_uq, mla_w_dkv, mla_kv_norm, mla_w_ukv, mla_w_o,
              hy_w_in, hy_b_in, hy_conv_w, hy_conv_b, hy_f_w1, hy_f_b1, hy_f_fr1, hy_f_w2, hy_f_b2, hy_f_fr2,
              hy_f_w3, hy_bias, hy_w_out, hy_b_out,
              gqa_w_qkv, gqa_q_norm, gqa_k_norm, gqa_w_o,
              peer_w_q, peer_keys1, peer_keys2, peer_u, peer_v):
    d = x.shape[-1]
    seq = x.shape[1]
    cos_a, sin_a = axial_rope_tables(seq, MLA_ROPE)
    cos_c, sin_c = axial_rope_tables(seq, GQA_HEAD_DIM)
    x_l, x_c = x, ctx
    ia = ib = ic = 0
    for layer in range(DEPTH):
        last = layer == DEPTH - 1
        mod_l = (jax.nn.silu(c) @ ada_w[layer] + ada_b[layer])[:, None, :]
        mod_c = (jax.nn.silu(c_ctx) @ ada_w[layer] + ada_b[layer])[None, None, :]
        sh_l, sc_l, g_l, shf_l, scf_l, gf_l = jnp.split(mod_l, 6, axis=-1)
        sh_c, sc_c, g_c, shf_c, scf_c, gf_c = jnp.split(mod_c, 6, axis=-1)
        h_l = modulate(x_l, sh_l, sc_l)
        h_c = modulate(x_c, sh_c, sc_c)
        kind = layer % N_MIXERS
        if kind == 0:
            y_c, y_l = mla_mixer(h_c, h_l, cos_a, sin_a, mla_w_dq[ia], mla_q_norm[ia], mla_w_uq[ia],
                                 mla_w_dkv[ia], mla_kv_norm[ia], mla_w_ukv[ia], mla_w_o[ia], not last)
            ia += 1
        elif kind == 1:
            hp = (hy_w_in[ib], hy_b_in[ib], hy_conv_w[ib], hy_conv_b[ib], hy_f_w1[ib], hy_f_b1[ib], hy_f_fr1[ib],
                  hy_f_w2[ib], hy_f_b2[ib], hy_f_fr2[ib], hy_f_w3[ib], hy_bias[ib], hy_w_out[ib], hy_b_out[ib])
            y_l = hyena_sequence(h_l, *hp)
            y_c = hyena_sequence(h_c, *hp) if not last else None
            ib += 1
        else:
            y_c, y_l = gqa_mixer(h_c, h_l, cos_c, sin_c, gqa_w_qkv[ic], gqa_q_norm[ic], gqa_k_norm[ic],
                                 gqa_w_o[ic], not last)
            ic += 1
        x_l = layer_norm(DEEPNORM_ALPHA * x_l + g_l * y_l, ln_g[layer, 0], ln_b[layer, 0])
        h_l = modulate(x_l, shf_l, scf_l)
        if last:
            f_l = peer_ffn(h_l.reshape(-1, d), peer_w_q[layer], peer_keys1[layer], peer_keys2[layer],
                           peer_u[layer], peer_v[layer]).reshape(x_l.shape)
        else:
            x_c = layer_norm(DEEPNORM_ALPHA * x_c + g_c * y_c, ln_g[layer, 0], ln_b[layer, 0])
            h_c = modulate(x_c, shf_c, scf_c)
            n_c = h_c.shape[0] * h_c.shape[1]
            tokens = jnp.concatenate([h_c.reshape(-1, d), h_l.reshape(-1, d)], 0)
            f_all = peer_ffn(tokens, peer_w_q[layer], peer_keys1[layer], peer_keys2[layer],
                             peer_u[layer], peer_v[layer])
            f_c = f_all[:n_c].reshape(x_c.shape)
            f_l = f_all[n_c:].reshape(x_l.shape)
            x_c = layer_norm(DEEPNORM_ALPHA * x_c + gf_c * f_c, ln_g[layer, 1], ln_b[layer, 1])
        x_l = layer_norm(DEEPNORM_ALPHA * x_l + gf_l * f_l, ln_g[layer, 1], ln_b[layer, 1])
    return x_l
```

```cpp
#include <hip/hip_runtime.h>
#include <hip/hip_cooperative_groups.h>
#include <cstdio>
#include <cstdint>
#include <cstring>
namespace cg = cooperative_groups;

#ifndef ONE_LAUNCH
#define ONE_LAUNCH 1
#endif

constexpr int D = 1024, NBATCH = 4, SEQ = 4096, CTXL = 256, RB = 4352, T = 17408, DEPTH = 4;
constexpr float ALPHA = 1.6817928305074290f;
constexpr int NTHR = 512;
constexpr int NPHASES = 41;

typedef unsigned short bf16_t;
using bf16x8 = __attribute__((ext_vector_type(8))) short;
using s16x4  = __attribute__((ext_vector_type(4))) short;
using f32x16 = __attribute__((ext_vector_type(16))) float;
using u32x4  = __attribute__((ext_vector_type(4))) unsigned;
using u32x2  = __attribute__((ext_vector_type(2))) unsigned;

typedef __bf16 bf16x2_t __attribute__((ext_vector_type(2)));
typedef float f32x2_t __attribute__((ext_vector_type(2)));
__device__ __forceinline__ unsigned cvtpk(float lo, float hi) { f32x2_t v = {lo, hi}; bf16x2_t b = __builtin_convertvector(v, bf16x2_t); return __builtin_bit_cast(unsigned, b); }
__device__ __forceinline__ bf16_t f2bf(float x) { __bf16 b = (__bf16)x; return __builtin_bit_cast(unsigned short, b); }
__device__ __forceinline__ unsigned cvtpk_asm(float lo, float hi) { unsigned r; asm volatile("v_cvt_pk_bf16_f32 %0, %1, %2" : "=v"(r) : "v"(lo), "v"(hi)); return r; }
__device__ __forceinline__ float bf2f(bf16_t u) { return __uint_as_float(((unsigned)u) << 16); }
__device__ __forceinline__ float bflo(unsigned w) { return __uint_as_float(w << 16); }
__device__ __forceinline__ float bfhi(unsigned w) { return __uint_as_float(w & 0xffff0000u); }
__device__ __forceinline__ int crow(int r, int hi) { return (r & 3) + 8 * (r >> 2) + 4 * hi; }
__device__ __forceinline__ float wsum(float v) {
#pragma unroll
  for (int o = 32; o; o >>= 1) v += __shfl_xor(v, o);
  return v;
}
__device__ __forceinline__ int otid() { int t = threadIdx.x; asm volatile("" : "+v"(t)); return t; }
__device__ __forceinline__ float sin_rev(float rev) { return __builtin_amdgcn_sinf(rev); }
__device__ __forceinline__ float cos_rev(float rev) { return __builtin_amdgcn_cosf(rev); }
__device__ __forceinline__ float sin_rad(float x) { return __builtin_amdgcn_sinf(x * 0.15915494309189535f); }

struct Params { const float* in[38]; float* out; char* ws; int ph_begin, ph_end; };
constexpr size_t al256c(size_t x) { return (x + 255) & ~(size_t)255; }
constexpr size_t SZ_W1 = al256c((size_t)1152 * 1024 * 2), SZ_WUQ = al256c((size_t)1536 * 768 * 2), SZ_WUKV = al256c((size_t)2048 * 256 * 2), SZ_WSQ = al256c((size_t)1024 * 1024 * 2),
                 SZ_WQ = al256c((size_t)2048 * 1024 * 2);
constexpr size_t OFF_MODP = 0;
constexpr size_t OFF_MOD  = OFF_MODP + al256c((size_t)8 * 4 * 5 * 6144 * 4);
constexpr size_t OFF_HDN  = OFF_MOD + al256c((size_t)4 * 5 * 6144 * 4);
constexpr size_t OFF_GLAT = OFF_HDN + al256c((size_t)2 * 4096 * 64 * 4);
constexpr size_t OFF_GCTX = OFF_GLAT + al256c((size_t)2 * 1024 * 8192 * 2);
constexpr size_t OFF_W1   = OFF_GCTX + al256c((size_t)2 * 1024 * 512 * 2);
constexpr size_t OFF_WUQ  = OFF_W1 + 2 * SZ_W1;
constexpr size_t OFF_WUKV = OFF_WUQ + 2 * SZ_WUQ;
constexpr size_t OFF_WOA  = OFF_WUKV + 2 * SZ_WUKV;
constexpr size_t OFF_WIN  = OFF_WOA + 2 * SZ_WSQ;
constexpr size_t OFF_WOUT = OFF_WIN + al256c((size_t)3072 * 1024 * 2);
constexpr size_t OFF_WQKV = OFF_WOUT + SZ_WSQ;
constexpr size_t OFF_WOC  = OFF_WQKV + al256c((size_t)1536 * 1024 * 2);
constexpr size_t OFF_WQ   = OFF_WOC + SZ_WSQ;
constexpr size_t OFF_KEYS = OFF_WQ + 4 * SZ_WQ;
constexpr size_t OFF_PU   = OFF_KEYS + al256c((size_t)4 * 16 * 16384 * 2);
constexpr size_t OFF_PV   = OFF_PU + (size_t)4 * 16384 * 1024 * 2;
constexpr size_t OFF_X    = OFF_PV + (size_t)4 * 16384 * 1024 * 2;
constexpr size_t OFF_H    = OFF_X + (size_t)T * 1024 * 4;
constexpr size_t OFF_Y    = OFF_H + (size_t)T * 1024 * 2;
constexpr size_t OFF_RA   = OFF_Y + (size_t)T * 1024 * 4;
constexpr size_t OFF_RB   = OFF_RA + (size_t)T * 2048 * 4;
constexpr size_t OFF_RC   = OFF_RB + (size_t)T * 2048 * 2;
constexpr size_t OFF_RD   = OFF_RC + (size_t)T * 1536 * 2;
constexpr size_t OFF_RE   = OFF_RD + (size_t)T * 1024 * 2;
constexpr size_t OFF_RF   = OFF_RE + (size_t)T * 1024 * 2;
constexpr size_t WS_TOTAL = OFF_RF + (size_t)T * 1024 * 2;
#define WSP(type, off) ((type*)(p.ws + (off)))

struct RowInfo { int b, rb, is_ctx, pos, mrow; };
__device__ __forceinline__ RowInfo row_info(int row) {
  RowInfo r; r.b = row / RB; r.rb = row - r.b * RB; r.is_ctx = r.rb < CTXL; r.pos = r.rb - CTXL; r.mrow = r.is_ctx ? 4 : r.b; return r;
}
__device__ __forceinline__ void rope_cs(int pos, int i, int quarter, float& c, float& s) {
  const int j = i < quarter ? i : i - quarter;
  const float inv = exp2f(-13.287712379549449f * (float)j / (float)quarter);
  const float p = (float)(i < quarter ? (pos >> 6) : (pos & 63));
  const float rev = p * inv * 0.15915494309189535f;
  c = cos_rev(rev); s = sin_rev(rev);
}

__device__ __forceinline__ int gswz(int row, int chunk) { return row * 128 + ((chunk ^ ((row >> 1) & 7)) << 4); }
constexpr int G_ASZ = 256 * 128, G_BSZ = 128 * 128;
template <class Epi>
__device__ __forceinline__ void gemm_tile(const bf16_t* __restrict__ A, int lda, const bf16_t* __restrict__ Bt, int ldb, int K, int m0, int n0, int acol0,
                                          const Epi& epi, char* lds) {
  const int tid = otid(), lane = tid & 63, wid = tid >> 6, wm = wid >> 1, wn = wid & 1, r32 = lane & 31, hi = lane >> 5;
  char* As = lds; char* Bs = lds + 2 * G_ASZ;
  f32x16 acc[2][2];
#pragma unroll
  for (int i = 0; i < 2; ++i)
#pragma unroll
    for (int j = 0; j < 2; ++j) acc[i][j] = f32x16{};
  u32x4 ra[4], rb[2];
  const int srow = tid >> 3, sch = tid & 7;
  const bf16_t* Ap = A + (size_t)(m0 + srow) * lda + acol0 + sch * 8;
  const bf16_t* Bp = Bt + (size_t)(n0 + srow) * ldb + sch * 8;
  const int nk = K >> 6;
#define G_LOAD(kt) do { _Pragma("unroll") for (int c_ = 0; c_ < 4; ++c_) ra[c_] = *(const u32x4*)(Ap + (size_t)(c_ * 64) * lda + (kt) * 64); \
                        _Pragma("unroll") for (int c_ = 0; c_ < 2; ++c_) rb[c_] = *(const u32x4*)(Bp + (size_t)(c_ * 64) * ldb + (kt) * 64); } while (0)
#define G_STORE(buf) do { _Pragma("unroll") for (int c_ = 0; c_ < 4; ++c_) *(u32x4*)(As + (buf) * G_ASZ + gswz(srow + c_ * 64, sch)) = ra[c_]; \
                          _Pragma("unroll") for (int c_ = 0; c_ < 2; ++c_) *(u32x4*)(Bs + (buf) * G_BSZ + gswz(srow + c_ * 64, sch)) = rb[c_]; } while (0)
  G_LOAD(0); G_STORE(0); __syncthreads();
  for (int kt = 0; kt < nk; ++kt) {
    if (kt + 1 < nk) G_LOAD(kt + 1);
    const char* Ab = As + (kt & 1) * G_ASZ; const char* Bb = Bs + (kt & 1) * G_BSZ;
#pragma unroll
    for (int ks = 0; ks < 4; ++ks) {
      bf16x8 af[2], bfr[2];
#pragma unroll
      for (int i = 0; i < 2; ++i) af[i] = *(const bf16x8*)(Ab + gswz(wm * 64 + i * 32 + r32, ks * 2 + hi));
#pragma unroll
      for (int j = 0; j < 2; ++j) bfr[j] = *(const bf16x8*)(Bb + gswz(wn * 64 + j * 32 + r32, ks * 2 + hi));
#pragma unroll
      for (int i = 0; i < 2; ++i)
#pragma unroll
        for (int j = 0; j < 2; ++j) acc[i][j] = __builtin_amdgcn_mfma_f32_32x32x16_bf16(af[i], bfr[j], acc[i][j], 0, 0, 0);
    }
    if (kt + 1 < nk) G_STORE((kt + 1) & 1);
    __syncthreads();
  }
#undef G_LOAD
#undef G_STORE
#pragma unroll
  for (int i = 0; i < 2; ++i)
#pragma unroll
    for (int j = 0; j < 2; ++j)
#pragma unroll
      for (int r = 0; r < 16; ++r) epi(m0 + wm * 64 + i * 32 + crow(r, hi), n0 + wn * 64 + j * 32 + r32, acc[i][j][r]);
}
template <class Epi>
__device__ __forceinline__ void gemm_job(const bf16_t* A, int lda, const bf16_t* Bt, int ldb, int M, int N, int K, bool grouped, const Epi& epi, char* lds) {
  const int ntn = N / 128, nt = ntn * (M / 256);
  for (int it = blockIdx.x; it < nt; it += gridDim.x) {
    const int mt = it / ntn, n_t = it - mt * ntn;
    gemm_tile(A, lda, Bt, ldb, K, mt * 256, n_t * 128, grouped ? n_t * 128 : 0, epi, lds);
  }
}
struct EpiF32 { float* C; int ldc, ncols; const float* bias;
  __device__ __forceinline__ void operator()(int row, int col, float v) const { if (col < ncols) C[(size_t)row * ldc + col] = v + (bias ? bias[col] : 0.f); } };
struct EpiBf16 { bf16_t* C; int ldc;
  __device__ __forceinline__ void operator()(int row, int col, float v) const { C[(size_t)row * ldc + col] = f2bf(v); } };
struct EpiZT { bf16_t* C; int ldc; const float* bias_row;
  __device__ __forceinline__ void operator()(int row, int col, float v) const { C[(size_t)row * ldc + col] = f2bf(v + bias_row[row]); } };
struct EpiMlaQ { bf16_t* Q;
  __device__ __forceinline__ void operator()(int row, int col, float v) const {
    const float partner = __shfl_xor(v, 1);
    const int w = col % 192;
    const RowInfo ri = row_info(row);
    float o = v;
    if (w >= 128 && !ri.is_ctx) { float c, s; rope_cs(ri.pos, (w - 128) >> 1, 16, c, s); o = (col & 1) ? (partner * s + v * c) : (v * c - partner * s); }
    Q[(size_t)row * 1536 + col] = f2bf(o);
  } };
struct EpiMlaKV { bf16_t* Kb; bf16_t* Vb;
  __device__ __forceinline__ void operator()(int row, int col, float v) const {
    const int h = col >> 8, w = col & 255;
    if (w < 128) Kb[(size_t)row * 1024 + h * 128 + w] = f2bf(v); else Vb[(size_t)row * 1024 + h * 128 + (w - 128)] = f2bf(v);
  } };

#define SBAR() __builtin_amdgcn_sched_barrier(0)
constexpr float ATT_THR = 8.f;
__device__ __forceinline__ void partialSM(f32x16& p0, f32x16& p1, float& m_reg, float& mn, float& alpha, const float C, const float thr_s) {
  float pmax = p0[0];
#pragma unroll
  for (int r = 1; r < 16; ++r) pmax = fmaxf(pmax, p0[r]);
#pragma unroll
  for (int r = 0; r < 16; ++r) pmax = fmaxf(pmax, p1[r]);
  { auto rr = __builtin_amdgcn_permlane32_swap(__float_as_uint(pmax), __float_as_uint(pmax), false, false);
    pmax = fmaxf(__uint_as_float(rr[0]), __uint_as_float(rr[1])); }
  if (__builtin_expect(__all(pmax - m_reg <= thr_s), 1)) { mn = m_reg; alpha = 1.f; }
  else { mn = fmaxf(m_reg, pmax); alpha = __builtin_amdgcn_exp2f((m_reg - mn) * C); m_reg = mn; }
  const float mnC = -mn * C;
#pragma unroll
  for (int r = 0; r < 16; ++r) p0[r] = fmaf(p0[r], C, mnC);
#pragma unroll
  for (int r = 0; r < 16; ++r) p1[r] = fmaf(p1[r], C, mnC);
#pragma unroll
  for (int r = 0; r < 16; ++r) p0[r] = __builtin_amdgcn_exp2f(p0[r]);
}
__device__ __forceinline__ void finishSM(f32x16& p0, f32x16& p1, float alpha, float& l_reg, bf16x8& pa0, bf16x8& pa1, bf16x8& pa2, bf16x8& pa3) {
#pragma unroll
  for (int r = 0; r < 16; ++r) p1[r] = __builtin_amdgcn_exp2f(p1[r]);
  float ps = 0;
#pragma unroll
  for (int r = 0; r < 16; ++r) ps += p0[r];
#pragma unroll
  for (int r = 0; r < 16; ++r) ps += p1[r];
  { auto rr = __builtin_amdgcn_permlane32_swap(__float_as_uint(ps), __float_as_uint(ps), false, false);
    ps = __uint_as_float(rr[0]) + __uint_as_float(rr[1]); }
  l_reg = l_reg * alpha + ps;
#define PK4(P, BASE, OUT) do { unsigned a0 = cvtpk_asm(P[BASE + 0], P[BASE + 1]), a1 = cvtpk_asm(P[BASE + 2], P[BASE + 3]);   \
    unsigned b0 = cvtpk_asm(P[BASE + 4], P[BASE + 5]), b1 = cvtpk_asm(P[BASE + 6], P[BASE + 7]);                              \
    auto r0 = __builtin_amdgcn_permlane32_swap(a0, b0, false, false); auto r1 = __builtin_amdgcn_permlane32_swap(a1, b1, false, false); \
    u32x4 w = {r0[0], r1[0], r0[1], r1[1]}; OUT = *reinterpret_cast<bf16x8*>(&w); } while (0)
  PK4(p0, 0, pa0); PK4(p0, 8, pa1); PK4(p1, 0, pa2); PK4(p1, 8, pa3);
#undef PK4
}
template <int DQ>
__device__ __forceinline__ void qkt(f32x16& p0, f32x16& p1, const char* Ks, const char* KRs, const bf16x8* qr, int r32, int hi) {
  p0 = f32x16{}; p1 = f32x16{};
  const int sw = (r32 & 7) << 4;
#pragma unroll
  for (int d0 = 0; d0 < 8; ++d0) { const int cb = (d0 * 32 + hi * 16) ^ sw;
    bf16x8 b0 = *reinterpret_cast<const bf16x8*>(Ks + r32 * 256 + cb);
    bf16x8 b1 = *reinterpret_cast<const bf16x8*>(Ks + (32 + r32) * 256 + cb);
    p0 = __builtin_amdgcn_mfma_f32_32x32x16_bf16(b0, qr[d0], p0, 0, 0, 0);
    p1 = __builtin_amdgcn_mfma_f32_32x32x16_bf16(b1, qr[d0], p1, 0, 0, 0); }
  if constexpr (DQ == 192) {
#pragma unroll
    for (int d0 = 0; d0 < 4; ++d0) { const int cb = (d0 * 32 + hi * 16) ^ sw;
      bf16x8 b0 = *reinterpret_cast<const bf16x8*>(KRs + r32 * 128 + cb);
      bf16x8 b1 = *reinterpret_cast<const bf16x8*>(KRs + (32 + r32) * 128 + cb);
      p0 = __builtin_amdgcn_mfma_f32_32x32x16_bf16(b0, qr[8 + d0], p0, 0, 0, 0);
      p1 = __builtin_amdgcn_mfma_f32_32x32x16_bf16(b1, qr[8 + d0], p1, 0, 0, 0); }
  }
}
__device__ __forceinline__ int v_st(int k, int c) { const int kk = (k & ~0xC) | ((k & 4) << 1) | ((k & 8) >> 1); return ((kk >> 3) * 4 + (c >> 5)) * 512 + ((kk & 7) * 32 + (c & 31)) * 2; }
__device__ __forceinline__ int v_rd_base(int lane) { return ((lane & 3) << 3) | (((lane >> 2) & 3) << 6) | (((lane >> 4) & 1) << 5) | (((lane >> 5) & 1) << 8); }
constexpr int v_rd_off(int d0, int ks, int half) { return d0 * 512 + ks * 4096 + half * 2048; }
template <int OFF> __device__ __forceinline__ s16x4 tr_read(int vb) {
  s16x4 r; asm volatile("ds_read_b64_tr_b16 %0, %1 offset:%2" : "=&v"(r) : "v"(vb), "i"(OFF) : "memory"); return r;
}
template <int D0> __device__ __forceinline__ void pv_one(f32x16& od, int vb, bf16x8 pa0, bf16x8 pa1, bf16x8 pa2, bf16x8 pa3) {
  const s16x4 l0 = tr_read<v_rd_off(D0, 0, 0)>(vb), h0 = tr_read<v_rd_off(D0, 0, 1)>(vb), l1 = tr_read<v_rd_off(D0, 1, 0)>(vb), h1 = tr_read<v_rd_off(D0, 1, 1)>(vb);
  const s16x4 l2 = tr_read<v_rd_off(D0, 2, 0)>(vb), h2 = tr_read<v_rd_off(D0, 2, 1)>(vb), l3 = tr_read<v_rd_off(D0, 3, 0)>(vb), h3 = tr_read<v_rd_off(D0, 3, 1)>(vb);
  asm volatile("s_waitcnt lgkmcnt(0)" ::: "memory"); SBAR();
#define PKV(L, H) (bf16x8){L[0], L[1], L[2], L[3], H[0], H[1], H[2], H[3]}
  od = __builtin_amdgcn_mfma_f32_32x32x16_bf16(pa0, PKV(l0, h0), od, 0, 0, 0);
  od = __builtin_amdgcn_mfma_f32_32x32x16_bf16(pa1, PKV(l1, h1), od, 0, 0, 0);
  od = __builtin_amdgcn_mfma_f32_32x32x16_bf16(pa2, PKV(l2, h2), od, 0, 0, 0);
  od = __builtin_amdgcn_mfma_f32_32x32x16_bf16(pa3, PKV(l3, h3), od, 0, 0, 0);
#undef PKV
}
__device__ __forceinline__ void pv_d0(f32x16* o, int vb, bf16x8 pa0, bf16x8 pa1, bf16x8 pa2, bf16x8 pa3) {
  pv_one<0>(o[0], vb, pa0, pa1, pa2, pa3); pv_one<1>(o[1], vb, pa0, pa1, pa2, pa3); pv_one<2>(o[2], vb, pa0, pa1, pa2, pa3); pv_one<3>(o[3], vb, pa0, pa1, pa2, pa3);
}
constexpr int ATT_LDS = 2 * 16384 + 2 * 16384 + 2 * 8192 + 2048;
template <int DQ, int LDQ, int LDK, int LDKR, int LDV, int LDO, int SDEPTH>
__device__ __forceinline__ void attn_body(const bf16_t* __restrict__ Qb, const bf16_t* __restrict__ Kh, const bf16_t* __restrict__ Krh, const bf16_t* __restrict__ Vh,
                                          bf16_t* __restrict__ Ob, int seq, char* lds) {
  constexpr int SHM_V = 16384, SHM_K = 16384, SHM_KR = 8192;
  constexpr bool ROPE = DQ == 192;
  constexpr float scale = ROPE ? 0.07216878364870322f : 0.08838834764831845f;
  constexpr float C = scale * 1.4426950408889634f, thr_s = ATT_THR / scale;
  const int tid = otid();
  const int wid = tid >> 6, lane = tid & 63, r32 = lane & 31, hi = lane >> 5;
  char* V_lds = lds; char* K_lds = lds + 2 * SHM_V; char* KR_lds = K_lds + 2 * SHM_K;
  float* ws = (float*)(KR_lds + 2 * SHM_KR) + wid * 64; float* li_l = ws; float* al_l = ws + 32;
  float m_reg = -1e30f, l_reg = 0; f32x16 o[4] = {}; bf16x8 qr[DQ / 16];
  const bf16_t* Qw = Qb + (long)(wid * 32 + r32) * LDQ + hi * 8;
#pragma unroll
  for (int d0 = 0; d0 < DQ / 16; ++d0) qr[d0] = *reinterpret_cast<const bf16x8*>(Qw + d0 * 16);
  const int sr = tid >> 4, sc = tid & 15;
  const unsigned voffK = (unsigned)(sr * LDK + sc * 8) * 2u, voffV = (unsigned)(sr * LDV + sc * 8) * 2u, voffKR = (unsigned)((tid >> 3) * LDKR + (tid & 7) * 8) * 2u;
  const int kst0 = sr * 256 + ((sc * 16) ^ ((sr & 7) << 4)), vst0 = v_st(sr, sc * 8), vst1 = v_st(32 + sr, sc * 8);
  const int krst = (tid >> 3) * 128 + (((tid & 7) * 16) ^ (((tid >> 3) & 7) << 4));
  const int vb0 = (int)(uintptr_t)V_lds + v_rd_base(lane);
  struct { bf16x8 v0, v1, k0, k1, kr; } sr_[SDEPTH];
#define SLOAD(i, kk) do { const char* vb_ = (const char*)Vh + (size_t)(kk) * (LDV * 2); const char* kb_ = (const char*)Kh + (size_t)(kk) * (LDK * 2); \
    sr_[i].v0 = *reinterpret_cast<const bf16x8*>(vb_ + voffV); sr_[i].v1 = *reinterpret_cast<const bf16x8*>(vb_ + voffV + 32 * LDV * 2); \
    sr_[i].k0 = *reinterpret_cast<const bf16x8*>(kb_ + voffK); sr_[i].k1 = *reinterpret_cast<const bf16x8*>(kb_ + voffK + 32 * LDK * 2); \
    if constexpr (ROPE) sr_[i].kr = *reinterpret_cast<const bf16x8*>((const char*)Krh + (size_t)(kk) * (LDKR * 2) + voffKR); } while (0)
#define SWRITE(b, i) do { *(bf16x8*)(V_lds + (b) * SHM_V + vst0) = sr_[i].v0; *(bf16x8*)(V_lds + (b) * SHM_V + vst1) = sr_[i].v1; \
    *(bf16x8*)(K_lds + (b) * SHM_K + kst0) = sr_[i].k0; *(bf16x8*)(K_lds + (b) * SHM_K + kst0 + 8192) = sr_[i].k1; \
    if constexpr (ROPE) *(bf16x8*)(KR_lds + (b) * SHM_KR + krst) = sr_[i].kr; } while (0)
#define SWAIT() do { if constexpr (SDEPTH == 2) { if constexpr (ROPE) asm volatile("s_waitcnt vmcnt(5)" ::: "memory"); else asm volatile("s_waitcnt vmcnt(4)" ::: "memory"); } \
    else asm volatile("s_waitcnt vmcnt(0)" ::: "memory"); } while (0)
#define RESC(a) do { if (__any((a) < 1.f)) { if (hi == 0) al_l[r32] = (a); asm volatile("s_waitcnt lgkmcnt(0)" ::: "memory"); \
    _Pragma("unroll") for (int d = 0; d < 4; ++d) _Pragma("unroll") for (int r = 0; r < 16; ++r) o[d][r] *= al_l[crow(r, hi)]; } } while (0)
  f32x16 pA0, pA1, pB0, pB1; float mnA, mnB, alA, alB; bf16x8 pa0, pa1, pa2, pa3; const int NT = seq / 64;
  constexpr int SE = 0, SO = SDEPTH - 1;
  SLOAD(SE, 0); asm volatile("s_waitcnt vmcnt(0)" ::: "memory"); SWRITE(0, SE); __syncthreads();
  qkt<DQ>(pA0, pA1, K_lds, KR_lds, qr, r32, hi); partialSM(pA0, pA1, m_reg, mnA, alA, C, thr_s);
  SLOAD(SO, 64); if constexpr (SDEPTH == 2) { if (2 < NT) SLOAD(SE, 2 * 64); }
  SWAIT(); SWRITE(1, SO); __syncthreads();
  for (int j = 1; j + 1 < NT; j += 2) {
    SBAR(); qkt<DQ>(pB0, pB1, K_lds + SHM_K, KR_lds + SHM_KR, qr, r32, hi);
    finishSM(pA0, pA1, alA, l_reg, pa0, pa1, pa2, pa3); SBAR();
    SLOAD(SO, (j + SDEPTH) * 64); SBAR();
    pv_d0(o, vb0, pa0, pa1, pa2, pa3); partialSM(pB0, pB1, m_reg, mnB, alB, C, thr_s);
    __syncthreads(); SWAIT(); SWRITE(0, SE);
    RESC(alB); __syncthreads();
    SBAR(); qkt<DQ>(pA0, pA1, K_lds, KR_lds, qr, r32, hi);
    finishSM(pB0, pB1, alB, l_reg, pa0, pa1, pa2, pa3); SBAR();
    if (SDEPTH == 1 || j + 3 < NT) SLOAD(SE, (j + 1 + SDEPTH) * 64); SBAR();
    pv_d0(o, vb0 + SHM_V, pa0, pa1, pa2, pa3); partialSM(pA0, pA1, m_reg, mnA, alA, C, thr_s);
    __syncthreads(); SWAIT(); SWRITE(1, SO);
    RESC(alA); __syncthreads();
  }
  SBAR(); qkt<DQ>(pB0, pB1, K_lds + SHM_K, KR_lds + SHM_KR, qr, r32, hi);
  finishSM(pA0, pA1, alA, l_reg, pa0, pa1, pa2, pa3); SBAR();
  pv_d0(o, vb0, pa0, pa1, pa2, pa3); partialSM(pB0, pB1, m_reg, mnB, alB, C, thr_s);
  __syncthreads(); RESC(alB);
  finishSM(pB0, pB1, alB, l_reg, pa0, pa1, pa2, pa3); SBAR();
  pv_d0(o, vb0 + SHM_V, pa0, pa1, pa2, pa3);
  if (hi == 0) li_l[r32] = l_reg; asm volatile("s_waitcnt lgkmcnt(0)" ::: "memory");
  bf16_t* Ow = Ob + (long)(wid * 32) * LDO + r32;
#pragma unroll
  for (int r = 0; r < 16; ++r) { const int orow = crow(r, hi); const float rl = __builtin_amdgcn_rcpf(li_l[orow]);
#pragma unroll
    for (int d0 = 0; d0 < 4; ++d0) Ow[(long)orow * LDO + d0 * 32] = f2bf(o[d0][r] * rl); }
#undef SLOAD
#undef SWRITE
#undef SWAIT
#undef RESC
  __syncthreads();
}

__device__ __forceinline__ void ln_row_finish(float (&r)[16], int lane, const float* lnw, const float* lnb, float* Xrow, bf16_t* Hrow, const float* sh, const float* sc, float* orow) {
  float s = 0.f;
#pragma unroll
  for (int i = 0; i < 16; ++i) s += r[i];
  const float mean = wsum(s) * (1.f / 1024.f);
  float q = 0.f;
#pragma unroll
  for (int i = 0; i < 16; ++i) { r[i] -= mean; q += r[i] * r[i]; }
  const float rstd = rsqrtf(wsum(q) * (1.f / 1024.f) + 1e-5f);
#pragma unroll
  for (int hf = 0; hf < 2; ++hf) {
    const int c0 = hf * 512 + lane * 8;
    float xn[8];
#pragma unroll
    for (int i = 0; i < 8; ++i) xn[i] = r[hf * 8 + i] * rstd * lnw[c0 + i] + lnb[c0 + i];
    *(float4*)(Xrow + c0) = make_float4(xn[0], xn[1], xn[2], xn[3]); *(float4*)(Xrow + c0 + 4) = make_float4(xn[4], xn[5], xn[6], xn[7]);
    if (orow) { *(float4*)(orow + c0) = make_float4(xn[0], xn[1], xn[2], xn[3]); *(float4*)(orow + c0 + 4) = make_float4(xn[4], xn[5], xn[6], xn[7]); }
    if (Hrow) {
      float hv[8];
#pragma unroll
      for (int i = 0; i < 8; ++i) hv[i] = xn[i] * (1.f + sc[c0 + i]) + sh[c0 + i];
      u32x4 w = {cvtpk(hv[0], hv[1]), cvtpk(hv[2], hv[3]), cvtpk(hv[4], hv[5]), cvtpk(hv[6], hv[7])};
      *(u32x4*)(Hrow + c0) = w;
    }
  }
}

struct WDesc { const float* src; bf16_t* dst; int K, N, Npad; };
constexpr int wd_tiles_of(int K, int Npad) { return (K / 64) * (Npad / 64); }
constexpr int WT_MLA = wd_tiles_of(1024, 768) + wd_tiles_of(1024, 384) + wd_tiles_of(768, 1536) + wd_tiles_of(256, 2048) + wd_tiles_of(1024, 1024);
constexpr int WT_HY = wd_tiles_of(1024, 3072) + wd_tiles_of(1024, 1024), WT_GQA = wd_tiles_of(1024, 1536) + wd_tiles_of(1024, 1024), WT_PQ = wd_tiles_of(1024, 2048);
constexpr int WD_TILES = 2 * WT_MLA + WT_HY + WT_GQA + 4 * WT_PQ;
__device__ __forceinline__ void job_wconv(const Params& p, char* lds) {
  float* tile = (float*)lds;
  const int tid = otid();
  for (int it = blockIdx.x; it < WD_TILES; it += gridDim.x) {
    WDesc w; int lt = it;
    if (lt < 2 * WT_MLA) {
      const int i = lt / WT_MLA; lt -= i * WT_MLA;
      if (lt < wd_tiles_of(1024, 768)) w = WDesc{p.in[8] + (size_t)i * 1024 * 768, WSP(bf16_t, OFF_W1 + (size_t)i * SZ_W1), 1024, 768, 768};
      else if ((lt -= wd_tiles_of(1024, 768)) < wd_tiles_of(1024, 384)) w = WDesc{p.in[11] + (size_t)i * 1024 * 320, WSP(bf16_t, OFF_W1 + (size_t)i * SZ_W1) + (size_t)768 * 1024, 1024, 320, 384};
      else if ((lt -= wd_tiles_of(1024, 384)) < wd_tiles_of(768, 1536)) w = WDesc{p.in[10] + (size_t)i * 768 * 1536, WSP(bf16_t, OFF_WUQ + (size_t)i * SZ_WUQ), 768, 1536, 1536};
      else if ((lt -= wd_tiles_of(768, 1536)) < wd_tiles_of(256, 2048)) w = WDesc{p.in[13] + (size_t)i * 256 * 2048, WSP(bf16_t, OFF_WUKV + (size_t)i * SZ_WUKV), 256, 2048, 2048};
      else { lt -= wd_tiles_of(256, 2048); w = WDesc{p.in[14] + (size_t)i * 1024 * 1024, WSP(bf16_t, OFF_WOA + (size_t)i * SZ_WSQ), 1024, 1024, 1024}; }
    } else if ((lt -= 2 * WT_MLA) < WT_HY) {
      if (lt < wd_tiles_of(1024, 3072)) w = WDesc{p.in[15], WSP(bf16_t, OFF_WIN), 1024, 3072, 3072};
      else { lt -= wd_tiles_of(1024, 3072); w = WDesc{p.in[27], WSP(bf16_t, OFF_WOUT), 1024, 1024, 1024}; }
    } else if ((lt -= WT_HY) < WT_GQA) {
      if (lt < wd_tiles_of(1024, 1536)) w = WDesc{p.in[29], WSP(bf16_t, OFF_WQKV), 1024, 1536, 1536};
      else { lt -= wd_tiles_of(1024, 1536); w = WDesc{p.in[32], WSP(bf16_t, OFF_WOC), 1024, 1024, 1024}; }
    } else {
      lt -= WT_GQA; const int l = lt / WT_PQ; lt -= l * WT_PQ;
      w = WDesc{p.in[33] + (size_t)l * 1024 * 2048, WSP(bf16_t, OFF_WQ + (size_t)l * SZ_WQ), 1024, 2048, 2048};
    }
    const int tn = w.Npad / 64, kt = lt / tn, nt = lt - kt * tn, k0 = kt * 64, n0 = nt * 64;
    for (int e = tid; e < 4096; e += NTHR) { const int k = e >> 6, n = e & 63; tile[k * 65 + n] = (n0 + n < w.N) ? w.src[(size_t)(k0 + k) * w.N + n0 + n] : 0.f; }
    __syncthreads();
    for (int e = tid; e < 4096; e += NTHR) { const int n = e >> 6, k = e & 63; w.dst[(size_t)(n0 + n) * w.K + k0 + k] = f2bf(tile[k * 65 + n]); }
    __syncthreads();
  }
}
__device__ __forceinline__ void job_peer_conv(const Params& p) {
  const size_t gt = (size_t)blockIdx.x * NTHR + otid(), gs = (size_t)gridDim.x * NTHR;
  const size_t nk8 = (size_t)4 * 16 * 16384 / 8;
  for (size_t i = gt; i < nk8; i += gs) {
    const size_t e = i * 8; const int blk = (int)(e >> 14), off = (int)(e & 16383); const int l = blk >> 4, h = (blk >> 1) & 7, side = blk & 1;
    const float* src = (side ? p.in[35] : p.in[34]) + ((size_t)(l * 8 + h) << 14) + off;
    const float4 a = *(const float4*)src, b = *(const float4*)(src + 4);
    u32x4 w = {cvtpk(a.x, a.y), cvtpk(a.z, a.w), cvtpk(b.x, b.y), cvtpk(b.z, b.w)};
    *(u32x4*)(WSP(bf16_t, OFF_KEYS) + e) = w;
  }
  const size_t n8 = (size_t)4 * 16384 * 1024 / 8;
  for (size_t i = gt; i < 2 * n8; i += gs) {
    const bool isv = i >= n8; const size_t j = isv ? i - n8 : i;
    const float* src = (isv ? p.in[37] : p.in[36]) + j * 8;
    const float4 a = *(const float4*)src, b = *(const float4*)(src + 4);
    u32x4 w = {cvtpk(a.x, a.y), cvtpk(a.z, a.w), cvtpk(b.x, b.y), cvtpk(b.z, b.w)};
    *(u32x4*)((isv ? WSP(bf16_t, OFF_PV) : WSP(bf16_t, OFF_PU)) + j * 8) = w;
  }
}
__device__ __forceinline__ void job_adaln_partial(const Params& p, char* lds) {
  float* sl = (float*)lds;
  float* red = (float*)lds + 1024;
  const int tid = otid();
  for (int it = blockIdx.x; it < 768; it += gridDim.x) {
    const int l = it / 192, rem = it - l * 192, cgp = rem >> 3, ks = rem & 7;
    for (int e = tid; e < 640; e += NTHR) { const int r = e >> 7, k = e & 127; const float v = (r < 4) ? p.in[1][r * 1024 + ks * 128 + k] : p.in[3][ks * 128 + k]; sl[e] = v / (1.f + __expf(-v)); }
    __syncthreads();
    const int cq = tid & 63, kg = tid >> 6;
    float4 acc[5];
#pragma unroll
    for (int r = 0; r < 5; ++r) acc[r] = make_float4(0.f, 0.f, 0.f, 0.f);
    for (int i = 0; i < 16; ++i) {
      const int k = kg * 16 + i;
      const float4 w = *(const float4*)(p.in[4] + ((size_t)l * 1024 + ks * 128 + k) * 6144 + cgp * 256 + cq * 4);
#pragma unroll
      for (int r = 0; r < 5; ++r) { const float sv = sl[r * 128 + k]; acc[r].x += sv * w.x; acc[r].y += sv * w.y; acc[r].z += sv * w.z; acc[r].w += sv * w.w; }
    }
#pragma unroll
    for (int r = 0; r < 5; ++r) *(float4*)(red + (kg * 5 + r) * 256 + cq * 4) = acc[r];
    __syncthreads();
    for (int e = tid; e < 1280; e += NTHR) {
      const int r = e >> 8, col = e & 255; float s = 0.f;
#pragma unroll
      for (int g = 0; g < 8; ++g) s += red[(g * 5 + r) * 256 + col];
      WSP(float, OFF_MODP)[((size_t)(ks * 4 + l) * 5 + r) * 6144 + cgp * 256 + col] = s;
    }
    __syncthreads();
  }
}
__device__ __forceinline__ void job_hdn(const Params& p, char* lds) {
  float* h1s = (float*)lds;
  const int tid = otid(), tl = tid >> 6, r = tid & 63;
  for (int it = blockIdx.x; it < 544; it += gridDim.x) {
    const int s = it < 512 ? 0 : 1, chunk = it - s * 512, L = s ? 256 : 4096, tau = chunk * 8 + tl;
    float a1 = p.in[20][r] + ((float)tau / (float)(L - 1)) * p.in[19][r];
#pragma unroll 4
    for (int k = 0; k < 16; ++k) {
      const float f = 1e-4f + (float)k * ((15.f - 1e-4f) / 15.f);
      const float rev = f * (float)tau / (float)L;
      a1 += cos_rev(rev) * p.in[19][(1 + k) * 64 + r] - sin_rev(rev) * p.in[19][(17 + k) * 64 + r];
    }
    h1s[tl * 64 + r] = sin_rad(p.in[21][r] * a1);
    __syncthreads();
    float a2 = p.in[23][r];
    for (int q = 0; q < 64; ++q) a2 += h1s[tl * 64 + q] * p.in[22][q * 64 + r];
    WSP(float, OFF_HDN)[((size_t)s * 4096 + tau) * 64 + r] = sin_rad(p.in[24][r] * a2);
    __syncthreads();
  }
}
__device__ __forceinline__ void job_mod_final(const Params& p) {
  for (int e = blockIdx.x * NTHR + otid(); e < 4 * 5 * 6144; e += gridDim.x * NTHR) {
    const int l = e / 30720, rem = e - l * 30720, col = rem % 6144;
    float s = p.in[5][l * 6144 + col];
#pragma unroll
    for (int ks = 0; ks < 8; ++ks) s += WSP(float, OFF_MODP)[(size_t)ks * 4 * 30720 + e];
    WSP(float, OFF_MOD)[e] = s;
  }
}
__device__ __forceinline__ void job_gbuild(const Params& p, char* lds) {
  float* hd = (float*)lds;
  const int tid = otid();
  for (int it = blockIdx.x; it < 1024 + 64; it += gridDim.x) {
    const int s = it < 1024 ? 0 : 1, li = it - s * 1024, L = s ? 256 : 4096, tt = li >> 3, ct = li & 7;
    const int col = ct * 512 + tid, o = col >> 11, dir = (col >> 10) & 1, d = col & 1023;
    float w3c[64];
#pragma unroll
    for (int r = 0; r < 64; ++r) w3c[r] = p.in[25][r * 4096 + col];
    for (int e = tid; e < 2048; e += NTHR) hd[e] = WSP(float, OFF_HDN)[((size_t)s * 4096 + tt * 32) * 64 + e];
    __syncthreads();
    const float delta = 3.0701134573253945f + 12.280453829301578f * ((float)d / 1023.f);
    const float bias_o = p.in[26][o * 1024 + d];
    bf16_t* Gp = (s ? WSP(bf16_t, OFF_GCTX) : WSP(bf16_t, OFF_GLAT)) + (size_t)(o * 1024 + d) * (2 * L);
    for (int j = 0; j < 32; ++j) {
      const int tau = tt * 32 + j;
      float f = 0.f;
#pragma unroll
      for (int r = 0; r < 64; ++r) f += hd[j * 64 + r] * w3c[r];
      const float t01 = (float)tau / (float)(L - 1);
      float val = f * (__expf(-t01 * delta) + 0.05f);
      int xi;
      if (dir == 0) { if (tau == 0) val += bias_o; xi = L + tau; }
      else { if (tau == 0) { val = 0.f; xi = 0; } else xi = L - tau; }
      Gp[xi] = f2bf(val);
    }
    __syncthreads();
  }
}
__device__ __forceinline__ void job_init(const Params& p) {
  const size_t n4 = (size_t)T * 256;
  for (size_t i = (size_t)blockIdx.x * NTHR + otid(); i < n4; i += (size_t)gridDim.x * NTHR) {
    const int row = (int)(i >> 8), c = (int)(i & 255) * 4;
    const RowInfo ri = row_info(row);
    const float* src = ri.is_ctx ? p.in[2] + ((size_t)(ri.b * CTXL + ri.rb) * 1024 + c) : p.in[0] + ((size_t)(ri.b * SEQ + ri.pos) * 1024 + c);
    const float4 v = *(const float4*)src;
    *(float4*)(WSP(float, OFF_X) + (size_t)row * 1024 + c) = v;
    const float* md = WSP(float, OFF_MOD) + (size_t)ri.mrow * 6144;
    const float4 sh = *(const float4*)(md + c), sc = *(const float4*)(md + 1024 + c);
    u32x2 w = {cvtpk(v.x * (1.f + sc.x) + sh.x, v.y * (1.f + sc.y) + sh.y), cvtpk(v.z * (1.f + sc.z) + sh.z, v.w * (1.f + sc.w) + sh.w)};
    *(u32x2*)(WSP(bf16_t, OFF_H) + (size_t)row * 1024 + c) = w;
  }
}
__device__ __forceinline__ void job_mla_norm(const Params& p, int ia) {
  const int lane = otid() & 63, wg = blockIdx.x * 8 + (otid() >> 6), nw = gridDim.x * 8;
  const float* C1 = WSP(float, OFF_RA); bf16_t* CQN = WSP(bf16_t, OFF_RE); bf16_t* CKVN = WSP(bf16_t, OFF_RE) + (size_t)T * 768; bf16_t* KPE = WSP(bf16_t, OFF_RC) + (size_t)T * 1024;
  const float* qn = p.in[9] + ia * 768; const float* kn = p.in[12] + ia * 256;
  for (int row = wg; row < T; row += nw) {
    const float* cr = C1 + (size_t)row * 1152;
    float4 v[3]; float ss = 0.f;
#pragma unroll
    for (int j = 0; j < 3; ++j) { v[j] = *(const float4*)(cr + (j * 64 + lane) * 4); ss += v[j].x * v[j].x + v[j].y * v[j].y + v[j].z * v[j].z + v[j].w * v[j].w; }
    const float rq = rsqrtf(wsum(ss) * (1.f / 768.f) + 1e-6f);
#pragma unroll
    for (int j = 0; j < 3; ++j) { const int c = (j * 64 + lane) * 4; const float4 g = *(const float4*)(qn + c);
      u32x2 w = {cvtpk(v[j].x * rq * g.x, v[j].y * rq * g.y), cvtpk(v[j].z * rq * g.z, v[j].w * rq * g.w)}; *(u32x2*)(CQN + (size_t)row * 768 + c) = w; }
    const float4 kv = *(const float4*)(cr + 768 + lane * 4);
    const float rk = rsqrtf(wsum(kv.x * kv.x + kv.y * kv.y + kv.z * kv.z + kv.w * kv.w) * (1.f / 256.f) + 1e-6f);
    { const float4 g = *(const float4*)(kn + lane * 4);
      u32x2 w = {cvtpk(kv.x * rk * g.x, kv.y * rk * g.y), cvtpk(kv.z * rk * g.z, kv.w * rk * g.w)}; *(u32x2*)(CKVN + (size_t)row * 256 + lane * 4) = w; }
    if (lane < 32) {
      const float2 xp = *(const float2*)(cr + 1024 + 2 * lane);
      const RowInfo ri = row_info(row);
      float o0 = xp.x, o1 = xp.y;
      if (!ri.is_ctx) { float c, s; rope_cs(ri.pos, lane, 16, c, s); o0 = xp.x * c - xp.y * s; o1 = xp.x * s + xp.y * c; }
      *(unsigned*)(KPE + (size_t)row * 64 + 2 * lane) = cvtpk(o0, o1);
    }
  }
}
__device__ __forceinline__ void job_gqa_norm(const Params& p) {
  const int lane = otid() & 63, wg = blockIdx.x * 8 + (otid() >> 6), nw = gridDim.x * 8;
  const float* QKV = WSP(float, OFF_RA); bf16_t* Qb = WSP(bf16_t, OFF_RB); bf16_t* Kb = WSP(bf16_t, OFF_RC); bf16_t* Vb = WSP(bf16_t, OFF_RD);
  for (int row = wg; row < T; row += nw) {
    const float* cr = QKV + (size_t)row * 1536;
    const RowInfo ri = row_info(row);
    float rc = 1.f, rs = 0.f;
    if (!ri.is_ctx) rope_cs(ri.pos, lane, 32, rc, rs);
#pragma unroll 2
    for (int hh = 0; hh < 10; ++hh) {
      const float2 xp = *(const float2*)(cr + hh * 128 + 2 * lane);
      const float rinv = rsqrtf(wsum(xp.x * xp.x + xp.y * xp.y) * (1.f / 128.f) + 1e-6f);
      const float2 g = *(const float2*)((hh < 8 ? p.in[30] : p.in[31]) + 2 * lane);
      const float x0 = xp.x * rinv * g.x, x1 = xp.y * rinv * g.y;
      const unsigned w = cvtpk(x0 * rc - x1 * rs, x0 * rs + x1 * rc);
      if (hh < 8) *(unsigned*)(Qb + (size_t)row * 1024 + hh * 128 + 2 * lane) = w; else *(unsigned*)(Kb + (size_t)row * 256 + (hh - 8) * 128 + 2 * lane) = w;
    }
    const float4 v = *(const float4*)(cr + 1280 + lane * 4);
    u32x2 w = {cvtpk(v.x, v.y), cvtpk(v.z, v.w)}; *(u32x2*)(Vb + (size_t)row * 256 + lane * 4) = w;
  }
}
__device__ __forceinline__ void job_ln1(const Params& p, int layer) {
  const int lane = otid() & 63, wg = blockIdx.x * 8 + (otid() >> 6), nw = gridDim.x * 8;
  const float* lnw = p.in[6] + (size_t)(layer * 2) * 1024; const float* lnb = p.in[7] + (size_t)(layer * 2) * 1024;
  for (int row = wg; row < T; row += nw) {
    const RowInfo ri = row_info(row);
    const float* md = WSP(float, OFF_MOD) + ((size_t)layer * 5 + ri.mrow) * 6144;
    float* Xr = WSP(float, OFF_X) + (size_t)row * 1024; const float* Yr = WSP(float, OFF_Y) + (size_t)row * 1024;
    float r[16];
#pragma unroll
    for (int hf = 0; hf < 2; ++hf) { const int c0 = hf * 512 + lane * 8;
#pragma unroll
      for (int q = 0; q < 2; ++q) { const float4 xv = *(const float4*)(Xr + c0 + q * 4), yv = *(const float4*)(Yr + c0 + q * 4), gv = *(const float4*)(md + 2048 + c0 + q * 4);
        r[hf * 8 + q * 4 + 0] = ALPHA * xv.x + gv.x * yv.x; r[hf * 8 + q * 4 + 1] = ALPHA * xv.y + gv.y * yv.y; r[hf * 8 + q * 4 + 2] = ALPHA * xv.z + gv.z * yv.z; r[hf * 8 + q * 4 + 3] = ALPHA * xv.w + gv.w * yv.w; } }
    ln_row_finish(r, lane, lnw, lnb, Xr, WSP(bf16_t, OFF_H) + (size_t)row * 1024, md + 3072, md + 4096, nullptr);
  }
}
__device__ __forceinline__ void job_attn_mla(const Params& p, char* lds) {
  const bf16_t* Qb = WSP(bf16_t, OFF_RB); const bf16_t* Kb = WSP(bf16_t, OFF_RC); const bf16_t* KPE = WSP(bf16_t, OFF_RC) + (size_t)T * 1024; const bf16_t* Vb = WSP(bf16_t, OFF_RD); bf16_t* AO = WSP(bf16_t, OFF_RF);
  for (int it = blockIdx.x; it < 544; it += gridDim.x) {
    int b, h, q0, seq;
    if (it < 512) { b = it >> 7; h = (it >> 4) & 7; q0 = b * RB + CTXL + (it & 15) * 256; seq = RB; } else { const int j = it - 512; b = j >> 3; h = j & 7; q0 = b * RB; seq = CTXL; }
    attn_body<192, 1536, 1024, 64, 1024, 1024, 1>(Qb + (size_t)q0 * 1536 + h * 192, Kb + (size_t)b * RB * 1024 + h * 128, KPE + (size_t)b * RB * 64, Vb + (size_t)b * RB * 1024 + h * 128,
                                                   AO + (size_t)q0 * 1024 + h * 128, seq, lds);
  }
}
__device__ __forceinline__ void job_attn_gqa(const Params& p, char* lds) {
  const bf16_t* Qb = WSP(bf16_t, OFF_RB); const bf16_t* Kb = WSP(bf16_t, OFF_RC); const bf16_t* Vb = WSP(bf16_t, OFF_RD); bf16_t* AO = WSP(bf16_t, OFF_RF);
  for (int it = blockIdx.x; it < 544; it += gridDim.x) {
    int b, h, q0, seq;
    if (it < 512) { b = it >> 7; h = (it >> 4) & 7; q0 = b * RB + CTXL + (it & 15) * 256; seq = RB; } else { const int j = it - 512; b = j >> 3; h = j & 7; q0 = b * RB; seq = CTXL; }
    attn_body<128, 1024, 256, 64, 256, 1024, 1>(Qb + (size_t)q0 * 1024 + h * 128, Kb + (size_t)b * RB * 256 + (h >> 2) * 128, nullptr, Vb + (size_t)b * RB * 256 + (h >> 2) * 128,
                                                 AO + (size_t)q0 * 1024 + h * 128, seq, lds);
  }
}
constexpr int HY_FCN = 8336, HY_VEN = 78 * 64;
constexpr int HY_LDS = 4 * HY_FCN * 2 + 2 * 4 * HY_VEN * 2;
__device__ __forceinline__ float hy_short(const bf16_t* zr, int t, int L, float w0, float w1, float w2, float cb) {
  float v = cb + w1 * bf2f(zr[t]);
  if (t > 0) v += w0 * bf2f(zr[t - 1]);
  if (t + 1 < L) v += w2 * bf2f(zr[t + 1]);
  return v;
}
__device__ __forceinline__ void hy_fill_seq(const Params& p, bf16_t* dst, int ch, int L, int nb, int seq0) {
  const bf16_t* ZT = WSP(bf16_t, OFF_RA);
  const float w0 = p.in[17][ch], w1 = p.in[17][3072 + ch], w2 = p.in[17][6144 + ch], cb = p.in[18][ch];
  const int cpb = (nb + 14) * 8;
  for (int e = otid(); e < 4 * cpb; e += NTHR) {
    const int b = e / cpb, ci = e - b * cpb, t0 = ci * 8 - 7 * 64;
    u32x4 w = {0u, 0u, 0u, 0u};
    if (t0 >= 0 && t0 < L) {
      const bf16_t* zr = ZT + (size_t)ch * T + b * RB + seq0;
      const u32x4 zc = *(const u32x4*)(zr + t0);
      float z[10];
      z[0] = t0 > 0 ? bf2f(zr[t0 - 1]) : 0.f; z[9] = (t0 + 8 < L) ? bf2f(zr[t0 + 8]) : 0.f;
      z[1] = bflo(zc[0]); z[2] = bfhi(zc[0]); z[3] = bflo(zc[1]); z[4] = bfhi(zc[1]); z[5] = bflo(zc[2]); z[6] = bfhi(zc[2]); z[7] = bflo(zc[3]); z[8] = bfhi(zc[3]);
      float o[8];
#pragma unroll
      for (int i = 0; i < 8; ++i) o[i] = cb + w0 * z[i] + w1 * z[i + 1] + w2 * z[i + 2];
      w = (u32x4){cvtpk(o[0], o[1]), cvtpk(o[2], o[3]), cvtpk(o[4], o[5]), cvtpk(o[6], o[7])};
    }
    *(u32x4*)(dst + (size_t)b * HY_VEN + ci * 8) = w;
  }
}
__device__ __forceinline__ void hy_fill_filter(bf16_t* FC, const bf16_t* Gp, int L) {
  const int OFF = L + 64, nch = (2 * L + 144) / 8;
  for (int e = otid(); e < 4 * nch; e += NTHR) {
    const int s = e / nch, u0 = (e - s * nch) * 8;
    unsigned short v[8];
#pragma unroll
    for (int i = 0; i < 8; ++i) { const int z = u0 + i - s - OFF; v[i] = (z > -L && z < L) ? Gp[L - z] : (unsigned short)0; }
    u32x4 w = {(unsigned)v[0] | ((unsigned)v[1] << 16), (unsigned)v[2] | ((unsigned)v[3] << 16), (unsigned)v[4] | ((unsigned)v[5] << 16), (unsigned)v[6] | ((unsigned)v[7] << 16)};
    *(u32x4*)(FC + (size_t)s * HY_FCN + u0) = w;
  }
}
__device__ __forceinline__ void hy_conv(f32x16 (&acc)[2], const bf16_t* FC, const bf16_t* SRC, int nb, int q, int r32, int hi) {
  acc[0] = f32x16{}; acc[1] = f32x16{};
  const int OFFL = nb * 64 + 64, s = r32 & 3, al = r32 >> 2, bb = r32 & 3;
  const int mlo = 8 * q - (nb - 1), mhi = (8 * q + 7 < nb - 1) ? 8 * q + 7 : nb - 1;
  const bf16_t* fbase = FC + (size_t)s * HY_FCN + (8 * hi - r32 + OFFL + s);
  const bf16_t* vbase = SRC + (size_t)bb * HY_VEN + (8 * q + al + 7) * 64 + 8 * hi;
  for (int m = mlo; m <= mhi; ++m) {
#pragma unroll
    for (int ks = 0; ks < 4; ++ks) {
      const bf16x8 bv = *(const bf16x8*)(vbase - m * 64 + ks * 16);
#pragma unroll
      for (int it = 0; it < 2; ++it) {
        const bf16_t* fp = fbase + ks * 16 - it * 32 - 64 * m;
        const s16x4 lo = *(const s16x4*)fp, hh = *(const s16x4*)(fp + 4);
        const bf16x8 av = {lo[0], lo[1], lo[2], lo[3], hh[0], hh[1], hh[2], hh[3]};
        acc[it] = __builtin_amdgcn_mfma_f32_32x32x16_bf16(av, bv, acc[it], 0, 0, 0);
      }
    }
  }
}
__device__ __forceinline__ void job_hyena(const Params& p, int ib, char* lds) {
  bf16_t* FC = (bf16_t*)lds; bf16_t* VE = FC + 4 * HY_FCN; bf16_t* ZE = VE + 4 * HY_VEN;
  bf16_t* YT = WSP(bf16_t, OFF_RB);
  const int tid = otid(), lane = tid & 63, q = tid >> 6, r32 = lane & 31, hi = lane >> 5;
  for (int it = blockIdx.x; it < 2048; it += gridDim.x) {
    const int s = it < 1024 ? 0 : 1, d = it & 1023, L = s ? 256 : 4096, nb = L >> 6, seq0 = s ? 0 : CTXL;
    const bf16_t* G0 = (s ? WSP(bf16_t, OFF_GCTX) : WSP(bf16_t, OFF_GLAT)) + (size_t)d * (2 * L); const bf16_t* G1 = G0 + (size_t)1024 * (2 * L);
    hy_fill_seq(p, VE, 2048 + d, L, nb, seq0);
    hy_fill_seq(p, ZE, d, L, nb, seq0);
    hy_fill_filter(FC, G0, L);
    __syncthreads();
    const bool active = 8 * q < nb;
    f32x16 acc[2];
    if (active) {
      hy_conv(acc, FC, VE, nb, q, r32, hi);
      const int a = 8 * q + (r32 >> 2), bb = r32 & 3;
      if (a < nb) {
#pragma unroll
        for (int i2 = 0; i2 < 2; ++i2)
#pragma unroll
          for (int r = 0; r < 16; ++r) { bf16_t* zp = ZE + (size_t)bb * HY_VEN + (a + 7) * 64 + i2 * 32 + crow(r, hi); *zp = f2bf(bf2f(*zp) * acc[i2][r]); }
      }
    }
    __syncthreads();
    hy_fill_seq(p, VE, 1024 + d, L, nb, seq0);
    hy_fill_filter(FC, G1, L);
    __syncthreads();
    if (active) {
      hy_conv(acc, FC, ZE, nb, q, r32, hi);
      const int a = 8 * q + (r32 >> 2), bb = r32 & 3;
      if (a < nb) {
#pragma unroll
        for (int i2 = 0; i2 < 2; ++i2)
#pragma unroll
          for (int r = 0; r < 16; ++r) { bf16_t* vp = VE + (size_t)bb * HY_VEN + (a + 7) * 64 + i2 * 32 + crow(r, hi); *vp = f2bf(bf2f(*vp) * acc[i2][r]); }
      }
    }
    __syncthreads();
    for (int e = tid; e < 4 * (L / 8); e += NTHR) {
      const int b = e / (L / 8), t0 = (e - b * (L / 8)) * 8;
      *(u32x4*)(YT + (size_t)d * T + b * RB + seq0 + t0) = *(const u32x4*)(VE + (size_t)b * HY_VEN + 7 * 64 + t0);
    }
    __syncthreads();
  }
}
__device__ __forceinline__ void job_transpose_y(const Params& p, char* lds) {
  bf16_t* tile = (bf16_t*)lds;
  const bf16_t* YT = WSP(bf16_t, OFF_RB); bf16_t* Ytr = WSP(bf16_t, OFF_RC);
  const int tid = otid();
  for (int it = blockIdx.x; it < 16 * 272; it += gridDim.x) {
    const int dt = it / 272, tt = it - dt * 272, d0 = dt * 64, t0 = tt * 64;
    for (int e = tid; e < 4096; e += NTHR) { const int dr = e >> 6, tc = e & 63; tile[dr * 66 + tc] = YT[(size_t)(d0 + dr) * T + t0 + tc]; }
    __syncthreads();
    for (int e = tid; e < 4096; e += NTHR) { const int tr = e >> 6, dc = e & 63; Ytr[(size_t)(t0 + tr) * 1024 + d0 + dc] = tile[dc * 66 + tr]; }
    __syncthreads();
  }
}
__device__ __forceinline__ void ins16(float (&L)[16], float x) {
#pragma unroll
  for (int i = 0; i < 16; ++i) { const float hi = __builtin_fmaxf(L[i], x); x = __builtin_fminf(L[i], x); L[i] = hi; }
}
__device__ __forceinline__ void job_topk(const Params& p) {
  const float* S = WSP(float, OFF_RA);
  const float NEG = -3.0e38f;
  for (int item = blockIdx.x * NTHR + otid(); item < T * 8; item += gridDim.x * NTHR) {
    const float* s1 = S + (size_t)item * 256;
    float L1[16], L2[16], L3[16];
#pragma unroll
    for (int i = 0; i < 16; ++i) { L1[i] = NEG; L2[i] = NEG; L3[i] = NEG; }
#pragma unroll 1
    for (int c = 0; c < 32; ++c) {
      const float4 v = *(const float4*)(s1 + c * 4);
      ins16(L1, __uint_as_float((__float_as_uint(v.x) & ~127u) | (unsigned)(c * 4 + 0)));
      ins16(L1, __uint_as_float((__float_as_uint(v.y) & ~127u) | (unsigned)(c * 4 + 1)));
      ins16(L1, __uint_as_float((__float_as_uint(v.z) & ~127u) | (unsigned)(c * 4 + 2)));
      ins16(L1, __uint_as_float((__float_as_uint(v.w) & ~127u) | (unsigned)(c * 4 + 3)));
    }
#pragma unroll 1
    for (int c = 0; c < 32; ++c) {
      const float4 v = *(const float4*)(s1 + 128 + c * 4);
      ins16(L2, __uint_as_float((__float_as_uint(v.x) & ~127u) | (unsigned)(c * 4 + 0)));
      ins16(L2, __uint_as_float((__float_as_uint(v.y) & ~127u) | (unsigned)(c * 4 + 1)));
      ins16(L2, __uint_as_float((__float_as_uint(v.z) & ~127u) | (unsigned)(c * 4 + 2)));
      ins16(L2, __uint_as_float((__float_as_uint(v.w) & ~127u) | (unsigned)(c * 4 + 3)));
    }
#pragma unroll
    for (int i = 0; i < 16; ++i)
#pragma unroll
      for (int j = 0; j < 16; ++j)
        if ((i + 1) * (j + 1) <= 16) {
          const float sum = __uint_as_float(__float_as_uint(L1[i]) & ~127u) + __uint_as_float(__float_as_uint(L2[j]) & ~127u);
          ins16(L3, __uint_as_float((__float_as_uint(sum) & ~255u) | (unsigned)(i * 16 + j)));
        }
    float ev[16]; float den = 0.f;
    const float mx = __uint_as_float(__float_as_uint(L3[0]) & ~255u);
#pragma unroll
    for (int k = 0; k < 16; ++k) { ev[k] = __expf(__uint_as_float(__float_as_uint(L3[k]) & ~255u) - mx); den += ev[k]; }
    const float rden = 1.f / den;
    int* ip = WSP(int, OFF_RC) + (size_t)item * 16; float* gp = WSP(float, OFF_RC + (size_t)T * 128 * 4) + (size_t)item * 16;
#pragma unroll
    for (int k = 0; k < 16; ++k) {
      const unsigned code = __float_as_uint(L3[k]) & 255u; const int ii = code >> 4, jj = code & 15;
      unsigned b1 = 0, b2 = 0;
#pragma unroll
      for (int i = 0; i < 16; ++i) { b1 = (ii == i) ? __float_as_uint(L1[i]) : b1; b2 = (jj == i) ? __float_as_uint(L2[i]) : b2; }
      ip[k] = (int)((b1 & 127u) * 128u + (b2 & 127u));
      gp[k] = ev[k] * rden;
    }
  }
}
__device__ __forceinline__ void job_peer_gather(const Params& p, int layer) {
  const int lane = otid() & 63, wg = blockIdx.x * 8 + (otid() >> 6), nw = gridDim.x * 8;
  const bf16_t* U = WSP(bf16_t, OFF_PU) + (size_t)layer * 16384 * 1024; const bf16_t* V = WSP(bf16_t, OFF_PV) + (size_t)layer * 16384 * 1024;
  const float* lnw = p.in[6] + (size_t)(layer * 2 + 1) * 1024; const float* lnb = p.in[7] + (size_t)(layer * 2 + 1) * 1024;
  const bool last = layer == DEPTH - 1;
  for (int row = wg; row < T; row += nw) {
    const RowInfo ri = row_info(row);
    float hv[16];
    { const u32x4 a = *(const u32x4*)(WSP(bf16_t, OFF_H) + (size_t)row * 1024 + lane * 8), b = *(const u32x4*)(WSP(bf16_t, OFF_H) + (size_t)row * 1024 + 512 + lane * 8);
#pragma unroll
      for (int i = 0; i < 4; ++i) { hv[2 * i] = bflo(a[i]); hv[2 * i + 1] = bfhi(a[i]); hv[8 + 2 * i] = bflo(b[i]); hv[8 + 2 * i + 1] = bfhi(b[i]); } }
    float out[16];
#pragma unroll
    for (int i = 0; i < 16; ++i) out[i] = 0.f;
    const int myidx0 = WSP(int, OFF_RC)[(size_t)row * 128 + lane], myidx1 = WSP(int, OFF_RC)[(size_t)row * 128 + 64 + lane];
    const float myg0 = WSP(float, OFF_RC + (size_t)T * 128 * 4)[(size_t)row * 128 + lane], myg1 = WSP(float, OFF_RC + (size_t)T * 128 * 4)[(size_t)row * 128 + 64 + lane];
#pragma unroll 1
    for (int e0 = 0; e0 < 128; e0 += 4) {
      u32x4 ua[4], ub[4], va[4], vb[4]; float gate[4];
#pragma unroll
      for (int qq = 0; qq < 4; ++qq) {
        const int e = e0 + qq;
        const int id = __builtin_amdgcn_readlane(e0 < 64 ? myidx0 : myidx1, e & 63);
        gate[qq] = __uint_as_float(__builtin_amdgcn_readlane(__float_as_uint(e0 < 64 ? myg0 : myg1), e & 63));
        const bf16_t* up = U + (size_t)id * 1024 + lane * 8; const bf16_t* vp = V + (size_t)id * 1024 + lane * 8;
        ua[qq] = *(const u32x4*)up; ub[qq] = *(const u32x4*)(up + 512); va[qq] = *(const u32x4*)vp; vb[qq] = *(const u32x4*)(vp + 512);
      }
#pragma unroll
      for (int qq = 0; qq < 4; ++qq) {
        float dsum = 0.f;
#pragma unroll
        for (int i = 0; i < 4; ++i) { dsum += hv[2 * i] * bflo(ua[qq][i]) + hv[2 * i + 1] * bfhi(ua[qq][i]); dsum += hv[8 + 2 * i] * bflo(ub[qq][i]) + hv[8 + 2 * i + 1] * bfhi(ub[qq][i]); }
        dsum = wsum(dsum);
        const float act = 0.5f * dsum * (1.f + erff(dsum * 0.7071067811865476f));
        const float cf = gate[qq] * act;
#pragma unroll
        for (int i = 0; i < 4; ++i) { out[2 * i] += cf * bflo(va[qq][i]); out[2 * i + 1] += cf * bfhi(va[qq][i]); out[8 + 2 * i] += cf * bflo(vb[qq][i]); out[8 + 2 * i + 1] += cf * bfhi(vb[qq][i]); }
      }
    }
    const float* md = WSP(float, OFF_MOD) + ((size_t)layer * 5 + ri.mrow) * 6144;
    float* Xr = WSP(float, OFF_X) + (size_t)row * 1024;
    float r[16];
#pragma unroll
    for (int hf = 0; hf < 2; ++hf) { const int c0 = hf * 512 + lane * 8;
#pragma unroll
      for (int i = 0; i < 8; ++i) r[hf * 8 + i] = ALPHA * Xr[c0 + i] + md[5120 + c0 + i] * out[hf * 8 + i]; }
    const float* mdn = WSP(float, OFF_MOD) + ((size_t)(last ? layer : layer + 1) * 5 + ri.mrow) * 6144;
    float* orow = (last && !ri.is_ctx) ? p.out + ((size_t)(ri.b * SEQ + ri.pos)) * 1024 : nullptr;
    ln_row_finish(r, lane, lnw, lnb, Xr, last ? nullptr : WSP(bf16_t, OFF_H) + (size_t)row * 1024, mdn, mdn + 1024, orow);
  }
}

constexpr int PARAM_LDS = 512;
constexpr int LDS_BYTES = PARAM_LDS + HY_LDS;
static_assert(HY_LDS >= ATT_LDS && HY_LDS >= 2 * G_ASZ + 2 * G_BSZ, "LDS budget");
static_assert(sizeof(Params) <= PARAM_LDS && sizeof(Params) == 41 * 8, "Params layout");
__device__ __forceinline__ Params load_params(const char* lds) {
  int off = 0; asm volatile("" : "+v"(off));
  const unsigned* lp = (const unsigned*)(lds + off);
  Params p;
#pragma unroll
  for (int k = 0; k < 38; ++k) {
    const unsigned lo = __builtin_amdgcn_readfirstlane(lp[2 * k]), hi = __builtin_amdgcn_readfirstlane(lp[2 * k + 1]);
    p.in[k] = (const float*)(((unsigned long long)hi << 32) | lo);
  }
  { const unsigned lo = __builtin_amdgcn_readfirstlane(lp[76]), hi = __builtin_amdgcn_readfirstlane(lp[77]); p.out = (float*)(((unsigned long long)hi << 32) | lo); }
  { const unsigned lo = __builtin_amdgcn_readfirstlane(lp[78]), hi = __builtin_amdgcn_readfirstlane(lp[79]); p.ws = (char*)(((unsigned long long)hi << 32) | lo); }
  p.ph_begin = 0; p.ph_end = 0;
  return p;
}
__global__ void __launch_bounds__(NTHR) mega(const Params kp) {
  extern __shared__ __attribute__((aligned(16))) char lds_all[];
  cg::grid_group grid = cg::this_grid();
  if (threadIdx.x == 0) {
    unsigned long long* lp = (unsigned long long*)lds_all;
#pragma unroll
    for (int k = 0; k < 38; ++k) lp[k] = (unsigned long long)kp.in[k];
    lp[38] = (unsigned long long)kp.out; lp[39] = (unsigned long long)kp.ws;
  }
  __syncthreads();
  char* lds = lds_all + PARAM_LDS;
  const int ph_begin = kp.ph_begin, ph_end = kp.ph_end;
  int ph = 0;
#define PHASE(...) do { if (ph >= ph_begin && ph < ph_end) { const Params p = load_params(lds_all); __VA_ARGS__; if (ph + 1 < ph_end) grid.sync(); } ++ph; } while (0)
  PHASE(job_wconv(p, lds); job_adaln_partial(p, lds); job_hdn(p, lds); job_peer_conv(p));
  PHASE(job_mod_final(p); job_gbuild(p, lds));
  PHASE(job_init(p));
#pragma unroll 1
  for (int layer = 0; layer < DEPTH; ++layer) {
    const int kind = layer % 3;
    if (kind == 0) {
      const int ia = layer / 3;
      PHASE(gemm_job(WSP(bf16_t, OFF_H), 1024, WSP(bf16_t, OFF_W1 + (size_t)ia * SZ_W1), 1024, T, 1152, 1024, false, EpiF32{WSP(float, OFF_RA), 1152, 1152, nullptr}, lds));
      PHASE(job_mla_norm(p, ia));
      PHASE(gemm_job(WSP(bf16_t, OFF_RE), 768, WSP(bf16_t, OFF_WUQ + (size_t)ia * SZ_WUQ), 768, T, 1536, 768, false, EpiMlaQ{WSP(bf16_t, OFF_RB)}, lds);
            gemm_job(WSP(bf16_t, OFF_RE) + (size_t)T * 768, 256, WSP(bf16_t, OFF_WUKV + (size_t)ia * SZ_WUKV), 256, T, 2048, 256, false, EpiMlaKV{WSP(bf16_t, OFF_RC), WSP(bf16_t, OFF_RD)}, lds));
      PHASE(job_attn_mla(p, lds));
      PHASE(gemm_job(WSP(bf16_t, OFF_RF), 1024, WSP(bf16_t, OFF_WOA + (size_t)ia * SZ_WSQ), 1024, T, 1024, 1024, false, EpiF32{WSP(float, OFF_Y), 1024, 1024, nullptr}, lds));
      PHASE(job_ln1(p, layer));
    } else if (kind == 1) {
      PHASE(gemm_job(WSP(bf16_t, OFF_WIN), 1024, WSP(bf16_t, OFF_H), 1024, 3072, T, 1024, false, EpiZT{WSP(bf16_t, OFF_RA), T, p.in[16]}, lds));
      PHASE(job_hyena(p, 0, lds));
      PHASE(job_transpose_y(p, lds));
      PHASE(gemm_job(WSP(bf16_t, OFF_RC), 1024, WSP(bf16_t, OFF_WOUT), 1024, T, 1024, 1024, false, EpiF32{WSP(float, OFF_Y), 1024, 1024, p.in[28]}, lds));
      PHASE(job_ln1(p, layer));
    } else {
      PHASE(gemm_job(WSP(bf16_t, OFF_H), 1024, WSP(bf16_t, OFF_WQKV), 1024, T, 1536, 1024, false, EpiF32{WSP(float, OFF_RA), 1536, 1536, nullptr}, lds));
      PHASE(job_gqa_norm(p));
      PHASE(job_attn_gqa(p, lds));
      PHASE(gemm_job(WSP(bf16_t, OFF_RF), 1024, WSP(bf16_t, OFF_WOC), 1024, T, 1024, 1024, false, EpiF32{WSP(float, OFF_Y), 1024, 1024, nullptr}, lds));
      PHASE(job_ln1(p, layer));
    }
    PHASE(gemm_job(WSP(bf16_t, OFF_H), 1024, WSP(bf16_t, OFF_WQ + (size_t)layer * SZ_WQ), 1024, T, 2048, 1024, false, EpiBf16{WSP(bf16_t, OFF_RB), 2048}, lds));
    PHASE(gemm_job(WSP(bf16_t, OFF_RB), 2048, WSP(bf16_t, OFF_KEYS) + (size_t)layer * 16 * 16384, 128, T, 2048, 128, true, EpiF32{WSP(float, OFF_RA), 2048, 2048, nullptr}, lds));
    PHASE(job_topk(p));
    PHASE(job_peer_gather(p, layer));
  }
#undef PHASE
}


#ifndef CUT_PHASE
#define CUT_PHASE NPHASES
#endif
#ifndef DUMP_OFF
#define DUMP_OFF OFF_RB
#endif
__global__ void __launch_bounds__(NTHR) dump_x(const Params p) {
  const size_t n4 = (size_t)NBATCH * SEQ * 256;
  for (size_t i = (size_t)blockIdx.x * NTHR + threadIdx.x; i < n4; i += (size_t)gridDim.x * NTHR)
    *(float4*)(p.out + i * 4) = *(const float4*)(WSP(float, DUMP_OFF) + i * 4);
}
extern "C" void kernel_launch(void* const* d_in, const int* in_sizes, int n_in, void* d_out, int out_size, void* d_ws, size_t ws_size, hipStream_t stream) {
  static int grid_blocks = 0;
  if (!grid_blocks) {
    int dev = 0, cus = 0, per_cu = 0;
    (void)hipGetDevice(&dev);
    (void)hipDeviceGetAttribute(&cus, hipDeviceAttributeMultiprocessorCount, dev);
    if (hipFuncSetAttribute((const void*)mega, hipFuncAttributeMaxDynamicSharedMemorySize, LDS_BYTES) != hipSuccess) fprintf(stderr, "kernel_launch: hipFuncSetAttribute failed\n");
    (void)hipOccupancyMaxActiveBlocksPerMultiprocessor(&per_cu, mega, NTHR, LDS_BYTES);
    if (per_cu < 1) { fprintf(stderr, "kernel_launch: occupancy query returned %d\n", per_cu); per_cu = 1; }
    if (per_cu > 1) per_cu = 1;
    grid_blocks = cus * per_cu;
  }
  if (n_in != 38 || WS_TOTAL > ws_size) { fprintf(stderr, "kernel_launch: bad call: n_in %d, workspace need %zu have %zu\n", n_in, (size_t)WS_TOTAL, ws_size); return; }
  Params p; memset(&p, 0, sizeof(p));
  for (int i = 0; i < 38; ++i) p.in[i] = (const float*)d_in[i];
  p.out = (float*)d_out; p.ws = (char*)d_ws;
#if ONE_LAUNCH
  p.ph_begin = 0; p.ph_end = NPHASES;
  void* args[] = {(void*)&p};
  hipError_t e = hipLaunchCooperativeKernel((const void*)mega, dim3(grid_blocks), dim3(NTHR), args, LDS_BYTES, stream);
  if (e != hipSuccess) fprintf(stderr, "kernel_launch: cooperative launch failed: %s (grid %d)\n", hipGetErrorString(e), grid_blocks);
#else
  for (int ph = 0; ph < CUT_PHASE; ++ph) {
    p.ph_begin = ph; p.ph_end = ph + 1;
    hipLaunchKernelGGL(mega, dim3(grid_blocks), dim3(NTHR), LDS_BYTES, stream, p);
  }
  if (CUT_PHASE < NPHASES) hipLaunchKernelGGL(dump_x, dim3(1024), dim3(NTHR), 0, stream, p);
#endif
}
```

```cpp
#include <hip/hip_runtime.h>
#include <hip/hip_cooperative_groups.h>
#include <cstdio>
#include <cstdint>
#include <cstring>
namespace cg = cooperative_groups;

#ifndef ONE_LAUNCH
#define ONE_LAUNCH 1
#endif
#ifndef R_GEMM
#define R_GEMM 1
#endif
#ifndef R_ATTN
#define R_ATTN 1
#endif
#ifndef R_HYENA
#define R_HYENA 1
#endif
#ifndef R_TOPK
#define R_TOPK 1
#endif
#ifndef R_GATHER
#define R_GATHER 1
#endif
#ifndef R_SYNC
#define R_SYNC 1
#endif
#ifndef R_PRO
#define R_PRO 1
#endif

constexpr int D = 1024, NBATCH = 4, SEQ = 4096, CTXL = 256, RB = 4352, T = 17408, DEPTH = 4;
constexpr float ALPHA = 1.6817928305074290f;
constexpr int NTHR = 512;
constexpr int NPHASES = 41;

typedef unsigned short bf16_t;
using bf16x8 = __attribute__((ext_vector_type(8))) short;
using s16x4  = __attribute__((ext_vector_type(4))) short;
using f32x16 = __attribute__((ext_vector_type(16))) float;
using u32x4  = __attribute__((ext_vector_type(4))) unsigned;
using u32x2  = __attribute__((ext_vector_type(2))) unsigned;

typedef __bf16 bf16x2_t __attribute__((ext_vector_type(2)));
typedef float f32x2_t __attribute__((ext_vector_type(2)));
__device__ __forceinline__ unsigned cvtpk(float lo, float hi) { f32x2_t v = {lo, hi}; bf16x2_t b = __builtin_convertvector(v, bf16x2_t); return __builtin_bit_cast(unsigned, b); }
__device__ __forceinline__ bf16_t f2bf(float x) { __bf16 b = (__bf16)x; return __builtin_bit_cast(unsigned short, b); }
__device__ __forceinline__ unsigned cvtpk_asm(float lo, float hi) { unsigned r; asm volatile("v_cvt_pk_bf16_f32 %0, %1, %2" : "=v"(r) : "v"(lo), "v"(hi)); return r; }
__device__ __forceinline__ float bf2f(bf16_t u) { return __uint_as_float(((unsigned)u) << 16); }
__device__ __forceinline__ float bflo(unsigned w) { return __uint_as_float(w << 16); }
__device__ __forceinline__ float bfhi(unsigned w) { return __uint_as_float(w & 0xffff0000u); }
__device__ __forceinline__ int crow(int r, int hi) { return (r & 3) + 8 * (r >> 2) + 4 * hi; }
__device__ __forceinline__ float wsum(float v) {
#pragma unroll
  for (int o = 32; o; o >>= 1) v += __shfl_xor(v, o);
  return v;
}
__device__ __forceinline__ int otid() { int t = threadIdx.x; asm volatile("" : "+v"(t)); return t; }
__device__ __forceinline__ float sin_rev(float rev) { return __builtin_amdgcn_sinf(rev); }
__device__ __forceinline__ float cos_rev(float rev) { return __builtin_amdgcn_cosf(rev); }
__device__ __forceinline__ float sin_rad(float x) { return __builtin_amdgcn_sinf(x * 0.15915494309189535f); }

struct Params { const float* in[38]; float* out; char* ws; int ph_begin, ph_end; };
constexpr size_t al256c(size_t x) { return (x + 255) & ~(size_t)255; }
constexpr size_t SZ_W1 = al256c((size_t)1152 * 1024 * 2), SZ_WUQ = al256c((size_t)1536 * 768 * 2), SZ_WUKV = al256c((size_t)2048 * 256 * 2), SZ_WSQ = al256c((size_t)1024 * 1024 * 2),
                 SZ_WQ = al256c((size_t)2048 * 1024 * 2);
constexpr size_t OFF_BAR  = 0;
constexpr size_t OFF_MODP = 16384;
constexpr size_t OFF_MOD  = OFF_MODP + al256c((size_t)8 * 4 * 5 * 6144 * 4);
constexpr size_t OFF_HDN  = OFF_MOD + al256c((size_t)4 * 5 * 6144 * 4);
constexpr size_t OFF_GLAT = OFF_HDN + al256c((size_t)2 * 4096 * 64 * 4);
constexpr size_t OFF_GCTX = OFF_GLAT + al256c((size_t)2 * 1024 * 8192 * 2);
constexpr size_t OFF_W1   = OFF_GCTX + al256c((size_t)2 * 1024 * 512 * 2);
constexpr size_t OFF_WUQ  = OFF_W1 + 2 * SZ_W1;
constexpr size_t OFF_WUKV = OFF_WUQ + 2 * SZ_WUQ;
constexpr size_t OFF_WOA  = OFF_WUKV + 2 * SZ_WUKV;
constexpr size_t OFF_WIN  = OFF_WOA + 2 * SZ_WSQ;
constexpr size_t OFF_WOUT = OFF_WIN + al256c((size_t)3072 * 1024 * 2);
constexpr size_t OFF_WQKV = OFF_WOUT + SZ_WSQ;
constexpr size_t OFF_WOC  = OFF_WQKV + al256c((size_t)1536 * 1024 * 2);
constexpr size_t OFF_WQ   = OFF_WOC + SZ_WSQ;
constexpr size_t OFF_KEYS = OFF_WQ + 4 * SZ_WQ;
constexpr size_t OFF_PU   = OFF_KEYS + al256c((size_t)4 * 16 * 16384 * 2);
constexpr size_t OFF_PV   = OFF_PU + (size_t)4 * 16384 * 1024;
constexpr size_t OFF_SU   = OFF_PV + (size_t)4 * 16384 * 1024;
constexpr size_t OFF_SV   = OFF_SU + (size_t)4 * 16384 * 4;
constexpr size_t OFF_X    = OFF_SV + (size_t)4 * 16384 * 4;
constexpr size_t OFF_H    = OFF_X + (size_t)T * 1024 * 4;
constexpr size_t OFF_Y    = OFF_H + (size_t)T * 1024 * 2;
constexpr size_t OFF_RA   = OFF_Y + (size_t)T * 1024 * 4;
constexpr size_t OFF_RB   = OFF_RA + (size_t)T * 2048 * 4;
constexpr size_t OFF_RC   = OFF_RB + (size_t)T * 2048 * 2;
constexpr size_t OFF_RD   = OFF_RC + (size_t)T * 1536 * 2;
constexpr size_t OFF_RE   = OFF_RD + (size_t)T * 1024 * 2;
constexpr size_t OFF_RF   = OFF_RE + (size_t)T * 1024 * 2;
constexpr size_t WS_TOTAL = OFF_RF + (size_t)T * 1024 * 2;
#define WSP(type, off) ((type*)(p.ws + (off)))

struct RowInfo { int b, rb, is_ctx, pos, mrow; };
__device__ __forceinline__ RowInfo row_info(int row) {
  RowInfo r; r.b = row / RB; r.rb = row - r.b * RB; r.is_ctx = r.rb < CTXL; r.pos = r.rb - CTXL; r.mrow = r.is_ctx ? 4 : r.b; return r;
}
__device__ __forceinline__ void rope_cs(int pos, int i, int quarter, float& c, float& s) {
  const int j = i < quarter ? i : i - quarter;
  const float inv = exp2f(-13.287712379549449f * (float)j / (float)quarter);
  const float p = (float)(i < quarter ? (pos >> 6) : (pos & 63));
  const float rev = p * inv * 0.15915494309189535f;
  c = cos_rev(rev); s = sin_rev(rev);
}

__device__ __forceinline__ int gswz(int row, int chunk) { return row * 128 + ((chunk ^ ((row >> 1) & 7)) << 4); }
constexpr int G_ASZ = 256 * 128, G_BSZ = 128 * 128;
template <class Epi>
__device__ __forceinline__ void gemm_tile(const bf16_t* __restrict__ A, int lda, const bf16_t* __restrict__ Bt, int ldb, int K, int m0, int n0, int acol0,
                                          const Epi& epi, char* lds) {
  const int tid = otid(), lane = tid & 63, wid = tid >> 6, wm = wid >> 1, wn = wid & 1, r32 = lane & 31, hi = lane >> 5;
  char* As = lds; char* Bs = lds + 2 * G_ASZ;
  f32x16 acc[2][2];
#pragma unroll
  for (int i = 0; i < 2; ++i)
#pragma unroll
    for (int j = 0; j < 2; ++j) acc[i][j] = f32x16{};
  u32x4 ra[4], rb[2];
  const int srow = tid >> 3, sch = tid & 7;
  const bf16_t* Ap = A + (size_t)(m0 + srow) * lda + acol0 + sch * 8;
  const bf16_t* Bp = Bt + (size_t)(n0 + srow) * ldb + sch * 8;
  const int nk = K >> 6;
#define G_LOAD(kt) do { _Pragma("unroll") for (int c_ = 0; c_ < 4; ++c_) ra[c_] = *(const u32x4*)(Ap + (size_t)(c_ * 64) * lda + (kt) * 64); \
                        _Pragma("unroll") for (int c_ = 0; c_ < 2; ++c_) rb[c_] = *(const u32x4*)(Bp + (size_t)(c_ * 64) * ldb + (kt) * 64); } while (0)
#define G_STORE(buf) do { _Pragma("unroll") for (int c_ = 0; c_ < 4; ++c_) *(u32x4*)(As + (buf) * G_ASZ + gswz(srow + c_ * 64, sch)) = ra[c_]; \
                          _Pragma("unroll") for (int c_ = 0; c_ < 2; ++c_) *(u32x4*)(Bs + (buf) * G_BSZ + gswz(srow + c_ * 64, sch)) = rb[c_]; } while (0)
  G_LOAD(0); G_STORE(0); __syncthreads();
  for (int kt = 0; kt < nk; ++kt) {
    if (kt + 1 < nk) G_LOAD(kt + 1);
    const char* Ab = As + (kt & 1) * G_ASZ; const char* Bb = Bs + (kt & 1) * G_BSZ;
#pragma unroll
    for (int ks = 0; ks < 4; ++ks) {
      bf16x8 af[2], bfr[2];
#pragma unroll
      for (int i = 0; i < 2; ++i) af[i] = *(const bf16x8*)(Ab + gswz(wm * 64 + i * 32 + r32, ks * 2 + hi));
#pragma unroll
      for (int j = 0; j < 2; ++j) bfr[j] = *(const bf16x8*)(Bb + gswz(wn * 64 + j * 32 + r32, ks * 2 + hi));
#pragma unroll
      for (int i = 0; i < 2; ++i)
#pragma unroll
        for (int j = 0; j < 2; ++j) acc[i][j] = __builtin_amdgcn_mfma_f32_32x32x16_bf16(af[i], bfr[j], acc[i][j], 0, 0, 0);
    }
    if (kt + 1 < nk) G_STORE((kt + 1) & 1);
    __syncthreads();
  }
#undef G_LOAD
#undef G_STORE
#pragma unroll
  for (int i = 0; i < 2; ++i)
#pragma unroll
    for (int j = 0; j < 2; ++j)
#pragma unroll
      for (int r = 0; r < 16; ++r) epi(m0 + wm * 64 + i * 32 + crow(r, hi), n0 + wn * 64 + j * 32 + r32, acc[i][j][r]);
}
template <class Epi>
__device__ __forceinline__ void gemm_job(const bf16_t* A, int lda, const bf16_t* Bt, int ldb, int M, int N, int K, bool grouped, const Epi& epi, char* lds) {
  const int ntn = N / 128, nt = ntn * (M / 256);
  for (int it = blockIdx.x; it < nt; it += gridDim.x) {
    const int mt = it / ntn, n_t = it - mt * ntn;
    gemm_tile(A, lda, Bt, ldb, K, mt * 256, n_t * 128, grouped ? n_t * 128 : 0, epi, lds);
  }
}
struct EpiF32 { float* C; int ldc, ncols; const float* bias;
  __device__ __forceinline__ void operator()(int row, int col, float v) const { if (col < ncols) C[(size_t)row * ldc + col] = v + (bias ? bias[col] : 0.f); } };
struct EpiBf16 { bf16_t* C; int ldc;
  __device__ __forceinline__ void operator()(int row, int col, float v) const { C[(size_t)row * ldc + col] = f2bf(v); } };
struct EpiZT { bf16_t* C; int ldc; const float* bias_row;
  __device__ __forceinline__ void operator()(int row, int col, float v) const { C[(size_t)row * ldc + col] = f2bf(v + bias_row[row]); } };
struct EpiMlaQ { bf16_t* Q;
  __device__ __forceinline__ void operator()(int row, int col, float v) const {
    const float partner = __shfl_xor(v, 1);
    const int w = col % 192;
    const RowInfo ri = row_info(row);
    float o = v;
    if (w >= 128 && !ri.is_ctx) { float c, s; rope_cs(ri.pos, (w - 128) >> 1, 16, c, s); o = (col & 1) ? (partner * s + v * c) : (v * c - partner * s); }
    Q[(size_t)row * 1536 + col] = f2bf(o);
  } };
struct EpiMlaKV { bf16_t* Kb; bf16_t* Vb;
  __device__ __forceinline__ void operator()(int row, int col, float v) const {
    const int h = col >> 8, w = col & 255;
    if (w < 128) Kb[(size_t)row * 1024 + h * 128 + w] = f2bf(v); else Vb[(size_t)row * 1024 + h * 128 + (w - 128)] = f2bf(v);
  } };

#define SBAR() __builtin_amdgcn_sched_barrier(0)
constexpr float ATT_THR = 8.f;
__device__ __forceinline__ void partialSM(f32x16& p0, f32x16& p1, float& m_reg, float& mn, float& alpha, const float C, const float thr_s) {
  float pmax = p0[0];
#pragma unroll
  for (int r = 1; r < 16; ++r) pmax = fmaxf(pmax, p0[r]);
#pragma unroll
  for (int r = 0; r < 16; ++r) pmax = fmaxf(pmax, p1[r]);
  { auto rr = __builtin_amdgcn_permlane32_swap(__float_as_uint(pmax), __float_as_uint(pmax), false, false);
    pmax = fmaxf(__uint_as_float(rr[0]), __uint_as_float(rr[1])); }
  if (__builtin_expect(__all(pmax - m_reg <= thr_s), 1)) { mn = m_reg; alpha = 1.f; }
  else { mn = fmaxf(m_reg, pmax); alpha = __builtin_amdgcn_exp2f((m_reg - mn) * C); m_reg = mn; }
  const float mnC = -mn * C;
#pragma unroll
  for (int r = 0; r < 16; ++r) p0[r] = fmaf(p0[r], C, mnC);
#pragma unroll
  for (int r = 0; r < 16; ++r) p1[r] = fmaf(p1[r], C, mnC);
#pragma unroll
  for (int r = 0; r < 16; ++r) p0[r] = __builtin_amdgcn_exp2f(p0[r]);
}
__device__ __forceinline__ void finishSM(f32x16& p0, f32x16& p1, float alpha, float& l_reg, bf16x8& pa0, bf16x8& pa1, bf16x8& pa2, bf16x8& pa3) {
#pragma unroll
  for (int r = 0; r < 16; ++r) p1[r] = __builtin_amdgcn_exp2f(p1[r]);
  float ps = 0;
#pragma unroll
  for (int r = 0; r < 16; ++r) ps += p0[r];
#pragma unroll
  for (int r = 0; r < 16; ++r) ps += p1[r];
  { auto rr = __builtin_amdgcn_permlane32_swap(__float_as_uint(ps), __float_as_uint(ps), false, false);
    ps = __uint_as_float(rr[0]) + __uint_as_float(rr[1]); }
  l_reg = l_reg * alpha + ps;
#define PK4(P, BASE, OUT) do { unsigned a0 = cvtpk_asm(P[BASE + 0], P[BASE + 1]), a1 = cvtpk_asm(P[BASE + 2], P[BASE + 3]);   \
    unsigned b0 = cvtpk_asm(P[BASE + 4], P[BASE + 5]), b1 = cvtpk_asm(P[BASE + 6], P[BASE + 7]);                              \
    auto r0 = __builtin_amdgcn_permlane32_swap(a0, b0, false, false); auto r1 = __builtin_amdgcn_permlane32_swap(a1, b1, false, false); \
    u32x4 w = {r0[0], r1[0], r0[1], r1[1]}; OUT = *reinterpret_cast<bf16x8*>(&w); } while (0)
  PK4(p0, 0, pa0); PK4(p0, 8, pa1); PK4(p1, 0, pa2); PK4(p1, 8, pa3);
#undef PK4
}
template <int DQ>
__device__ __forceinline__ void qkt(f32x16& p0, f32x16& p1, const char* Ks, const char* KRs, const bf16x8* qr, int r32, int hi) {
  p0 = f32x16{}; p1 = f32x16{};
  const int sw = (r32 & 7) << 4;
#pragma unroll
  for (int d0 = 0; d0 < 8; ++d0) { const int cb = (d0 * 32 + hi * 16) ^ sw;
    bf16x8 b0 = *reinterpret_cast<const bf16x8*>(Ks + r32 * 256 + cb);
    bf16x8 b1 = *reinterpret_cast<const bf16x8*>(Ks + (32 + r32) * 256 + cb);
    p0 = __builtin_amdgcn_mfma_f32_32x32x16_bf16(b0, qr[d0], p0, 0, 0, 0);
    p1 = __builtin_amdgcn_mfma_f32_32x32x16_bf16(b1, qr[d0], p1, 0, 0, 0); }
  if constexpr (DQ == 192) {
#pragma unroll
    for (int d0 = 0; d0 < 4; ++d0) { const int cb = (d0 * 32 + hi * 16) ^ sw;
      bf16x8 b0 = *reinterpret_cast<const bf16x8*>(KRs + r32 * 128 + cb);
      bf16x8 b1 = *reinterpret_cast<const bf16x8*>(KRs + (32 + r32) * 128 + cb);
      p0 = __builtin_amdgcn_mfma_f32_32x32x16_bf16(b0, qr[8 + d0], p0, 0, 0, 0);
      p1 = __builtin_amdgcn_mfma_f32_32x32x16_bf16(b1, qr[8 + d0], p1, 0, 0, 0); }
  }
}
__device__ __forceinline__ int v_st(int k, int c) { const int kk = (k & ~0xC) | ((k & 4) << 1) | ((k & 8) >> 1); return ((kk >> 3) * 4 + (c >> 5)) * 512 + ((kk & 7) * 32 + (c & 31)) * 2; }
__device__ __forceinline__ int v_rd_base(int lane) { return ((lane & 3) << 3) | (((lane >> 2) & 3) << 6) | (((lane >> 4) & 1) << 5) | (((lane >> 5) & 1) << 8); }
constexpr int v_rd_off(int d0, int ks, int half) { return d0 * 512 + ks * 4096 + half * 2048; }
template <int OFF> __device__ __forceinline__ s16x4 tr_read(int vb) {
  s16x4 r; asm volatile("ds_read_b64_tr_b16 %0, %1 offset:%2" : "=&v"(r) : "v"(vb), "i"(OFF) : "memory"); return r;
}
template <int D0> __device__ __forceinline__ void pv_one(f32x16& od, int vb, bf16x8 pa0, bf16x8 pa1, bf16x8 pa2, bf16x8 pa3) {
  const s16x4 l0 = tr_read<v_rd_off(D0, 0, 0)>(vb), h0 = tr_read<v_rd_off(D0, 0, 1)>(vb), l1 = tr_read<v_rd_off(D0, 1, 0)>(vb), h1 = tr_read<v_rd_off(D0, 1, 1)>(vb);
  const s16x4 l2 = tr_read<v_rd_off(D0, 2, 0)>(vb), h2 = tr_read<v_rd_off(D0, 2, 1)>(vb), l3 = tr_read<v_rd_off(D0, 3, 0)>(vb), h3 = tr_read<v_rd_off(D0, 3, 1)>(vb);
  asm volatile("s_waitcnt lgkmcnt(0)" ::: "memory"); SBAR();
#define PKV(L, H) (bf16x8){L[0], L[1], L[2], L[3], H[0], H[1], H[2], H[3]}
  od = __builtin_amdgcn_mfma_f32_32x32x16_bf16(pa0, PKV(l0, h0), od, 0, 0, 0);
  od = __builtin_amdgcn_mfma_f32_32x32x16_bf16(pa1, PKV(l1, h1), od, 0, 0, 0);
  od = __builtin_amdgcn_mfma_f32_32x32x16_bf16(pa2, PKV(l2, h2), od, 0, 0, 0);
  od = __builtin_amdgcn_mfma_f32_32x32x16_bf16(pa3, PKV(l3, h3), od, 0, 0, 0);
#undef PKV
}
__device__ __forceinline__ void pv_d0(f32x16* o, int vb, bf16x8 pa0, bf16x8 pa1, bf16x8 pa2, bf16x8 pa3) {
  pv_one<0>(o[0], vb, pa0, pa1, pa2, pa3); pv_one<1>(o[1], vb, pa0, pa1, pa2, pa3); pv_one<2>(o[2], vb, pa0, pa1, pa2, pa3); pv_one<3>(o[3], vb, pa0, pa1, pa2, pa3);
}
constexpr int ATT_LDS = 2 * 16384 + 2 * 16384 + 2 * 8192 + 2048;
template <int DQ, int LDQ, int LDK, int LDKR, int LDV, int LDO, int SDEPTH>
__device__ __forceinline__ void attn_body(const bf16_t* __restrict__ Qb, const bf16_t* __restrict__ Kh, const bf16_t* __restrict__ Krh, const bf16_t* __restrict__ Vh,
                                          bf16_t* __restrict__ Ob, int seq, char* lds) {
  constexpr int SHM_V = 16384, SHM_K = 16384, SHM_KR = 8192;
  constexpr bool ROPE = DQ == 192;
  constexpr float scale = ROPE ? 0.07216878364870322f : 0.08838834764831845f;
  constexpr float C = scale * 1.4426950408889634f, thr_s = ATT_THR / scale;
  const int tid = otid();
  const int wid = tid >> 6, lane = tid & 63, r32 = lane & 31, hi = lane >> 5;
  char* V_lds = lds; char* K_lds = lds + 2 * SHM_V; char* KR_lds = K_lds + 2 * SHM_K;
  float* ws = (float*)(KR_lds + 2 * SHM_KR) + wid * 64; float* li_l = ws; float* al_l = ws + 32;
  float m_reg = -1e30f, l_reg = 0; f32x16 o[4] = {}; bf16x8 qr[DQ / 16];
  const bf16_t* Qw = Qb + (long)(wid * 32 + r32) * LDQ + hi * 8;
#pragma unroll
  for (int d0 = 0; d0 < DQ / 16; ++d0) qr[d0] = *reinterpret_cast<const bf16x8*>(Qw + d0 * 16);
  const int sr = tid >> 4, sc = tid & 15;
  const unsigned voffK = (unsigned)(sr * LDK + sc * 8) * 2u, voffV = (unsigned)(sr * LDV + sc * 8) * 2u, voffKR = (unsigned)((tid >> 3) * LDKR + (tid & 7) * 8) * 2u;
  const int kst0 = sr * 256 + ((sc * 16) ^ ((sr & 7) << 4)), vst0 = v_st(sr, sc * 8), vst1 = v_st(32 + sr, sc * 8);
  const int krst = (tid >> 3) * 128 + (((tid & 7) * 16) ^ (((tid >> 3) & 7) << 4));
  const int vb0 = (int)(uintptr_t)V_lds + v_rd_base(lane);
  struct { bf16x8 v0, v1, k0, k1, kr; } sr_[SDEPTH];
#define SLOAD(i, kk) do { const char* vb_ = (const char*)Vh + (size_t)(kk) * (LDV * 2); const char* kb_ = (const char*)Kh + (size_t)(kk) * (LDK * 2); \
    sr_[i].v0 = *reinterpret_cast<const bf16x8*>(vb_ + voffV); sr_[i].v1 = *reinterpret_cast<const bf16x8*>(vb_ + voffV + 32 * LDV * 2); \
    sr_[i].k0 = *reinterpret_cast<const bf16x8*>(kb_ + voffK); sr_[i].k1 = *reinterpret_cast<const bf16x8*>(kb_ + voffK + 32 * LDK * 2); \
    if constexpr (ROPE) sr_[i].kr = *reinterpret_cast<const bf16x8*>((const char*)Krh + (size_t)(kk) * (LDKR * 2) + voffKR); } while (0)
#define SWRITE(b, i) do { *(bf16x8*)(V_lds + (b) * SHM_V + vst0) = sr_[i].v0; *(bf16x8*)(V_lds + (b) * SHM_V + vst1) = sr_[i].v1; \
    *(bf16x8*)(K_lds + (b) * SHM_K + kst0) = sr_[i].k0; *(bf16x8*)(K_lds + (b) * SHM_K + kst0 + 8192) = sr_[i].k1; \
    if constexpr (ROPE) *(bf16x8*)(KR_lds + (b) * SHM_KR + krst) = sr_[i].kr; } while (0)
#define SWAIT() do { if constexpr (SDEPTH == 2) { if constexpr (ROPE) asm volatile("s_waitcnt vmcnt(5)" ::: "memory"); else asm volatile("s_waitcnt vmcnt(4)" ::: "memory"); } \
    else asm volatile("s_waitcnt vmcnt(0)" ::: "memory"); } while (0)
#define RESC(a) do { if (__any((a) < 1.f)) { if (hi == 0) al_l[r32] = (a); asm volatile("s_waitcnt lgkmcnt(0)" ::: "memory"); \
    _Pragma("unroll") for (int d = 0; d < 4; ++d) _Pragma("unroll") for (int r = 0; r < 16; ++r) o[d][r] *= al_l[crow(r, hi)]; } } while (0)
  f32x16 pA0, pA1, pB0, pB1; float mnA, mnB, alA, alB; bf16x8 pa0, pa1, pa2, pa3; const int NT = seq / 64;
  constexpr int SE = 0, SO = SDEPTH - 1;
  SLOAD(SE, 0); asm volatile("s_waitcnt vmcnt(0)" ::: "memory"); SWRITE(0, SE); __syncthreads();
  qkt<DQ>(pA0, pA1, K_lds, KR_lds, qr, r32, hi); partialSM(pA0, pA1, m_reg, mnA, alA, C, thr_s);
  SLOAD(SO, 64); if constexpr (SDEPTH == 2) { if (2 < NT) SLOAD(SE, 2 * 64); }
  SWAIT(); SWRITE(1, SO); __syncthreads();
  for (int j = 1; j + 1 < NT; j += 2) {
    SBAR(); qkt<DQ>(pB0, pB1, K_lds + SHM_K, KR_lds + SHM_KR, qr, r32, hi);
    finishSM(pA0, pA1, alA, l_reg, pa0, pa1, pa2, pa3); SBAR();
    SLOAD(SO, (j + SDEPTH) * 64); SBAR();
    pv_d0(o, vb0, pa0, pa1, pa2, pa3); partialSM(pB0, pB1, m_reg, mnB, alB, C, thr_s);
    __syncthreads(); SWAIT(); SWRITE(0, SE);
    RESC(alB); __syncthreads();
    SBAR(); qkt<DQ>(pA0, pA1, K_lds, KR_lds, qr, r32, hi);
    finishSM(pB0, pB1, alB, l_reg, pa0, pa1, pa2, pa3); SBAR();
    if (SDEPTH == 1 || j + 3 < NT) SLOAD(SE, (j + 1 + SDEPTH) * 64); SBAR();
    pv_d0(o, vb0 + SHM_V, pa0, pa1, pa2, pa3); partialSM(pA0, pA1, m_reg, mnA, alA, C, thr_s);
    __syncthreads(); SWAIT(); SWRITE(1, SO);
    RESC(alA); __syncthreads();
  }
  SBAR(); qkt<DQ>(pB0, pB1, K_lds + SHM_K, KR_lds + SHM_KR, qr, r32, hi);
  finishSM(pA0, pA1, alA, l_reg, pa0, pa1, pa2, pa3); SBAR();
  pv_d0(o, vb0, pa0, pa1, pa2, pa3); partialSM(pB0, pB1, m_reg, mnB, alB, C, thr_s);
  __syncthreads(); RESC(alB);
  finishSM(pB0, pB1, alB, l_reg, pa0, pa1, pa2, pa3); SBAR();
  pv_d0(o, vb0 + SHM_V, pa0, pa1, pa2, pa3);
  if (hi == 0) li_l[r32] = l_reg; asm volatile("s_waitcnt lgkmcnt(0)" ::: "memory");
  bf16_t* Ow = Ob + (long)(wid * 32) * LDO + r32;
#pragma unroll
  for (int r = 0; r < 16; ++r) { const int orow = crow(r, hi); const float rl = __builtin_amdgcn_rcpf(li_l[orow]);
#pragma unroll
    for (int d0 = 0; d0 < 4; ++d0) Ow[(long)orow * LDO + d0 * 32] = f2bf(o[d0][r] * rl); }
#undef SLOAD
#undef SWRITE
#undef SWAIT
#undef RESC
  __syncthreads();
}

__device__ __forceinline__ void ln_row_finish(float (&r)[16], int cA, int cB, const float* lnw, const float* lnb, float* Xrow, bf16_t* Hrow, const float* sh, const float* sc, float* orow) {
  float s = 0.f;
#pragma unroll
  for (int i = 0; i < 16; ++i) s += r[i];
  const float mean = wsum(s) * (1.f / 1024.f);
  float q = 0.f;
#pragma unroll
  for (int i = 0; i < 16; ++i) { r[i] -= mean; q += r[i] * r[i]; }
  const float rstd = rsqrtf(wsum(q) * (1.f / 1024.f) + 1e-5f);
#pragma unroll
  for (int hf = 0; hf < 2; ++hf) {
    const int c0 = hf ? cB : cA;
    float xn[8];
#pragma unroll
    for (int i = 0; i < 8; ++i) xn[i] = r[hf * 8 + i] * rstd * lnw[c0 + i] + lnb[c0 + i];
    *(float4*)(Xrow + c0) = make_float4(xn[0], xn[1], xn[2], xn[3]); *(float4*)(Xrow + c0 + 4) = make_float4(xn[4], xn[5], xn[6], xn[7]);
    if (orow) { *(float4*)(orow + c0) = make_float4(xn[0], xn[1], xn[2], xn[3]); *(float4*)(orow + c0 + 4) = make_float4(xn[4], xn[5], xn[6], xn[7]); }
    if (Hrow) {
      float hv[8];
#pragma unroll
      for (int i = 0; i < 8; ++i) hv[i] = xn[i] * (1.f + sc[c0 + i]) + sh[c0 + i];
      u32x4 w = {cvtpk(hv[0], hv[1]), cvtpk(hv[2], hv[3]), cvtpk(hv[4], hv[5]), cvtpk(hv[6], hv[7])};
      *(u32x4*)(Hrow + c0) = w;
    }
  }
}

struct WDesc { const float* src; bf16_t* dst; int K, N, Npad; };
constexpr int wd_tiles_of(int K, int Npad) { return (K / 64) * (Npad / 64); }
constexpr int WT_MLA = wd_tiles_of(1024, 768) + wd_tiles_of(1024, 384) + wd_tiles_of(768, 1536) + wd_tiles_of(256, 2048) + wd_tiles_of(1024, 1024);
constexpr int WT_HY = wd_tiles_of(1024, 3072) + wd_tiles_of(1024, 1024), WT_GQA = wd_tiles_of(1024, 1536) + wd_tiles_of(1024, 1024), WT_PQ = wd_tiles_of(1024, 2048);
constexpr int WD_TILES = 2 * WT_MLA + WT_HY + WT_GQA + 4 * WT_PQ;
__device__ __forceinline__ void job_wconv(const Params& p, char* lds) {
  float* tile = (float*)lds;
  const int tid = otid();
  for (int it = blockIdx.x; it < WD_TILES; it += gridDim.x) {
    WDesc w; int lt = it;
    if (lt < 2 * WT_MLA) {
      const int i = lt / WT_MLA; lt -= i * WT_MLA;
      if (lt < wd_tiles_of(1024, 768)) w = WDesc{p.in[8] + (size_t)i * 1024 * 768, WSP(bf16_t, OFF_W1 + (size_t)i * SZ_W1), 1024, 768, 768};
      else if ((lt -= wd_tiles_of(1024, 768)) < wd_tiles_of(1024, 384)) w = WDesc{p.in[11] + (size_t)i * 1024 * 320, WSP(bf16_t, OFF_W1 + (size_t)i * SZ_W1) + (size_t)768 * 1024, 1024, 320, 384};
      else if ((lt -= wd_tiles_of(1024, 384)) < wd_tiles_of(768, 1536)) w = WDesc{p.in[10] + (size_t)i * 768 * 1536, WSP(bf16_t, OFF_WUQ + (size_t)i * SZ_WUQ), 768, 1536, 1536};
      else if ((lt -= wd_tiles_of(768, 1536)) < wd_tiles_of(256, 2048)) w = WDesc{p.in[13] + (size_t)i * 256 * 2048, WSP(bf16_t, OFF_WUKV + (size_t)i * SZ_WUKV), 256, 2048, 2048};
      else { lt -= wd_tiles_of(256, 2048); w = WDesc{p.in[14] + (size_t)i * 1024 * 1024, WSP(bf16_t, OFF_WOA + (size_t)i * SZ_WSQ), 1024, 1024, 1024}; }
    } else if ((lt -= 2 * WT_MLA) < WT_HY) {
      if (lt < wd_tiles_of(1024, 3072)) w = WDesc{p.in[15], WSP(bf16_t, OFF_WIN), 1024, 3072, 3072};
      else { lt -= wd_tiles_of(1024, 3072); w = WDesc{p.in[27], WSP(bf16_t, OFF_WOUT), 1024, 1024, 1024}; }
    } else if ((lt -= WT_HY) < WT_GQA) {
      if (lt < wd_tiles_of(1024, 1536)) w = WDesc{p.in[29], WSP(bf16_t, OFF_WQKV), 1024, 1536, 1536};
      else { lt -= wd_tiles_of(1024, 1536); w = WDesc{p.in[32], WSP(bf16_t, OFF_WOC), 1024, 1024, 1024}; }
    } else {
      lt -= WT_GQA; const int l = lt / WT_PQ; lt -= l * WT_PQ;
      w = WDesc{p.in[33] + (size_t)l * 1024 * 2048, WSP(bf16_t, OFF_WQ + (size_t)l * SZ_WQ), 1024, 2048, 2048};
    }
    const int tn = w.Npad / 64, kt = lt / tn, nt = lt - kt * tn, k0 = kt * 64, n0 = nt * 64;
    for (int e = tid; e < 4096; e += NTHR) { const int k = e >> 6, n = e & 63; tile[k * 65 + n] = (n0 + n < w.N) ? w.src[(size_t)(k0 + k) * w.N + n0 + n] : 0.f; }
    __syncthreads();
    for (int e = tid; e < 4096; e += NTHR) { const int n = e >> 6, k = e & 63; w.dst[(size_t)(n0 + n) * w.K + k0 + k] = f2bf(tile[k * 65 + n]); }
    __syncthreads();
  }
}
__device__ __forceinline__ void job_peer_conv(const Params& p) {
  const int tid = otid();
  const size_t gt = (size_t)blockIdx.x * NTHR + tid, gs = (size_t)gridDim.x * NTHR;
  const size_t nk8 = (size_t)4 * 16 * 16384 / 8;
  for (size_t i = gt; i < nk8; i += gs) {
    const size_t e = i * 8; const int blk = (int)(e >> 14), off = (int)(e & 16383); const int l = blk >> 4, h = (blk >> 1) & 7, side = blk & 1;
    const float* src = (side ? p.in[35] : p.in[34]) + ((size_t)(l * 8 + h) << 14) + off;
    const float4 a = *(const float4*)src, b = *(const float4*)(src + 4);
    u32x4 w = {cvtpk(a.x, a.y), cvtpk(a.z, a.w), cvtpk(b.x, b.y), cvtpk(b.z, b.w)};
    *(u32x4*)(WSP(bf16_t, OFF_KEYS) + e) = w;
  }
  const int lane = tid & 63, wg = blockIdx.x * 8 + (tid >> 6), nw = gridDim.x * 8;
  for (int r = wg; r < 2 * 4 * 16384; r += nw) {
    const int isv = r >= 4 * 16384, row = isv ? r - 4 * 16384 : r;
    const float* src = (isv ? p.in[37] : p.in[36]) + (size_t)row * 1024 + lane * 16;
    float4 x[4]; float am = 0.f;
#pragma unroll
    for (int j = 0; j < 4; ++j) { x[j] = *(const float4*)(src + 4 * j); am = fmaxf(am, fmaxf(fmaxf(fabsf(x[j].x), fabsf(x[j].y)), fmaxf(fabsf(x[j].z), fabsf(x[j].w)))); }
#pragma unroll
    for (int o = 32; o; o >>= 1) am = fmaxf(am, __shfl_xor(am, o));
    int e = (int)((__float_as_uint(am) >> 23) & 255u) - 127; e = e < -100 ? -100 : (e > 100 ? 100 : e);
    const int k = 7 - e;
    const float sc = __uint_as_float((unsigned)(k + 127) << 23), isc = __uint_as_float((unsigned)(127 - k) << 23);
    u32x4 w;
#pragma unroll
    for (int j = 0; j < 4; ++j) { int q = 0; q = __builtin_amdgcn_cvt_pk_fp8_f32(x[j].x * sc, x[j].y * sc, q, false); q = __builtin_amdgcn_cvt_pk_fp8_f32(x[j].z * sc, x[j].w * sc, q, true); w[j] = (unsigned)q; }
    *(u32x4*)((isv ? WSP(unsigned char, OFF_PV) : WSP(unsigned char, OFF_PU)) + (size_t)row * 1024 + lane * 16) = w;
    if (lane == 0) (isv ? WSP(float, OFF_SV) : WSP(float, OFF_SU))[row] = isc;
  }
}
__device__ __forceinline__ void job_adaln_partial(const Params& p, char* lds) {
  float* sl = (float*)lds;
  float* red = (float*)lds + 1024;
  const int tid = otid();
  for (int it = blockIdx.x; it < 768; it += gridDim.x) {
    const int l = it / 192, rem = it - l * 192, cgp = rem >> 3, ks = rem & 7;
    for (int e = tid; e < 640; e += NTHR) { const int r = e >> 7, k = e & 127; const float v = (r < 4) ? p.in[1][r * 1024 + ks * 128 + k] : p.in[3][ks * 128 + k]; sl[e] = v / (1.f + __expf(-v)); }
    __syncthreads();
    const int cq = tid & 63, kg = tid >> 6;
    float4 acc[5];
#pragma unroll
    for (int r = 0; r < 5; ++r) acc[r] = make_float4(0.f, 0.f, 0.f, 0.f);
    for (int i = 0; i < 16; ++i) {
      const int k = kg * 16 + i;
      const float4 w = *(const float4*)(p.in[4] + ((size_t)l * 1024 + ks * 128 + k) * 6144 + cgp * 256 + cq * 4);
#pragma unroll
      for (int r = 0; r < 5; ++r) { const float sv = sl[r * 128 + k]; acc[r].x += sv * w.x; acc[r].y += sv * w.y; acc[r].z += sv * w.z; acc[r].w += sv * w.w; }
    }
#pragma unroll
    for (int r = 0; r < 5; ++r) *(float4*)(red + (kg * 5 + r) * 256 + cq * 4) = acc[r];
    __syncthreads();
    for (int e = tid; e < 1280; e += NTHR) {
      const int r = e >> 8, col = e & 255; float s = 0.f;
#pragma unroll
      for (int g = 0; g < 8; ++g) s += red[(g * 5 + r) * 256 + col];
      WSP(float, OFF_MODP)[((size_t)(ks * 4 + l) * 5 + r) * 6144 + cgp * 256 + col] = s;
    }
    __syncthreads();
  }
}
__device__ __forceinline__ void job_hdn(const Params& p, char* lds) {
  float* h1s = (float*)lds;
  const int tid = otid(), tl = tid >> 6, r = tid & 63;
  for (int it = blockIdx.x; it < 544; it += gridDim.x) {
    const int s = it < 512 ? 0 : 1, chunk = it - s * 512, L = s ? 256 : 4096, tau = chunk * 8 + tl;
    float a1 = p.in[20][r] + ((float)tau / (float)(L - 1)) * p.in[19][r];
#pragma unroll 4
    for (int k = 0; k < 16; ++k) {
      const float f = 1e-4f + (float)k * ((15.f - 1e-4f) / 15.f);
      const float rev = f * (float)tau / (float)L;
      a1 += cos_rev(rev) * p.in[19][(1 + k) * 64 + r] - sin_rev(rev) * p.in[19][(17 + k) * 64 + r];
    }
    h1s[tl * 64 + r] = sin_rad(p.in[21][r] * a1);
    __syncthreads();
    float a2 = p.in[23][r];
    for (int q = 0; q < 64; ++q) a2 += h1s[tl * 64 + q] * p.in[22][q * 64 + r];
    WSP(float, OFF_HDN)[((size_t)s * 4096 + tau) * 64 + r] = sin_rad(p.in[24][r] * a2);
    __syncthreads();
  }
}
__device__ __forceinline__ void job_mod_final(const Params& p) {
  for (int e = blockIdx.x * NTHR + otid(); e < 4 * 5 * 6144; e += gridDim.x * NTHR) {
    const int l = e / 30720, rem = e - l * 30720, col = rem % 6144;
    float s = p.in[5][l * 6144 + col];
#pragma unroll
    for (int ks = 0; ks < 8; ++ks) s += WSP(float, OFF_MODP)[(size_t)ks * 4 * 30720 + e];
    WSP(float, OFF_MOD)[e] = s;
  }
}
__device__ __forceinline__ void job_gbuild(const Params& p, char* lds) {
  float* hd = (float*)lds;
  const int tid = otid();
  for (int it = blockIdx.x; it < 1024 + 64; it += gridDim.x) {
    const int s = it < 1024 ? 0 : 1, li = it - s * 1024, L = s ? 256 : 4096, tt = li >> 3, ct = li & 7;
    const int col = ct * 512 + tid, o = col >> 11, dir = (col >> 10) & 1, d = col & 1023;
    float w3c[64];
#pragma unroll
    for (int r = 0; r < 64; ++r) w3c[r] = p.in[25][r * 4096 + col];
    for (int e = tid; e < 2048; e += NTHR) hd[e] = WSP(float, OFF_HDN)[((size_t)s * 4096 + tt * 32) * 64 + e];
    __syncthreads();
    const float delta = 3.0701134573253945f + 12.280453829301578f * ((float)d / 1023.f);
    const float bias_o = p.in[26][o * 1024 + d];
    bf16_t* Gp = (s ? WSP(bf16_t, OFF_GCTX) : WSP(bf16_t, OFF_GLAT)) + (size_t)(o * 1024 + d) * (2 * L);
    for (int j = 0; j < 32; ++j) {
      const int tau = tt * 32 + j;
      float f = 0.f;
#pragma unroll
      for (int r = 0; r < 64; ++r) f += hd[j * 64 + r] * w3c[r];
      const float t01 = (float)tau / (float)(L - 1);
      float val = f * (__expf(-t01 * delta) + 0.05f);
      int xi;
      if (dir == 0) { if (tau == 0) val += bias_o; xi = L + tau; }
      else { if (tau == 0) { val = 0.f; xi = 0; } else xi = L - tau; }
      Gp[xi] = f2bf(val);
    }
    __syncthreads();
  }
}
__device__ __forceinline__ void job_init(const Params& p) {
  const size_t n4 = (size_t)T * 256;
  for (size_t i = (size_t)blockIdx.x * NTHR + otid(); i < n4; i += (size_t)gridDim.x * NTHR) {
    const int row = (int)(i >> 8), c = (int)(i & 255) * 4;
    const RowInfo ri = row_info(row);
    const float* src = ri.is_ctx ? p.in[2] + ((size_t)(ri.b * CTXL + ri.rb) * 1024 + c) : p.in[0] + ((size_t)(ri.b * SEQ + ri.pos) * 1024 + c);
    const float4 v = *(const float4*)src;
    *(float4*)(WSP(float, OFF_X) + (size_t)row * 1024 + c) = v;
    const float* md = WSP(float, OFF_MOD) + (size_t)ri.mrow * 6144;
    const float4 sh = *(const float4*)(md + c), sc = *(const float4*)(md + 1024 + c);
    u32x2 w = {cvtpk(v.x * (1.f + sc.x) + sh.x, v.y * (1.f + sc.y) + sh.y), cvtpk(v.z * (1.f + sc.z) + sh.z, v.w * (1.f + sc.w) + sh.w)};
    *(u32x2*)(WSP(bf16_t, OFF_H) + (size_t)row * 1024 + c) = w;
  }
}
__device__ __forceinline__ void job_mla_norm(const Params& p, int ia) {
  const int lane = otid() & 63, wg = blockIdx.x * 8 + (otid() >> 6), nw = gridDim.x * 8;
  const float* C1 = WSP(float, OFF_RA); bf16_t* CQN = WSP(bf16_t, OFF_RE); bf16_t* CKVN = WSP(bf16_t, OFF_RE) + (size_t)T * 768; bf16_t* KPE = WSP(bf16_t, OFF_RC) + (size_t)T * 1024;
  const float* qn = p.in[9] + ia * 768; const float* kn = p.in[12] + ia * 256;
  for (int row = wg; row < T; row += nw) {
    const float* cr = C1 + (size_t)row * 1152;
    float4 v[3]; float ss = 0.f;
#pragma unroll
    for (int j = 0; j < 3; ++j) { v[j] = *(const float4*)(cr + (j * 64 + lane) * 4); ss += v[j].x * v[j].x + v[j].y * v[j].y + v[j].z * v[j].z + v[j].w * v[j].w; }
    const float rq = rsqrtf(wsum(ss) * (1.f / 768.f) + 1e-6f);
#pragma unroll
    for (int j = 0; j < 3; ++j) { const int c = (j * 64 + lane) * 4; const float4 g = *(const float4*)(qn + c);
      u32x2 w = {cvtpk(v[j].x * rq * g.x, v[j].y * rq * g.y), cvtpk(v[j].z * rq * g.z, v[j].w * rq * g.w)}; *(u32x2*)(CQN + (size_t)row * 768 + c) = w; }
    const float4 kv = *(const float4*)(cr + 768 + lane * 4);
    const float rk = rsqrtf(wsum(kv.x * kv.x + kv.y * kv.y + kv.z * kv.z + kv.w * kv.w) * (1.f / 256.f) + 1e-6f);
    { const float4 g = *(const float4*)(kn + lane * 4);
      u32x2 w = {cvtpk(kv.x * rk * g.x, kv.y * rk * g.y), cvtpk(kv.z * rk * g.z, kv.w * rk * g.w)}; *(u32x2*)(CKVN + (size_t)row * 256 + lane * 4) = w; }
    if (lane < 32) {
      const float2 xp = *(const float2*)(cr + 1024 + 2 * lane);
      const RowInfo ri = row_info(row);
      float o0 = xp.x, o1 = xp.y;
      if (!ri.is_ctx) { float c, s; rope_cs(ri.pos, lane, 16, c, s); o0 = xp.x * c - xp.y * s; o1 = xp.x * s + xp.y * c; }
      *(unsigned*)(KPE + (size_t)row * 64 + 2 * lane) = cvtpk(o0, o1);
    }
  }
}
__device__ __forceinline__ void job_gqa_norm(const Params& p) {
  const int lane = otid() & 63, wg = blockIdx.x * 8 + (otid() >> 6), nw = gridDim.x * 8;
  const float* QKV = WSP(float, OFF_RA); bf16_t* Qb = WSP(bf16_t, OFF_RB); bf16_t* Kb = WSP(bf16_t, OFF_RC); bf16_t* Vb = WSP(bf16_t, OFF_RD);
  for (int row = wg; row < T; row += nw) {
    const float* cr = QKV + (size_t)row * 1536;
    const RowInfo ri = row_info(row);
    float rc = 1.f, rs = 0.f;
    if (!ri.is_ctx) rope_cs(ri.pos, lane, 32, rc, rs);
#pragma unroll 2
    for (int hh = 0; hh < 10; ++hh) {
      const float2 xp = *(const float2*)(cr + hh * 128 + 2 * lane);
      const float rinv = rsqrtf(wsum(xp.x * xp.x + xp.y * xp.y) * (1.f / 128.f) + 1e-6f);
      const float2 g = *(const float2*)((hh < 8 ? p.in[30] : p.in[31]) + 2 * lane);
      const float x0 = xp.x * rinv * g.x, x1 = xp.y * rinv * g.y;
      const unsigned w = cvtpk(x0 * rc - x1 * rs, x0 * rs + x1 * rc);
      if (hh < 8) *(unsigned*)(Qb + (size_t)row * 1024 + hh * 128 + 2 * lane) = w; else *(unsigned*)(Kb + (size_t)row * 256 + (hh - 8) * 128 + 2 * lane) = w;
    }
    const float4 v = *(const float4*)(cr + 1280 + lane * 4);
    u32x2 w = {cvtpk(v.x, v.y), cvtpk(v.z, v.w)}; *(u32x2*)(Vb + (size_t)row * 256 + lane * 4) = w;
  }
}
__device__ __forceinline__ void job_ln1(const Params& p, int layer) {
  const int lane = otid() & 63, wg = blockIdx.x * 8 + (otid() >> 6), nw = gridDim.x * 8;
  const float* lnw = p.in[6] + (size_t)(layer * 2) * 1024; const float* lnb = p.in[7] + (size_t)(layer * 2) * 1024;
  for (int row = wg; row < T; row += nw) {
    const RowInfo ri = row_info(row);
    const float* md = WSP(float, OFF_MOD) + ((size_t)layer * 5 + ri.mrow) * 6144;
    float* Xr = WSP(float, OFF_X) + (size_t)row * 1024; const float* Yr = WSP(float, OFF_Y) + (size_t)row * 1024;
    float r[16];
#pragma unroll
    for (int hf = 0; hf < 2; ++hf) { const int c0 = hf * 512 + lane * 8;
#pragma unroll
      for (int q = 0; q < 2; ++q) { const float4 xv = *(const float4*)(Xr + c0 + q * 4), yv = *(const float4*)(Yr + c0 + q * 4), gv = *(const float4*)(md + 2048 + c0 + q * 4);
        r[hf * 8 + q * 4 + 0] = ALPHA * xv.x + gv.x * yv.x; r[hf * 8 + q * 4 + 1] = ALPHA * xv.y + gv.y * yv.y; r[hf * 8 + q * 4 + 2] = ALPHA * xv.z + gv.z * yv.z; r[hf * 8 + q * 4 + 3] = ALPHA * xv.w + gv.w * yv.w; } }
    ln_row_finish(r, lane * 8, 512 + lane * 8, lnw, lnb, Xr, WSP(bf16_t, OFF_H) + (size_t)row * 1024, md + 3072, md + 4096, nullptr);
  }
}
__device__ __forceinline__ void job_attn_mla(const Params& p, char* lds) {
  const bf16_t* Qb = WSP(bf16_t, OFF_RB); const bf16_t* Kb = WSP(bf16_t, OFF_RC); const bf16_t* KPE = WSP(bf16_t, OFF_RC) + (size_t)T * 1024; const bf16_t* Vb = WSP(bf16_t, OFF_RD); bf16_t* AO = WSP(bf16_t, OFF_RF);
  for (int it = blockIdx.x; it < 544; it += gridDim.x) {
    int b, h, q0, seq;
    if (it < 512) { b = it >> 7; h = (it >> 4) & 7; q0 = b * RB + CTXL + (it & 15) * 256; seq = RB; } else { const int j = it - 512; b = j >> 3; h = j & 7; q0 = b * RB; seq = CTXL; }
    attn_body<192, 1536, 1024, 64, 1024, 1024, 1>(Qb + (size_t)q0 * 1536 + h * 192, Kb + (size_t)b * RB * 1024 + h * 128, KPE + (size_t)b * RB * 64, Vb + (size_t)b * RB * 1024 + h * 128,
                                                   AO + (size_t)q0 * 1024 + h * 128, seq, lds);
  }
}
__device__ __forceinline__ void job_attn_gqa(const Params& p, char* lds) {
  const bf16_t* Qb = WSP(bf16_t, OFF_RB); const bf16_t* Kb = WSP(bf16_t, OFF_RC); const bf16_t* Vb = WSP(bf16_t, OFF_RD); bf16_t* AO = WSP(bf16_t, OFF_RF);
  for (int it = blockIdx.x; it < 544; it += gridDim.x) {
    int b, h, q0, seq;
    if (it < 512) { b = it >> 7; h = (it >> 4) & 7; q0 = b * RB + CTXL + (it & 15) * 256; seq = RB; } else { const int j = it - 512; b = j >> 3; h = j & 7; q0 = b * RB; seq = CTXL; }
    attn_body<128, 1024, 256, 64, 256, 1024, 1>(Qb + (size_t)q0 * 1024 + h * 128, Kb + (size_t)b * RB * 256 + (h >> 2) * 128, nullptr, Vb + (size_t)b * RB * 256 + (h >> 2) * 128,
                                                 AO + (size_t)q0 * 1024 + h * 128, seq, lds);
  }
}
constexpr int HY_FCN = 8336, HY_VEN = 78 * 64;
constexpr int HY_LDS = 4 * HY_FCN * 2 + 2 * 4 * HY_VEN * 2;
__device__ __forceinline__ float hy_short(const bf16_t* zr, int t, int L, float w0, float w1, float w2, float cb) {
  float v = cb + w1 * bf2f(zr[t]);
  if (t > 0) v += w0 * bf2f(zr[t - 1]);
  if (t + 1 < L) v += w2 * bf2f(zr[t + 1]);
  return v;
}
__device__ __forceinline__ void hy_fill_seq(const Params& p, bf16_t* dst, int ch, int L, int nb, int seq0) {
  const bf16_t* ZT = WSP(bf16_t, OFF_RA);
  const float w0 = p.in[17][ch], w1 = p.in[17][3072 + ch], w2 = p.in[17][6144 + ch], cb = p.in[18][ch];
  const int cpb = (nb + 14) * 8;
  for (int e = otid(); e < 4 * cpb; e += NTHR) {
    const int b = e / cpb, ci = e - b * cpb, t0 = ci * 8 - 7 * 64;
    u32x4 w = {0u, 0u, 0u, 0u};
    if (t0 >= 0 && t0 < L) {
      const bf16_t* zr = ZT + (size_t)ch * T + b * RB + seq0;
      const u32x4 zc = *(const u32x4*)(zr + t0);
      float z[10];
      z[0] = t0 > 0 ? bf2f(zr[t0 - 1]) : 0.f; z[9] = (t0 + 8 < L) ? bf2f(zr[t0 + 8]) : 0.f;
      z[1] = bflo(zc[0]); z[2] = bfhi(zc[0]); z[3] = bflo(zc[1]); z[4] = bfhi(zc[1]); z[5] = bflo(zc[2]); z[6] = bfhi(zc[2]); z[7] = bflo(zc[3]); z[8] = bfhi(zc[3]);
      float o[8];
#pragma unroll
      for (int i = 0; i < 8; ++i) o[i] = cb + w0 * z[i] + w1 * z[i + 1] + w2 * z[i + 2];
      w = (u32x4){cvtpk(o[0], o[1]), cvtpk(o[2], o[3]), cvtpk(o[4], o[5]), cvtpk(o[6], o[7])};
    }
    *(u32x4*)(dst + (size_t)b * HY_VEN + ci * 8) = w;
  }
}
__device__ __forceinline__ void hy_fill_filter(bf16_t* FC, const bf16_t* Gp, int L) {
  const int OFF = L + 64, nch = (2 * L + 144) / 8;
  for (int e = otid(); e < 4 * nch; e += NTHR) {
    const int s = e / nch, u0 = (e - s * nch) * 8;
    unsigned short v[8];
#pragma unroll
    for (int i = 0; i < 8; ++i) { const int z = u0 + i - s - OFF; v[i] = (z > -L && z < L) ? Gp[L - z] : (unsigned short)0; }
    u32x4 w = {(unsigned)v[0] | ((unsigned)v[1] << 16), (unsigned)v[2] | ((unsigned)v[3] << 16), (unsigned)v[4] | ((unsigned)v[5] << 16), (unsigned)v[6] | ((unsigned)v[7] << 16)};
    *(u32x4*)(FC + (size_t)s * HY_FCN + u0) = w;
  }
}
__device__ __forceinline__ void hy_conv(f32x16 (&acc)[2], const bf16_t* FC, const bf16_t* SRC, int nb, int q, int r32, int hi) {
  acc[0] = f32x16{}; acc[1] = f32x16{};
  const int OFFL = nb * 64 + 64, s = r32 & 3, al = r32 >> 2, bb = r32 & 3;
  const int mlo = 8 * q - (nb - 1), mhi = (8 * q + 7 < nb - 1) ? 8 * q + 7 : nb - 1;
  const bf16_t* fbase = FC + (size_t)s * HY_FCN + (8 * hi - r32 + OFFL + s);
  const bf16_t* vbase = SRC + (size_t)bb * HY_VEN + (8 * q + al + 7) * 64 + 8 * hi;
  for (int m = mlo; m <= mhi; ++m) {
#pragma unroll
    for (int ks = 0; ks < 4; ++ks) {
      const bf16x8 bv = *(const bf16x8*)(vbase - m * 64 + ks * 16);
#pragma unroll
      for (int it = 0; it < 2; ++it) {
        const bf16_t* fp = fbase + ks * 16 - it * 32 - 64 * m;
        const s16x4 lo = *(const s16x4*)fp, hh = *(const s16x4*)(fp + 4);
        const bf16x8 av = {lo[0], lo[1], lo[2], lo[3], hh[0], hh[1], hh[2], hh[3]};
        acc[it] = __builtin_amdgcn_mfma_f32_32x32x16_bf16(av, bv, acc[it], 0, 0, 0);
      }
    }
  }
}
__device__ __forceinline__ void job_hyena(const Params& p, int ib, char* lds) {
  bf16_t* FC = (bf16_t*)lds; bf16_t* VE = FC + 4 * HY_FCN; bf16_t* ZE = VE + 4 * HY_VEN;
  bf16_t* YT = WSP(bf16_t, OFF_RB);
  const int tid = otid(), lane = tid & 63, q = tid >> 6, r32 = lane & 31, hi = lane >> 5;
  for (int it = blockIdx.x; it < 2048; it += gridDim.x) {
    const int s = it < 1024 ? 0 : 1, d = it & 1023, L = s ? 256 : 4096, nb = L >> 6, seq0 = s ? 0 : CTXL;
    const bf16_t* G0 = (s ? WSP(bf16_t, OFF_GCTX) : WSP(bf16_t, OFF_GLAT)) + (size_t)d * (2 * L); const bf16_t* G1 = G0 + (size_t)1024 * (2 * L);
    hy_fill_seq(p, VE, 2048 + d, L, nb, seq0);
    hy_fill_seq(p, ZE, d, L, nb, seq0);
    hy_fill_filter(FC, G0, L);
    __syncthreads();
    const bool active = 8 * q < nb;
    f32x16 acc[2];
    if (active) {
      hy_conv(acc, FC, VE, nb, q, r32, hi);
      const int a = 8 * q + (r32 >> 2), bb = r32 & 3;
      if (a < nb) {
#pragma unroll
        for (int i2 = 0; i2 < 2; ++i2)
#pragma unroll
          for (int r = 0; r < 16; ++r) { bf16_t* zp = ZE + (size_t)bb * HY_VEN + (a + 7) * 64 + i2 * 32 + crow(r, hi); *zp = f2bf(bf2f(*zp) * acc[i2][r]); }
      }
    }
    __syncthreads();
    hy_fill_seq(p, VE, 1024 + d, L, nb, seq0);
    hy_fill_filter(FC, G1, L);
    __syncthreads();
    if (active) {
      hy_conv(acc, FC, ZE, nb, q, r32, hi);
      const int a = 8 * q + (r32 >> 2), bb = r32 & 3;
      if (a < nb) {
#pragma unroll
        for (int i2 = 0; i2 < 2; ++i2)
#pragma unroll
          for (int r = 0; r < 16; ++r) { bf16_t* vp = VE + (size_t)bb * HY_VEN + (a + 7) * 64 + i2 * 32 + crow(r, hi); *vp = f2bf(bf2f(*vp) * acc[i2][r]); }
      }
    }
    __syncthreads();
    for (int e = tid; e < 4 * (L / 8); e += NTHR) {
      const int b = e / (L / 8), t0 = (e - b * (L / 8)) * 8;
      *(u32x4*)(YT + (size_t)d * T + b * RB + seq0 + t0) = *(const u32x4*)(VE + (size_t)b * HY_VEN + 7 * 64 + t0);
    }
    __syncthreads();
  }
}
__device__ __forceinline__ void job_transpose_y(const Params& p, char* lds) {
  bf16_t* tile = (bf16_t*)lds;
  const bf16_t* YT = WSP(bf16_t, OFF_RB); bf16_t* Ytr = WSP(bf16_t, OFF_RC);
  const int tid = otid();
  for (int it = blockIdx.x; it < 16 * 272; it += gridDim.x) {
    const int dt = it / 272, tt = it - dt * 272, d0 = dt * 64, t0 = tt * 64;
    for (int e = tid; e < 4096; e += NTHR) { const int dr = e >> 6, tc = e & 63; tile[dr * 66 + tc] = YT[(size_t)(d0 + dr) * T + t0 + tc]; }
    __syncthreads();
    for (int e = tid; e < 4096; e += NTHR) { const int tr = e >> 6, dc = e & 63; Ytr[(size_t)(t0 + tr) * 1024 + d0 + dc] = tile[dc * 66 + tr]; }
    __syncthreads();
  }
}
__device__ __forceinline__ void ins16(float (&L)[16], float x) {
#pragma unroll
  for (int i = 0; i < 16; ++i) { const float hi = __builtin_fmaxf(L[i], x); x = __builtin_fminf(L[i], x); L[i] = hi; }
}
__device__ __forceinline__ void job_topk(const Params& p) {
  const float* S = WSP(float, OFF_RA);
  const float NEG = -3.0e38f;
  for (int item = blockIdx.x * NTHR + otid(); item < T * 8; item += gridDim.x * NTHR) {
    const float* s1 = S + (size_t)item * 256;
    float L1[16], L2[16], L3[16];
#pragma unroll
    for (int i = 0; i < 16; ++i) { L1[i] = NEG; L2[i] = NEG; L3[i] = NEG; }
#pragma unroll 1
    for (int c = 0; c < 32; ++c) {
      const float4 v = *(const float4*)(s1 + c * 4);
      ins16(L1, __uint_as_float((__float_as_uint(v.x) & ~127u) | (unsigned)(c * 4 + 0)));
      ins16(L1, __uint_as_float((__float_as_uint(v.y) & ~127u) | (unsigned)(c * 4 + 1)));
      ins16(L1, __uint_as_float((__float_as_uint(v.z) & ~127u) | (unsigned)(c * 4 + 2)));
      ins16(L1, __uint_as_float((__float_as_uint(v.w) & ~127u) | (unsigned)(c * 4 + 3)));
    }
#pragma unroll 1
    for (int c = 0; c < 32; ++c) {
      const float4 v = *(const float4*)(s1 + 128 + c * 4);
      ins16(L2, __uint_as_float((__float_as_uint(v.x) & ~127u) | (unsigned)(c * 4 + 0)));
      ins16(L2, __uint_as_float((__float_as_uint(v.y) & ~127u) | (unsigned)(c * 4 + 1)));
      ins16(L2, __uint_as_float((__float_as_uint(v.z) & ~127u) | (unsigned)(c * 4 + 2)));
      ins16(L2, __uint_as_float((__float_as_uint(v.w) & ~127u) | (unsigned)(c * 4 + 3)));
    }
#pragma unroll
    for (int i = 0; i < 16; ++i)
#pragma unroll
      for (int j = 0; j < 16; ++j)
        if ((i + 1) * (j + 1) <= 16) {
          const float sum = __uint_as_float(__float_as_uint(L1[i]) & ~127u) + __uint_as_float(__float_as_uint(L2[j]) & ~127u);
          ins16(L3, __uint_as_float((__float_as_uint(sum) & ~255u) | (unsigned)(i * 16 + j)));
        }
    float ev[16]; float den = 0.f;
    const float mx = __uint_as_float(__float_as_uint(L3[0]) & ~255u);
#pragma unroll
    for (int k = 0; k < 16; ++k) { ev[k] = __expf(__uint_as_float(__float_as_uint(L3[k]) & ~255u) - mx); den += ev[k]; }
    const float rden = 1.f / den;
    int* ip = WSP(int, OFF_RC) + (size_t)item * 16; float* gp = WSP(float, OFF_RC + (size_t)T * 128 * 4) + (size_t)item * 16;
#pragma unroll
    for (int k = 0; k < 16; ++k) {
      const unsigned code = __float_as_uint(L3[k]) & 255u; const int ii = code >> 4, jj = code & 15;
      unsigned b1 = 0, b2 = 0;
#pragma unroll
      for (int i = 0; i < 16; ++i) { b1 = (ii == i) ? __float_as_uint(L1[i]) : b1; b2 = (jj == i) ? __float_as_uint(L2[i]) : b2; }
      ip[k] = (int)((b1 & 127u) * 128u + (b2 & 127u));
      gp[k] = ev[k] * rden;
    }
  }
}
__device__ __forceinline__ void job_peer_gather(const Params& p, int layer) {
  const int lane = otid() & 63, wg = blockIdx.x * 8 + (otid() >> 6), nw = gridDim.x * 8;
  const unsigned char* U = WSP(unsigned char, OFF_PU) + (size_t)layer * 16384 * 1024; const unsigned char* V = WSP(unsigned char, OFF_PV) + (size_t)layer * 16384 * 1024;
  const float* SU = WSP(float, OFF_SU) + layer * 16384; const float* SV = WSP(float, OFF_SV) + layer * 16384;
  const float* lnw = p.in[6] + (size_t)(layer * 2 + 1) * 1024; const float* lnb = p.in[7] + (size_t)(layer * 2 + 1) * 1024;
  const bool last = layer == DEPTH - 1;
  for (int row = wg; row < T; row += nw) {
    const RowInfo ri = row_info(row);
    float hv[16];
    { const u32x4 a = *(const u32x4*)(WSP(bf16_t, OFF_H) + (size_t)row * 1024 + lane * 16), b = *(const u32x4*)(WSP(bf16_t, OFF_H) + (size_t)row * 1024 + lane * 16 + 8);
#pragma unroll
      for (int i = 0; i < 4; ++i) { hv[2 * i] = bflo(a[i]); hv[2 * i + 1] = bfhi(a[i]); hv[8 + 2 * i] = bflo(b[i]); hv[8 + 2 * i + 1] = bfhi(b[i]); } }
    float out[16];
    const int myidx0 = WSP(int, OFF_RC)[(size_t)row * 128 + lane], myidx1 = WSP(int, OFF_RC)[(size_t)row * 128 + 64 + lane];
    const float mysu0 = SU[myidx0], mysu1 = SU[myidx1];
    const float mygv0 = WSP(float, OFF_RC + (size_t)T * 128 * 4)[(size_t)row * 128 + lane] * SV[myidx0], mygv1 = WSP(float, OFF_RC + (size_t)T * 128 * 4)[(size_t)row * 128 + 64 + lane] * SV[myidx1];
#pragma unroll 1
    for (int rep_ = 0; rep_ < R_GATHER; ++rep_) {
#pragma unroll
    for (int i = 0; i < 16; ++i) out[i] = 0.f;
#pragma unroll 1
    for (int e0 = 0; e0 < 128; e0 += 8) {
      u32x4 uq[8], vq[8]; float su[8], gv[8];
#pragma unroll
      for (int qq = 0; qq < 8; ++qq) {
        const int e = e0 + qq;
        const int id = __builtin_amdgcn_readlane(e0 < 64 ? myidx0 : myidx1, e & 63);
        su[qq] = __uint_as_float(__builtin_amdgcn_readlane(__float_as_uint(e0 < 64 ? mysu0 : mysu1), e & 63));
        gv[qq] = __uint_as_float(__builtin_amdgcn_readlane(__float_as_uint(e0 < 64 ? mygv0 : mygv1), e & 63));
        uq[qq] = *(const u32x4*)(U + (size_t)id * 1024 + lane * 16); vq[qq] = *(const u32x4*)(V + (size_t)id * 1024 + lane * 16);
      }
#pragma unroll
      for (int qq = 0; qq < 8; ++qq) {
        float dsum = 0.f;
#pragma unroll
        for (int i = 0; i < 4; ++i) { const f32x2_t lo = __builtin_amdgcn_cvt_pk_f32_fp8((int)uq[qq][i], false), hi = __builtin_amdgcn_cvt_pk_f32_fp8((int)uq[qq][i], true);
          dsum += hv[4 * i] * lo[0] + hv[4 * i + 1] * lo[1]; dsum += hv[4 * i + 2] * hi[0] + hv[4 * i + 3] * hi[1]; }
        dsum = wsum(dsum) * su[qq];
        const float act = 0.5f * dsum * (1.f + erff(dsum * 0.7071067811865476f));
        const float cf = gv[qq] * act;
#pragma unroll
        for (int i = 0; i < 4; ++i) { const f32x2_t lo = __builtin_amdgcn_cvt_pk_f32_fp8((int)vq[qq][i], false), hi = __builtin_amdgcn_cvt_pk_f32_fp8((int)vq[qq][i], true);
          out[4 * i] += cf * lo[0]; out[4 * i + 1] += cf * lo[1]; out[4 * i + 2] += cf * hi[0]; out[4 * i + 3] += cf * hi[1]; }
      }
    }
    }
    const float* md = WSP(float, OFF_MOD) + ((size_t)layer * 5 + ri.mrow) * 6144;
    float* Xr = WSP(float, OFF_X) + (size_t)row * 1024;
    float r[16];
    { const int c0 = lane * 16;
#pragma unroll
      for (int i = 0; i < 16; ++i) r[i] = ALPHA * Xr[c0 + i] + md[5120 + c0 + i] * out[i]; }
    const float* mdn = WSP(float, OFF_MOD) + ((size_t)(last ? layer : layer + 1) * 5 + ri.mrow) * 6144;
    float* orow = (last && !ri.is_ctx) ? p.out + ((size_t)(ri.b * SEQ + ri.pos)) * 1024 : nullptr;
    ln_row_finish(r, lane * 16, lane * 16 + 8, lnw, lnb, Xr, last ? nullptr : WSP(bf16_t, OFF_H) + (size_t)row * 1024, mdn, mdn + 1024, orow);
  }
}

#define XB_TMO      128
#define XB_XCNT(j)  (256  + 64 * (j))
#define XB_XSUB(j)  (1280 + 64 * (j))
#define XB_XGEN(j)  (2304 + 64 * (j))
#define XB_TOP      3328
#define XB_TOPGEN   3392
#define XCD_BAR_WORDS 3456
#define XB_SPIN_CAP (1u << 22)
#define LAS __attribute__((address_space(3)))
__device__ __forceinline__ unsigned xb_ld(unsigned* p)              { return __hip_atomic_load(p, __ATOMIC_RELAXED, __HIP_MEMORY_SCOPE_AGENT); }
__device__ __forceinline__ unsigned xb_add(unsigned* p, unsigned v) { return __hip_atomic_fetch_add(p, v, __ATOMIC_RELAXED, __HIP_MEMORY_SCOPE_AGENT); }
__device__ __forceinline__ unsigned xb_xcc_id() { return (unsigned)__builtin_amdgcn_s_getreg((3 << 11) | 20) & 0xFu; }
#define XB_SPIN(cond, bar) do { unsigned _sp = 0; while (cond) { __builtin_amdgcn_s_sleep(1); \
    if ((++_sp & 255u) == 0u) { if (xb_ld(&(bar)[XB_TMO])) break; if (_sp > XB_SPIN_CAP) { atomicAdd(&(bar)[XB_TMO], 1u); break; } } } } while (0)
struct XcdBarrier { unsigned* bar; unsigned x; volatile LAS unsigned* st; };
__device__ __forceinline__ XcdBarrier xcd_barrier_post(unsigned* bar, volatile LAS unsigned* st) {
  XcdBarrier b; b.bar = bar; b.x = xb_xcc_id(); b.st = st;
  if (threadIdx.x == 0) (void)xb_add(&bar[XB_XCNT(b.x)], 1u);
  return b;
}
__device__ __forceinline__ void xcd_barrier_complete(unsigned* bar, unsigned x, unsigned& nloc, unsigned& nx) {
  const unsigned G = gridDim.x * gridDim.y * gridDim.z;
  unsigned sum, cnt, mine, sp = 0u;
  for (;;) {
    sum = 0u; cnt = 0u; mine = 0u;
#pragma unroll
    for (unsigned j = 0; j < 16; ++j) { const unsigned c = xb_ld(&bar[XB_XCNT(j)]); sum += c; cnt += (c > 0u) ? 1u : 0u; mine = (j == x) ? c : mine; }
    if (sum == G) break;
    __builtin_amdgcn_s_sleep(1);
    if ((++sp & 255u) == 0u) { if (xb_ld(&bar[XB_TMO])) break; if (sp > XB_SPIN_CAP) { atomicAdd(&bar[XB_TMO], 1u); break; } }
  }
  nloc = mine > 0u ? mine : 1u; nx = cnt > 0u ? cnt : 1u;
}
__device__ __forceinline__ void xcd_barrier(const XcdBarrier& b) {
  asm volatile("s_waitcnt vmcnt(0)" ::: "memory");
  __syncthreads();
  if (threadIdx.x == 0) {
    unsigned* bar = b.bar;
    __builtin_amdgcn_s_waitcnt(0);
    unsigned nloc = b.st[0], nx = b.st[1];
    if (nloc == 0u) { xcd_barrier_complete(bar, b.x, nloc, nx); b.st[0] = nloc; b.st[1] = nx; }
    const unsigned old = xb_add(&bar[XB_XSUB(b.x)], 1u);
    const unsigned gen = old / nloc;
    if (old + 1u == (gen + 1u) * nloc) {
      __builtin_amdgcn_fence(__ATOMIC_RELEASE, "agent");
      asm volatile("s_waitcnt vmcnt(0)" ::: "memory");
      const unsigned og = xb_add(&bar[XB_TOP], 1u);
      const unsigned tg = og / nx;
      if (og + 1u == (tg + 1u) * nx) xb_add(&bar[XB_TOPGEN], 1u);
      else XB_SPIN(xb_ld(&bar[XB_TOPGEN]) == tg, bar);
      __builtin_amdgcn_fence(__ATOMIC_ACQUIRE, "agent");
      xb_add(&bar[XB_XGEN(b.x)], 1u);
      asm volatile("s_waitcnt vmcnt(0)" ::: "memory");
    } else {
      XB_SPIN(xb_ld(&bar[XB_XGEN(b.x)]) == gen, bar);
      __builtin_amdgcn_fence(__ATOMIC_ACQUIRE, "agent");
      asm volatile("s_waitcnt vmcnt(0)" ::: "memory");
    }
  }
  __syncthreads();
}

constexpr int PARAM_LDS = 512;
constexpr int LDS_BYTES = PARAM_LDS + HY_LDS;
static_assert(HY_LDS >= ATT_LDS && HY_LDS >= 2 * G_ASZ + 2 * G_BSZ, "LDS budget");
static_assert(sizeof(Params) <= PARAM_LDS && sizeof(Params) == 41 * 8, "Params layout");
__device__ __forceinline__ Params load_params(const char* lds) {
  int off = 0; asm volatile("" : "+v"(off));
  const unsigned* lp = (const unsigned*)(lds + off);
  Params p;
#pragma unroll
  for (int k = 0; k < 38; ++k) {
    const unsigned lo = __builtin_amdgcn_readfirstlane(lp[2 * k]), hi = __builtin_amdgcn_readfirstlane(lp[2 * k + 1]);
    p.in[k] = (const float*)(((unsigned long long)hi << 32) | lo);
  }
  { const unsigned lo = __builtin_amdgcn_readfirstlane(lp[76]), hi = __builtin_amdgcn_readfirstlane(lp[77]); p.out = (float*)(((unsigned long long)hi << 32) | lo); }
  { const unsigned lo = __builtin_amdgcn_readfirstlane(lp[78]), hi = __builtin_amdgcn_readfirstlane(lp[79]); p.ws = (char*)(((unsigned long long)hi << 32) | lo); }
  p.ph_begin = 0; p.ph_end = 0;
  return p;
}
__global__ void __launch_bounds__(NTHR) mega(const Params kp) {
  extern __shared__ __attribute__((aligned(16))) char lds_all[];
  cg::grid_group grid = cg::this_grid();
  if (threadIdx.x == 0) {
    unsigned long long* lp = (unsigned long long*)lds_all;
#pragma unroll
    for (int k = 0; k < 38; ++k) lp[k] = (unsigned long long)kp.in[k];
    lp[38] = (unsigned long long)kp.out; lp[39] = (unsigned long long)kp.ws;
  }
  if (threadIdx.x == 0) { volatile LAS unsigned* st0 = (volatile LAS unsigned*)(lds_all + 384); st0[0] = 0u; st0[1] = 0u; st0[2] = 0u; st0[3] = 0u; }
  __syncthreads();
  char* lds = lds_all + PARAM_LDS;
  const int ph_begin = kp.ph_begin, ph_end = kp.ph_end;
  (void)xcd_barrier_post((unsigned*)(kp.ws + OFF_BAR), (volatile LAS unsigned*)(lds_all + 384));
  int ph = 0;
#define PHASER(reps, ...) do { if (ph >= ph_begin && ph < ph_end) { const Params p = load_params(lds_all); for (int rep_ = 0; rep_ < (reps); ++rep_) { __VA_ARGS__; } \
    if (ph + 1 < ph_end) { for (int rs_ = 0; rs_ < R_SYNC; ++rs_) { if (ph == 0) grid.sync(); else xcd_barrier(XcdBarrier{(unsigned*)(p.ws + OFF_BAR), xb_xcc_id(), (volatile LAS unsigned*)(lds_all + 384)}); } } } ++ph; } while (0)
#define PHASE(...) PHASER(1, __VA_ARGS__)
  PHASER(R_PRO, job_wconv(p, lds); job_adaln_partial(p, lds); job_hdn(p, lds); job_peer_conv(p));
  PHASER(R_PRO, job_mod_final(p); job_gbuild(p, lds));
  PHASER(R_PRO, job_init(p));
#pragma unroll 1
  for (int layer = 0; layer < DEPTH; ++layer) {
    const int kind = layer % 3;
    if (kind == 0) {
      const int ia = layer / 3;
      PHASER(R_GEMM, gemm_job(WSP(bf16_t, OFF_H), 1024, WSP(bf16_t, OFF_W1 + (size_t)ia * SZ_W1), 1024, T, 1152, 1024, false, EpiF32{WSP(float, OFF_RA), 1152, 1152, nullptr}, lds));
      PHASE(job_mla_norm(p, ia));
      PHASER(R_GEMM, gemm_job(WSP(bf16_t, OFF_RE), 768, WSP(bf16_t, OFF_WUQ + (size_t)ia * SZ_WUQ), 768, T, 1536, 768, false, EpiMlaQ{WSP(bf16_t, OFF_RB)}, lds);
            gemm_job(WSP(bf16_t, OFF_RE) + (size_t)T * 768, 256, WSP(bf16_t, OFF_WUKV + (size_t)ia * SZ_WUKV), 256, T, 2048, 256, false, EpiMlaKV{WSP(bf16_t, OFF_RC), WSP(bf16_t, OFF_RD)}, lds));
      PHASER(R_ATTN, job_attn_mla(p, lds));
      PHASER(R_GEMM, gemm_job(WSP(bf16_t, OFF_RF), 1024, WSP(bf16_t, OFF_WOA + (size_t)ia * SZ_WSQ), 1024, T, 1024, 1024, false, EpiF32{WSP(float, OFF_Y), 1024, 1024, nullptr}, lds));
      PHASE(job_ln1(p, layer));
    } else if (kind == 1) {
      PHASER(R_GEMM, gemm_job(WSP(bf16_t, OFF_WIN), 1024, WSP(bf16_t, OFF_H), 1024, 3072, T, 1024, false, EpiZT{WSP(bf16_t, OFF_RA), T, p.in[16]}, lds));
      PHASER(R_HYENA, job_hyena(p, 0, lds));
      PHASE(job_transpose_y(p, lds));
      PHASER(R_GEMM, gemm_job(WSP(bf16_t, OFF_RC), 1024, WSP(bf16_t, OFF_WOUT), 1024, T, 1024, 1024, false, EpiF32{WSP(float, OFF_Y), 1024, 1024, p.in[28]}, lds));
      PHASE(job_ln1(p, layer));
    } else {
      PHASER(R_GEMM, gemm_job(WSP(bf16_t, OFF_H), 1024, WSP(bf16_t, OFF_WQKV), 1024, T, 1536, 1024, false, EpiF32{WSP(float, OFF_RA), 1536, 1536, nullptr}, lds));
      PHASE(job_gqa_norm(p));
      PHASER(R_ATTN, job_attn_gqa(p, lds));
      PHASER(R_GEMM, gemm_job(WSP(bf16_t, OFF_RF), 1024, WSP(bf16_t, OFF_WOC), 1024, T, 1024, 1024, false, EpiF32{WSP(float, OFF_Y), 1024, 1024, nullptr}, lds));
      PHASE(job_ln1(p, layer));
    }
    PHASER(R_GEMM, gemm_job(WSP(bf16_t, OFF_H), 1024, WSP(bf16_t, OFF_WQ + (size_t)layer * SZ_WQ), 1024, T, 2048, 1024, false, EpiBf16{WSP(bf16_t, OFF_RB), 2048}, lds));
    PHASER(R_GEMM, gemm_job(WSP(bf16_t, OFF_RB), 2048, WSP(bf16_t, OFF_KEYS) + (size_t)layer * 16 * 16384, 128, T, 2048, 128, true, EpiF32{WSP(float, OFF_RA), 2048, 2048, nullptr}, lds));
    PHASER(R_TOPK, job_topk(p));
    PHASE(job_peer_gather(p, layer));
  }
#undef PHASE
#undef PHASER
}


#ifndef CUT_PHASE
#define CUT_PHASE NPHASES
#endif
#ifndef DUMP_OFF
#define DUMP_OFF OFF_RB
#endif
__global__ void __launch_bounds__(NTHR) dump_x(const Params p) {
  const size_t n4 = (size_t)NBATCH * SEQ * 256;
  for (size_t i = (size_t)blockIdx.x * NTHR + threadIdx.x; i < n4; i += (size_t)gridDim.x * NTHR)
    *(float4*)(p.out + i * 4) = *(const float4*)(WSP(float, DUMP_OFF) + i * 4);
}
extern "C" void kernel_launch(void* const* d_in, const int* in_sizes, int n_in, void* d_out, int out_size, void* d_ws, size_t ws_size, hipStream_t stream) {
  static int grid_blocks = 0;
  if (!grid_blocks) {
    int dev = 0, cus = 0, per_cu = 0;
    (void)hipGetDevice(&dev);
    (void)hipDeviceGetAttribute(&cus, hipDeviceAttributeMultiprocessorCount, dev);
    if (hipFuncSetAttribute((const void*)mega, hipFuncAttributeMaxDynamicSharedMemorySize, LDS_BYTES) != hipSuccess) fprintf(stderr, "kernel_launch: hipFuncSetAttribute failed\n");
    (void)hipOccupancyMaxActiveBlocksPerMultiprocessor(&per_cu, mega, NTHR, LDS_BYTES);
    if (per_cu < 1) { fprintf(stderr, "kernel_launch: occupancy query returned %d\n", per_cu); per_cu = 1; }
    if (per_cu > 1) per_cu = 1;
    grid_blocks = cus * per_cu;
  }
  if (n_in != 38 || WS_TOTAL > ws_size) { fprintf(stderr, "kernel_launch: bad call: n_in %d, workspace need %zu have %zu\n", n_in, (size_t)WS_TOTAL, ws_size); return; }
  Params p; memset(&p, 0, sizeof(p));
  for (int i = 0; i < 38; ++i) p.in[i] = (const float*)d_in[i];
  p.out = (float*)d_out; p.ws = (char*)d_ws;
  (void)hipMemsetAsync((char*)d_ws + OFF_BAR, 0, 16384, stream);
#if ONE_LAUNCH
  p.ph_begin = 0; p.ph_end = NPHASES;
  void* args[] = {(void*)&p};
  hipError_t e = hipLaunchCooperativeKernel((const void*)mega, dim3(grid_blocks), dim3(NTHR), args, LDS_BYTES, stream);
  if (e != hipSuccess) fprintf(stderr, "kernel_launch: cooperative launch failed: %s (grid %d)\n", hipGetErrorString(e), grid_blocks);
#else
  for (int ph = 0; ph < CUT_PHASE; ++ph) {
    p.ph_begin = ph; p.ph_end = ph + 1;
    hipLaunchKernelGGL(mega, dim3(grid_blocks), dim3(NTHR), LDS_BYTES, stream, p);
  }
  if (CUT_PHASE < NPHASES) hipLaunchKernelGGL(dump_x, dim3(1024), dim3(NTHR), 0, stream, p);
#endif
}
```

```cpp
#include <hip/hip_runtime.h>
#include <hip/hip_cooperative_groups.h>
#include <cstdio>
#include <cstdint>
#include <cstring>
namespace cg = cooperative_groups;

#ifndef ONE_LAUNCH
#define ONE_LAUNCH 1
#endif
#ifndef R_GEMM
#define R_GEMM 1
#endif
#ifndef R_ATTN
#define R_ATTN 1
#endif
#ifndef R_HYENA
#define R_HYENA 1
#endif
#ifndef R_TOPK
#define R_TOPK 1
#endif
#ifndef R_GATHER
#define R_GATHER 1
#endif
#ifndef R_SYNC
#define R_SYNC 1
#endif
#ifndef R_PRO
#define R_PRO 1
#endif

constexpr int D = 1024, NBATCH = 4, SEQ = 4096, CTXL = 256, RB = 4352, T = 17408, DEPTH = 4;
constexpr float ALPHA = 1.6817928305074290f;
constexpr int NTHR = 512;
constexpr int NPHASES = 41;

typedef unsigned short bf16_t;
using bf16x8 = __attribute__((ext_vector_type(8))) short;
using s16x4  = __attribute__((ext_vector_type(4))) short;
using f32x16 = __attribute__((ext_vector_type(16))) float;
using u32x4  = __attribute__((ext_vector_type(4))) unsigned;
using u32x2  = __attribute__((ext_vector_type(2))) unsigned;

typedef __bf16 bf16x2_t __attribute__((ext_vector_type(2)));
typedef float f32x2_t __attribute__((ext_vector_type(2)));
__device__ __forceinline__ unsigned cvtpk(float lo, float hi) { f32x2_t v = {lo, hi}; bf16x2_t b = __builtin_convertvector(v, bf16x2_t); return __builtin_bit_cast(unsigned, b); }
__device__ __forceinline__ bf16_t f2bf(float x) { __bf16 b = (__bf16)x; return __builtin_bit_cast(unsigned short, b); }
__device__ __forceinline__ unsigned cvtpk_asm(float lo, float hi) { unsigned r; asm volatile("v_cvt_pk_bf16_f32 %0, %1, %2" : "=v"(r) : "v"(lo), "v"(hi)); return r; }
__device__ __forceinline__ float bf2f(bf16_t u) { return __uint_as_float(((unsigned)u) << 16); }
__device__ __forceinline__ float bflo(unsigned w) { return __uint_as_float(w << 16); }
__device__ __forceinline__ float bfhi(unsigned w) { return __uint_as_float(w & 0xffff0000u); }
__device__ __forceinline__ int crow(int r, int hi) { return (r & 3) + 8 * (r >> 2) + 4 * hi; }
__device__ __forceinline__ float wsum(float v) {
#pragma unroll
  for (int o = 32; o; o >>= 1) v += __shfl_xor(v, o);
  return v;
}
__device__ __forceinline__ int otid() { int t = threadIdx.x; asm volatile("" : "+v"(t)); return t; }
__device__ __forceinline__ float sin_rev(float rev) { return __builtin_amdgcn_sinf(rev); }
__device__ __forceinline__ float cos_rev(float rev) { return __builtin_amdgcn_cosf(rev); }
__device__ __forceinline__ float sin_rad(float x) { return __builtin_amdgcn_sinf(x * 0.15915494309189535f); }

struct Params { const float* in[38]; float* out; char* ws; int ph_begin, ph_end; };
constexpr size_t al256c(size_t x) { return (x + 255) & ~(size_t)255; }
constexpr size_t SZ_W1 = al256c((size_t)1152 * 1024 * 2), SZ_WUQ = al256c((size_t)1536 * 768 * 2), SZ_WUKV = al256c((size_t)2048 * 256 * 2), SZ_WSQ = al256c((size_t)1024 * 1024 * 2),
                 SZ_WQ = al256c((size_t)2048 * 1024 * 2);
constexpr size_t OFF_BAR  = 0;
constexpr size_t OFF_MODP = 16384;
constexpr size_t OFF_MOD  = OFF_MODP + al256c((size_t)8 * 4 * 5 * 6144 * 4);
constexpr size_t OFF_HDN  = OFF_MOD + al256c((size_t)4 * 5 * 6144 * 4);
constexpr size_t OFF_GLAT = OFF_HDN + al256c((size_t)2 * 4096 * 64 * 4);
constexpr size_t OFF_GCTX = OFF_GLAT + al256c((size_t)2 * 1024 * 8192 * 2);
constexpr size_t OFF_W1   = OFF_GCTX + al256c((size_t)2 * 1024 * 512 * 2);
constexpr size_t OFF_WUQ  = OFF_W1 + 2 * SZ_W1;
constexpr size_t OFF_WUKV = OFF_WUQ + 2 * SZ_WUQ;
constexpr size_t OFF_WOA  = OFF_WUKV + 2 * SZ_WUKV;
constexpr size_t OFF_WIN  = OFF_WOA + 2 * SZ_WSQ;
constexpr size_t OFF_WOUT = OFF_WIN + al256c((size_t)3072 * 1024 * 2);
constexpr size_t OFF_WQKV = OFF_WOUT + SZ_WSQ;
constexpr size_t OFF_WOC  = OFF_WQKV + al256c((size_t)1536 * 1024 * 2);
constexpr size_t OFF_WQ   = OFF_WOC + SZ_WSQ;
constexpr size_t OFF_KEYS = OFF_WQ + 4 * SZ_WQ;
constexpr size_t OFF_PU   = OFF_KEYS + al256c((size_t)4 * 16 * 16384 * 2);
constexpr size_t OFF_PV   = OFF_PU + (size_t)4 * 16384 * 1024;
constexpr size_t OFF_SU   = OFF_PV + (size_t)4 * 16384 * 1024;
constexpr size_t OFF_SV   = OFF_SU + (size_t)4 * 16384 * 4;
constexpr size_t OFF_X    = OFF_SV + (size_t)4 * 16384 * 4;
constexpr size_t OFF_H    = OFF_X + (size_t)T * 1024 * 4;
constexpr size_t OFF_Y    = OFF_H + (size_t)T * 1024 * 2;
constexpr size_t OFF_RA   = OFF_Y + (size_t)T * 1024 * 4;
constexpr size_t OFF_RB   = OFF_RA + (size_t)T * 2048 * 4;
constexpr size_t OFF_RC   = OFF_RB + (size_t)T * 2048 * 2;
constexpr size_t OFF_RD   = OFF_RC + (size_t)T * 1536 * 2;
constexpr size_t OFF_RE   = OFF_RD + (size_t)T * 1024 * 2;
constexpr size_t OFF_RF   = OFF_RE + (size_t)T * 1024 * 2;
constexpr size_t WS_TOTAL = OFF_RF + (size_t)T * 1024 * 2;
#define WSP(type, off) ((type*)(p.ws + (off)))

struct RowInfo { int b, rb, is_ctx, pos, mrow; };
__device__ __forceinline__ RowInfo row_info(int row) {
  RowInfo r; r.b = row / RB; r.rb = row - r.b * RB; r.is_ctx = r.rb < CTXL; r.pos = r.rb - CTXL; r.mrow = r.is_ctx ? 4 : r.b; return r;
}
__device__ __forceinline__ void rope_cs(int pos, int i, int quarter, float& c, float& s) {
  const int j = i < quarter ? i : i - quarter;
  const float inv = exp2f(-13.287712379549449f * (float)j / (float)quarter);
  const float p = (float)(i < quarter ? (pos >> 6) : (pos & 63));
  const float rev = p * inv * 0.15915494309189535f;
  c = cos_rev(rev); s = sin_rev(rev);
}

__device__ __forceinline__ int gswz(int row, int chunk) { return row * 128 + ((chunk ^ ((row >> 1) & 7)) << 4); }
constexpr int G_ASZ = 256 * 128, G_BSZ = 128 * 128;
template <class Epi>
__device__ __forceinline__ void gemm_tile(const bf16_t* __restrict__ A, int lda, const bf16_t* __restrict__ Bt, int ldb, int K, int m0, int n0, int acol0,
                                          const Epi& epi, char* lds) {
  const int tid = otid(), lane = tid & 63, wid = tid >> 6, wm = wid >> 1, wn = wid & 1, r32 = lane & 31, hi = lane >> 5;
  char* As = lds; char* Bs = lds + 2 * G_ASZ;
  f32x16 acc[2][2];
#pragma unroll
  for (int i = 0; i < 2; ++i)
#pragma unroll
    for (int j = 0; j < 2; ++j) acc[i][j] = f32x16{};
  u32x4 ra[4], rb[2];
  const int srow = tid >> 3, sch = tid & 7;
  const bf16_t* Ap = A + (size_t)(m0 + srow) * lda + acol0 + sch * 8;
  const bf16_t* Bp = Bt + (size_t)(n0 + srow) * ldb + sch * 8;
  const int nk = K >> 6;
#define G_LOAD(kt) do { _Pragma("unroll") for (int c_ = 0; c_ < 4; ++c_) ra[c_] = *(const u32x4*)(Ap + (size_t)(c_ * 64) * lda + (kt) * 64); \
                        _Pragma("unroll") for (int c_ = 0; c_ < 2; ++c_) rb[c_] = *(const u32x4*)(Bp + (size_t)(c_ * 64) * ldb + (kt) * 64); } while (0)
#define G_STORE(buf) do { _Pragma("unroll") for (int c_ = 0; c_ < 4; ++c_) *(u32x4*)(As + (buf) * G_ASZ + gswz(srow + c_ * 64, sch)) = ra[c_]; \
                          _Pragma("unroll") for (int c_ = 0; c_ < 2; ++c_) *(u32x4*)(Bs + (buf) * G_BSZ + gswz(srow + c_ * 64, sch)) = rb[c_]; } while (0)
  G_LOAD(0); G_STORE(0); __syncthreads();
  for (int kt = 0; kt < nk; ++kt) {
    if (kt + 1 < nk) G_LOAD(kt + 1);
    const char* Ab = As + (kt & 1) * G_ASZ; const char* Bb = Bs + (kt & 1) * G_BSZ;
#pragma unroll
    for (int ks = 0; ks < 4; ++ks) {
      bf16x8 af[2], bfr[2];
#pragma unroll
      for (int i = 0; i < 2; ++i) af[i] = *(const bf16x8*)(Ab + gswz(wm * 64 + i * 32 + r32, ks * 2 + hi));
#pragma unroll
      for (int j = 0; j < 2; ++j) bfr[j] = *(const bf16x8*)(Bb + gswz(wn * 64 + j * 32 + r32, ks * 2 + hi));
#pragma unroll
      for (int i = 0; i < 2; ++i)
#pragma unroll
        for (int j = 0; j < 2; ++j) acc[i][j] = __builtin_amdgcn_mfma_f32_32x32x16_bf16(af[i], bfr[j], acc[i][j], 0, 0, 0);
    }
    if (kt + 1 < nk) G_STORE((kt + 1) & 1);
    __syncthreads();
  }
#undef G_LOAD
#undef G_STORE
#pragma unroll
  for (int i = 0; i < 2; ++i)
#pragma unroll
    for (int j = 0; j < 2; ++j)
#pragma unroll
      for (int r = 0; r < 16; ++r) epi(m0 + wm * 64 + i * 32 + crow(r, hi), n0 + wn * 64 + j * 32 + r32, acc[i][j][r]);
}
template <class Epi>
__device__ __forceinline__ void gemm_job(const bf16_t* A, int lda, const bf16_t* Bt, int ldb, int M, int N, int K, bool grouped, const Epi& epi, char* lds) {
  const int ntn = N / 128, nt = ntn * (M / 256);
  for (int it = blockIdx.x; it < nt; it += gridDim.x) {
    const int mt = it / ntn, n_t = it - mt * ntn;
    gemm_tile(A, lda, Bt, ldb, K, mt * 256, n_t * 128, grouped ? n_t * 128 : 0, epi, lds);
  }
}
struct EpiF32 { float* C; int ldc, ncols; const float* bias;
  __device__ __forceinline__ void operator()(int row, int col, float v) const { if (col < ncols) C[(size_t)row * ldc + col] = v + (bias ? bias[col] : 0.f); } };
struct EpiBf16 { bf16_t* C; int ldc;
  __device__ __forceinline__ void operator()(int row, int col, float v) const { C[(size_t)row * ldc + col] = f2bf(v); } };
struct EpiZT { bf16_t* C; int ldc; const float* bias_row;
  __device__ __forceinline__ void operator()(int row, int col, float v) const { C[(size_t)row * ldc + col] = f2bf(v + bias_row[row]); } };
struct EpiMlaQ { bf16_t* Q;
  __device__ __forceinline__ void operator()(int row, int col, float v) const {
    const float partner = __shfl_xor(v, 1);
    const int w = col % 192;
    const RowInfo ri = row_info(row);
    float o = v;
    if (w >= 128 && !ri.is_ctx) { float c, s; rope_cs(ri.pos, (w - 128) >> 1, 16, c, s); o = (col & 1) ? (partner * s + v * c) : (v * c - partner * s); }
    Q[(size_t)row * 1536 + col] = f2bf(o);
  } };
struct EpiMlaKV { bf16_t* Kb; bf16_t* Vb;
  __device__ __forceinline__ void operator()(int row, int col, float v) const {
    const int h = col >> 8, w = col & 255;
    if (w < 128) Kb[(size_t)row * 1024 + h * 128 + w] = f2bf(v); else Vb[(size_t)row * 1024 + h * 128 + (w - 128)] = f2bf(v);
  } };

#define SBAR() __builtin_amdgcn_sched_barrier(0)
constexpr float ATT_THR = 8.f;
__device__ __forceinline__ void partialSM(f32x16& p0, f32x16& p1, float& m_reg, float& mn, float& alpha, const float C, const float thr_s) {
  float pmax = p0[0];
#pragma unroll
  for (int r = 1; r < 16; ++r) pmax = fmaxf(pmax, p0[r]);
#pragma unroll
  for (int r = 0; r < 16; ++r) pmax = fmaxf(pmax, p1[r]);
  { auto rr = __builtin_amdgcn_permlane32_swap(__float_as_uint(pmax), __float_as_uint(pmax), false, false);
    pmax = fmaxf(__uint_as_float(rr[0]), __uint_as_float(rr[1])); }
  if (__builtin_expect(__all(pmax - m_reg <= thr_s), 1)) { mn = m_reg; alpha = 1.f; }
  else { mn = fmaxf(m_reg, pmax); alpha = __builtin_amdgcn_exp2f((m_reg - mn) * C); m_reg = mn; }
  const float mnC = -mn * C;
#pragma unroll
  for (int r = 0; r < 16; ++r) p0[r] = fmaf(p0[r], C, mnC);
#pragma unroll
  for (int r = 0; r < 16; ++r) p1[r] = fmaf(p1[r], C, mnC);
#pragma unroll
  for (int r = 0; r < 16; ++r) p0[r] = __builtin_amdgcn_exp2f(p0[r]);
}
__device__ __forceinline__ void finishSM(f32x16& p0, f32x16& p1, float alpha, float& l_reg, bf16x8& pa0, bf16x8& pa1, bf16x8& pa2, bf16x8& pa3) {
#pragma unroll
  for (int r = 0; r < 16; ++r) p1[r] = __builtin_amdgcn_exp2f(p1[r]);
  float ps = 0;
#pragma unroll
  for (int r = 0; r < 16; ++r) ps += p0[r];
#pragma unroll
  for (int r = 0; r < 16; ++r) ps += p1[r];
  { auto rr = __builtin_amdgcn_permlane32_swap(__float_as_uint(ps), __float_as_uint(ps), false, false);
    ps = __uint_as_float(rr[0]) + __uint_as_float(rr[1]); }
  l_reg = l_reg * alpha + ps;
#define PK4(P, BASE, OUT) do { unsigned a0 = cvtpk_asm(P[BASE + 0], P[BASE + 1]), a1 = cvtpk_asm(P[BASE + 2], P[BASE + 3]);   \
    unsigned b0 = cvtpk_asm(P[BASE + 4], P[BASE + 5]), b1 = cvtpk_asm(P[BASE + 6], P[BASE + 7]);                              \
    auto r0 = __builtin_amdgcn_permlane32_swap(a0, b0, false, false); auto r1 = __builtin_amdgcn_permlane32_swap(a1, b1, false, false); \
    u32x4 w = {r0[0], r1[0], r0[1], r1[1]}; OUT = *reinterpret_cast<bf16x8*>(&w); } while (0)
  PK4(p0, 0, pa0); PK4(p0, 8, pa1); PK4(p1, 0, pa2); PK4(p1, 8, pa3);
#undef PK4
}
template <int DQ>
__device__ __forceinline__ void qkt(f32x16& p0, f32x16& p1, const char* Ks, const char* KRs, const bf16x8* qr, int r32, int hi) {
  p0 = f32x16{}; p1 = f32x16{};
  const int sw = (r32 & 7) << 4;
#pragma unroll
  for (int d0 = 0; d0 < 8; ++d0) { const int cb = (d0 * 32 + hi * 16) ^ sw;
    bf16x8 b0 = *reinterpret_cast<const bf16x8*>(Ks + r32 * 256 + cb);
    bf16x8 b1 = *reinterpret_cast<const bf16x8*>(Ks + (32 + r32) * 256 + cb);
    p0 = __builtin_amdgcn_mfma_f32_32x32x16_bf16(b0, qr[d0], p0, 0, 0, 0);
    p1 = __builtin_amdgcn_mfma_f32_32x32x16_bf16(b1, qr[d0], p1, 0, 0, 0); }
  if constexpr (DQ == 192) {
#pragma unroll
    for (int d0 = 0; d0 < 4; ++d0) { const int cb = (d0 * 32 + hi * 16) ^ sw;
      bf16x8 b0 = *reinterpret_cast<const bf16x8*>(KRs + r32 * 128 + cb);
      bf16x8 b1 = *reinterpret_cast<const bf16x8*>(KRs + (32 + r32) * 128 + cb);
      p0 = __builtin_amdgcn_mfma_f32_32x32x16_bf16(b0, qr[8 + d0], p0, 0, 0, 0);
      p1 = __builtin_amdgcn_mfma_f32_32x32x16_bf16(b1, qr[8 + d0], p1, 0, 0, 0); }
  }
}
__device__ __forceinline__ int v_st(int k, int c) { const int kk = (k & ~0xC) | ((k & 4) << 1) | ((k & 8) >> 1); return ((kk >> 3) * 4 + (c >> 5)) * 512 + ((kk & 7) * 32 + (c & 31)) * 2; }
__device__ __forceinline__ int v_rd_base(int lane) { return ((lane & 3) << 3) | (((lane >> 2) & 3) << 6) | (((lane >> 4) & 1) << 5) | (((lane >> 5) & 1) << 8); }
constexpr int v_rd_off(int d0, int ks, int half) { return d0 * 512 + ks * 4096 + half * 2048; }
template <int OFF> __device__ __forceinline__ s16x4 tr_read(int vb) {
  s16x4 r; asm volatile("ds_read_b64_tr_b16 %0, %1 offset:%2" : "=&v"(r) : "v"(vb), "i"(OFF) : "memory"); return r;
}
template <int D0> __device__ __forceinline__ void pv_one(f32x16& od, int vb, bf16x8 pa0, bf16x8 pa1, bf16x8 pa2, bf16x8 pa3) {
  const s16x4 l0 = tr_read<v_rd_off(D0, 0, 0)>(vb), h0 = tr_read<v_rd_off(D0, 0, 1)>(vb), l1 = tr_read<v_rd_off(D0, 1, 0)>(vb), h1 = tr_read<v_rd_off(D0, 1, 1)>(vb);
  const s16x4 l2 = tr_read<v_rd_off(D0, 2, 0)>(vb), h2 = tr_read<v_rd_off(D0, 2, 1)>(vb), l3 = tr_read<v_rd_off(D0, 3, 0)>(vb), h3 = tr_read<v_rd_off(D0, 3, 1)>(vb);
  asm volatile("s_waitcnt lgkmcnt(0)" ::: "memory"); SBAR();
#define PKV(L, H) (bf16x8){L[0], L[1], L[2], L[3], H[0], H[1], H[2], H[3]}
  od = __builtin_amdgcn_mfma_f32_32x32x16_bf16(pa0, PKV(l0, h0), od, 0, 0, 0);
  od = __builtin_amdgcn_mfma_f32_32x32x16_bf16(pa1, PKV(l1, h1), od, 0, 0, 0);
  od = __builtin_amdgcn_mfma_f32_32x32x16_bf16(pa2, PKV(l2, h2), od, 0, 0, 0);
  od = __builtin_amdgcn_mfma_f32_32x32x16_bf16(pa3, PKV(l3, h3), od, 0, 0, 0);
#undef PKV
}
__device__ __forceinline__ void pv_d0(f32x16* o, int vb, bf16x8 pa0, bf16x8 pa1, bf16x8 pa2, bf16x8 pa3) {
  pv_one<0>(o[0], vb, pa0, pa1, pa2, pa3); pv_one<1>(o[1], vb, pa0, pa1, pa2, pa3); pv_one<2>(o[2], vb, pa0, pa1, pa2, pa3); pv_one<3>(o[3], vb, pa0, pa1, pa2, pa3);
}
constexpr int ATT_LDS = 2 * 16384 + 2 * 16384 + 2 * 8192 + 2048;
template <int DQ, int LDQ, int LDK, int LDKR, int LDV, int LDO, int SDEPTH>
__device__ __forceinline__ void attn_body(const bf16_t* __restrict__ Qb, const bf16_t* __restrict__ Kh, const bf16_t* __restrict__ Krh, const bf16_t* __restrict__ Vh,
                                          bf16_t* __restrict__ Ob, int seq, char* lds) {
  constexpr int SHM_V = 16384, SHM_K = 16384, SHM_KR = 8192;
  constexpr bool ROPE = DQ == 192;
  constexpr float scale = ROPE ? 0.07216878364870322f : 0.08838834764831845f;
  constexpr float C = scale * 1.4426950408889634f, thr_s = ATT_THR / scale;
  const int tid = otid();
  const int wid = tid >> 6, lane = tid & 63, r32 = lane & 31, hi = lane >> 5;
  char* V_lds = lds; char* K_lds = lds + 2 * SHM_V; char* KR_lds = K_lds + 2 * SHM_K;
  float* ws = (float*)(KR_lds + 2 * SHM_KR) + wid * 64; float* li_l = ws; float* al_l = ws + 32;
  float m_reg = -1e30f, l_reg = 0; f32x16 o[4] = {}; bf16x8 qr[DQ / 16];
  const bf16_t* Qw = Qb + (long)(wid * 32 + r32) * LDQ + hi * 8;
#pragma unroll
  for (int d0 = 0; d0 < DQ / 16; ++d0) qr[d0] = *reinterpret_cast<const bf16x8*>(Qw + d0 * 16);
  const int sr = tid >> 4, sc = tid & 15;
  const unsigned voffK = (unsigned)(sr * LDK + sc * 8) * 2u, voffV = (unsigned)(sr * LDV + sc * 8) * 2u, voffKR = (unsigned)((tid >> 3) * LDKR + (tid & 7) * 8) * 2u;
  const int kst0 = sr * 256 + ((sc * 16) ^ ((sr & 7) << 4)), vst0 = v_st(sr, sc * 8), vst1 = v_st(32 + sr, sc * 8);
  const int krst = (tid >> 3) * 128 + (((tid & 7) * 16) ^ (((tid >> 3) & 7) << 4));
  const int vb0 = (int)(uintptr_t)V_lds + v_rd_base(lane);
  struct { bf16x8 v0, v1, k0, k1, kr; } sr_[SDEPTH];
#define SLOAD(i, kk) do { const char* vb_ = (const char*)Vh + (size_t)(kk) * (LDV * 2); const char* kb_ = (const char*)Kh + (size_t)(kk) * (LDK * 2); \
    sr_[i].v0 = *reinterpret_cast<const bf16x8*>(vb_ + voffV); sr_[i].v1 = *reinterpret_cast<const bf16x8*>(vb_ + voffV + 32 * LDV * 2); \
    sr_[i].k0 = *reinterpret_cast<const bf16x8*>(kb_ + voffK); sr_[i].k1 = *reinterpret_cast<const bf16x8*>(kb_ + voffK + 32 * LDK * 2); \
    if constexpr (ROPE) sr_[i].kr = *reinterpret_cast<const bf16x8*>((const char*)Krh + (size_t)(kk) * (LDKR * 2) + voffKR); } while (0)
#define SWRITE(b, i) do { *(bf16x8*)(V_lds + (b) * SHM_V + vst0) = sr_[i].v0; *(bf16x8*)(V_lds + (b) * SHM_V + vst1) = sr_[i].v1; \
    *(bf16x8*)(K_lds + (b) * SHM_K + kst0) = sr_[i].k0; *(bf16x8*)(K_lds + (b) * SHM_K + kst0 + 8192) = sr_[i].k1; \
    if constexpr (ROPE) *(bf16x8*)(KR_lds + (b) * SHM_KR + krst) = sr_[i].kr; } while (0)
#define SWAIT() do { if constexpr (SDEPTH == 2) { if constexpr (ROPE) asm volatile("s_waitcnt vmcnt(5)" ::: "memory"); else asm volatile("s_waitcnt vmcnt(4)" ::: "memory"); } \
    else asm volatile("s_waitcnt vmcnt(0)" ::: "memory"); } while (0)
#define RESC(a) do { if (__any((a) < 1.f)) { if (hi == 0) al_l[r32] = (a); asm volatile("s_waitcnt lgkmcnt(0)" ::: "memory"); \
    _Pragma("unroll") for (int d = 0; d < 4; ++d) _Pragma("unroll") for (int r = 0; r < 16; ++r) o[d][r] *= al_l[crow(r, hi)]; } } while (0)
  f32x16 pA0, pA1, pB0, pB1; float mnA, mnB, alA, alB; bf16x8 pa0, pa1, pa2, pa3; const int NT = seq / 64;
  constexpr int SE = 0, SO = SDEPTH - 1;
  SLOAD(SE, 0); asm volatile("s_waitcnt vmcnt(0)" ::: "memory"); SWRITE(0, SE); __syncthreads();
  qkt<DQ>(pA0, pA1, K_lds, KR_lds, qr, r32, hi); partialSM(pA0, pA1, m_reg, mnA, alA, C, thr_s);
  SLOAD(SO, 64); if constexpr (SDEPTH == 2) { if (2 < NT) SLOAD(SE, 2 * 64); }
  SWAIT(); SWRITE(1, SO); __syncthreads();
  for (int j = 1; j + 1 < NT; j += 2) {
    SBAR(); qkt<DQ>(pB0, pB1, K_lds + SHM_K, KR_lds + SHM_KR, qr, r32, hi);
    finishSM(pA0, pA1, alA, l_reg, pa0, pa1, pa2, pa3); SBAR();
    SLOAD(SO, (j + SDEPTH) * 64); SBAR();
    pv_d0(o, vb0, pa0, pa1, pa2, pa3); partialSM(pB0, pB1, m_reg, mnB, alB, C, thr_s);
    __syncthreads(); SWAIT(); SWRITE(0, SE);
    RESC(alB); __syncthreads();
    SBAR(); qkt<DQ>(pA0, pA1, K_lds, KR_lds, qr, r32, hi);
    finishSM(pB0, pB1, alB, l_reg, pa0, pa1, pa2, pa3); SBAR();
    if (SDEPTH == 1 || j + 3 < NT) SLOAD(SE, (j + 1 + SDEPTH) * 64); SBAR();
    pv_d0(o, vb0 + SHM_V, pa0, pa1, pa2, pa3); partialSM(pA0, pA1, m_reg, mnA, alA, C, thr_s);
    __syncthreads(); SWAIT(); SWRITE(1, SO);
    RESC(alA); __syncthreads();
  }
  SBAR(); qkt<DQ>(pB0, pB1, K_lds + SHM_K, KR_lds + SHM_KR, qr, r32, hi);
  finishSM(pA0, pA1, alA, l_reg, pa0, pa1, pa2, pa3); SBAR();
  pv_d0(o, vb0, pa0, pa1, pa2, pa3); partialSM(pB0, pB1, m_reg, mnB, alB, C, thr_s);
  __syncthreads(); RESC(alB);
  finishSM(pB0, pB1, alB, l_reg, pa0, pa1, pa2, pa3); SBAR();
  pv_d0(o, vb0 + SHM_V, pa0, pa1, pa2, pa3);
  if (hi == 0) li_l[r32] = l_reg; asm volatile("s_waitcnt lgkmcnt(0)" ::: "memory");
  bf16_t* Ow = Ob + (long)(wid * 32) * LDO + r32;
#pragma unroll
  for (int r = 0; r < 16; ++r) { const int orow = crow(r, hi); const float rl = __builtin_amdgcn_rcpf(li_l[orow]);
#pragma unroll
    for (int d0 = 0; d0 < 4; ++d0) Ow[(long)orow * LDO + d0 * 32] = f2bf(o[d0][r] * rl); }
#undef SLOAD
#undef SWRITE
#undef SWAIT
#undef RESC
  __syncthreads();
}

__device__ __forceinline__ void ln_row_finish(float (&r)[16], int cA, int cB, const float* lnw, const float* lnb, float* Xrow, bf16_t* Hrow, const float* sh, const float* sc, float* orow) {
  float s = 0.f;
#pragma unroll
  for (int i = 0; i < 16; ++i) s += r[i];
  const float mean = wsum(s) * (1.f / 1024.f);
  float q = 0.f;
#pragma unroll
  for (int i = 0; i < 16; ++i) { r[i] -= mean; q += r[i] * r[i]; }
  const float rstd = rsqrtf(wsum(q) * (1.f / 1024.f) + 1e-5f);
#pragma unroll
  for (int hf = 0; hf < 2; ++hf) {
    const int c0 = hf ? cB : cA;
    float xn[8];
#pragma unroll
    for (int i = 0; i < 8; ++i) xn[i] = r[hf * 8 + i] * rstd * lnw[c0 + i] + lnb[c0 + i];
    *(float4*)(Xrow + c0) = make_float4(xn[0], xn[1], xn[2], xn[3]); *(float4*)(Xrow + c0 + 4) = make_float4(xn[4], xn[5], xn[6], xn[7]);
    if (orow) { *(float4*)(orow + c0) = make_float4(xn[0], xn[1], xn[2], xn[3]); *(float4*)(orow + c0 + 4) = make_float4(xn[4], xn[5], xn[6], xn[7]); }
    if (Hrow) {
      float hv[8];
#pragma unroll
      for (int i = 0; i < 8; ++i) hv[i] = xn[i] * (1.f + sc[c0 + i]) + sh[c0 + i];
      u32x4 w = {cvtpk(hv[0], hv[1]), cvtpk(hv[2], hv[3]), cvtpk(hv[4], hv[5]), cvtpk(hv[6], hv[7])};
      *(u32x4*)(Hrow + c0) = w;
    }
  }
}

struct WDesc { const float* src; bf16_t* dst; int K, N, Npad; };
constexpr int wd_tiles_of(int K, int Npad) { return (K / 64) * (Npad / 64); }
constexpr int WT_MLA = wd_tiles_of(1024, 768) + wd_tiles_of(1024, 384) + wd_tiles_of(768, 1536) + wd_tiles_of(256, 2048) + wd_tiles_of(1024, 1024);
constexpr int WT_HY = wd_tiles_of(1024, 3072) + wd_tiles_of(1024, 1024), WT_GQA = wd_tiles_of(1024, 1536) + wd_tiles_of(1024, 1024), WT_PQ = wd_tiles_of(1024, 2048);
constexpr int WD_TILES = 2 * WT_MLA + WT_HY + WT_GQA + 4 * WT_PQ;
__device__ __forceinline__ void job_wconv(const Params& p, char* lds) {
  float* tile = (float*)lds;
  const int tid = otid();
  for (int it = blockIdx.x; it < WD_TILES; it += gridDim.x) {
    WDesc w; int lt = it;
    if (lt < 2 * WT_MLA) {
      const int i = lt / WT_MLA; lt -= i * WT_MLA;
      if (lt < wd_tiles_of(1024, 768)) w = WDesc{p.in[8] + (size_t)i * 1024 * 768, WSP(bf16_t, OFF_W1 + (size_t)i * SZ_W1), 1024, 768, 768};
      else if ((lt -= wd_tiles_of(1024, 768)) < wd_tiles_of(1024, 384)) w = WDesc{p.in[11] + (size_t)i * 1024 * 320, WSP(bf16_t, OFF_W1 + (size_t)i * SZ_W1) + (size_t)768 * 1024, 1024, 320, 384};
      else if ((lt -= wd_tiles_of(1024, 384)) < wd_tiles_of(768, 1536)) w = WDesc{p.in[10] + (size_t)i * 768 * 1536, WSP(bf16_t, OFF_WUQ + (size_t)i * SZ_WUQ), 768, 1536, 1536};
      else if ((lt -= wd_tiles_of(768, 1536)) < wd_tiles_of(256, 2048)) w = WDesc{p.in[13] + (size_t)i * 256 * 2048, WSP(bf16_t, OFF_WUKV + (size_t)i * SZ_WUKV), 256, 2048, 2048};
      else { lt -= wd_tiles_of(256, 2048); w = WDesc{p.in[14] + (size_t)i * 1024 * 1024, WSP(bf16_t, OFF_WOA + (size_t)i * SZ_WSQ), 1024, 1024, 1024}; }
    } else if ((lt -= 2 * WT_MLA) < WT_HY) {
      if (lt < wd_tiles_of(1024, 3072)) w = WDesc{p.in[15], WSP(bf16_t, OFF_WIN), 1024, 3072, 3072};
      else { lt -= wd_tiles_of(1024, 3072); w = WDesc{p.in[27], WSP(bf16_t, OFF_WOUT), 1024, 1024, 1024}; }
    } else if ((lt -= WT_HY) < WT_GQA) {
      if (lt < wd_tiles_of(1024, 1536)) w = WDesc{p.in[29], WSP(bf16_t, OFF_WQKV), 1024, 1536, 1536};
      else { lt -= wd_tiles_of(1024, 1536); w = WDesc{p.in[32], WSP(bf16_t, OFF_WOC), 1024, 1024, 1024}; }
    } else {
      lt -= WT_GQA; const int l = lt / WT_PQ; lt -= l * WT_PQ;
      w = WDesc{p.in[33] + (size_t)l * 1024 * 2048, WSP(bf16_t, OFF_WQ + (size_t)l * SZ_WQ), 1024, 2048, 2048};
    }
    const int tn = w.Npad / 64, kt = lt / tn, nt = lt - kt * tn, k0 = kt * 64, n0 = nt * 64;
    for (int e = tid; e < 4096; e += NTHR) { const int k = e >> 6, n = e & 63; tile[k * 65 + n] = (n0 + n < w.N) ? w.src[(size_t)(k0 + k) * w.N + n0 + n] : 0.f; }
    __syncthreads();
    for (int e = tid; e < 4096; e += NTHR) { const int n = e >> 6, k = e & 63; w.dst[(size_t)(n0 + n) * w.K + k0 + k] = f2bf(tile[k * 65 + n]); }
    __syncthreads();
  }
}
__device__ __forceinline__ void job_peer_conv(const Params& p) {
  const int tid = otid();
  const size_t gt = (size_t)blockIdx.x * NTHR + tid, gs = (size_t)gridDim.x * NTHR;
  const size_t nk8 = (size_t)4 * 16 * 16384 / 8;
  for (size_t i = gt; i < nk8; i += gs) {
    const size_t e = i * 8; const int blk = (int)(e >> 14), off = (int)(e & 16383); const int l = blk >> 4, h = (blk >> 1) & 7, side = blk & 1;
    const float* src = (side ? p.in[35] : p.in[34]) + ((size_t)(l * 8 + h) << 14) + off;
    const float4 a = *(const float4*)src, b = *(const float4*)(src + 4);
    u32x4 w = {cvtpk(a.x, a.y), cvtpk(a.z, a.w), cvtpk(b.x, b.y), cvtpk(b.z, b.w)};
    *(u32x4*)(WSP(bf16_t, OFF_KEYS) + e) = w;
  }
  const int lane = tid & 63, wg = blockIdx.x * 8 + (tid >> 6), nw = gridDim.x * 8;
  for (int r = wg; r < 2 * 4 * 16384; r += nw) {
    const int isv = r >= 4 * 16384, row = isv ? r - 4 * 16384 : r;
    const float* src = (isv ? p.in[37] : p.in[36]) + (size_t)row * 1024 + lane * 16;
    float4 x[4]; float am = 0.f;
#pragma unroll
    for (int j = 0; j < 4; ++j) { x[j] = *(const float4*)(src + 4 * j); am = fmaxf(am, fmaxf(fmaxf(fabsf(x[j].x), fabsf(x[j].y)), fmaxf(fabsf(x[j].z), fabsf(x[j].w)))); }
#pragma unroll
    for (int o = 32; o; o >>= 1) am = fmaxf(am, __shfl_xor(am, o));
    int e = (int)((__float_as_uint(am) >> 23) & 255u) - 127; e = e < -100 ? -100 : (e > 100 ? 100 : e);
    const int k = 7 - e;
    const float sc = __uint_as_float((unsigned)(k + 127) << 23), isc = __uint_as_float((unsigned)(127 - k) << 23);
    u32x4 w;
#pragma unroll
    for (int j = 0; j < 4; ++j) { int q = 0; q = __builtin_amdgcn_cvt_pk_fp8_f32(x[j].x * sc, x[j].y * sc, q, false); q = __builtin_amdgcn_cvt_pk_fp8_f32(x[j].z * sc, x[j].w * sc, q, true); w[j] = (unsigned)q; }
    *(u32x4*)((isv ? WSP(unsigned char, OFF_PV) : WSP(unsigned char, OFF_PU)) + (size_t)row * 1024 + lane * 16) = w;
    if (lane == 0) (isv ? WSP(float, OFF_SV) : WSP(float, OFF_SU))[row] = isc;
  }
}
__device__ __forceinline__ void job_adaln_partial(const Params& p, char* lds) {
  float* sl = (float*)lds;
  float* red = (float*)lds + 1024;
  const int tid = otid();
  for (int it = blockIdx.x; it < 768; it += gridDim.x) {
    const int l = it / 192, rem = it - l * 192, cgp = rem >> 3, ks = rem & 7;
    for (int e = tid; e < 640; e += NTHR) { const int r = e >> 7, k = e & 127; const float v = (r < 4) ? p.in[1][r * 1024 + ks * 128 + k] : p.in[3][ks * 128 + k]; sl[e] = v / (1.f + __expf(-v)); }
    __syncthreads();
    const int cq = tid & 63, kg = tid >> 6;
    float4 acc[5];
#pragma unroll
    for (int r = 0; r < 5; ++r) acc[r] = make_float4(0.f, 0.f, 0.f, 0.f);
    for (int i = 0; i < 16; ++i) {
      const int k = kg * 16 + i;
      const float4 w = *(const float4*)(p.in[4] + ((size_t)l * 1024 + ks * 128 + k) * 6144 + cgp * 256 + cq * 4);
#pragma unroll
      for (int r = 0; r < 5; ++r) { const float sv = sl[r * 128 + k]; acc[r].x += sv * w.x; acc[r].y += sv * w.y; acc[r].z += sv * w.z; acc[r].w += sv * w.w; }
    }
#pragma unroll
    for (int r = 0; r < 5; ++r) *(float4*)(red + (kg * 5 + r) * 256 + cq * 4) = acc[r];
    __syncthreads();
    for (int e = tid; e < 1280; e += NTHR) {
      const int r = e >> 8, col = e & 255; float s = 0.f;
#pragma unroll
      for (int g = 0; g < 8; ++g) s += red[(g * 5 + r) * 256 + col];
      WSP(float, OFF_MODP)[((size_t)(ks * 4 + l) * 5 + r) * 6144 + cgp * 256 + col] = s;
    }
    __syncthreads();
  }
}
__device__ __forceinline__ void job_hdn(const Params& p, char* lds) {
  float* h1s = (float*)lds;
  const int tid = otid(), tl = tid >> 6, r = tid & 63;
  for (int it = blockIdx.x; it < 544; it += gridDim.x) {
    const int s = it < 512 ? 0 : 1, chunk = it - s * 512, L = s ? 256 : 4096, tau = chunk * 8 + tl;
    float a1 = p.in[20][r] + ((float)tau / (float)(L - 1)) * p.in[19][r];
#pragma unroll 4
    for (int k = 0; k < 16; ++k) {
      const float f = 1e-4f + (float)k * ((15.f - 1e-4f) / 15.f);
      const float rev = f * (float)tau / (float)L;
      a1 += cos_rev(rev) * p.in[19][(1 + k) * 64 + r] - sin_rev(rev) * p.in[19][(17 + k) * 64 + r];
    }
    h1s[tl * 64 + r] = sin_rad(p.in[21][r] * a1);
    __syncthreads();
    float a2 = p.in[23][r];
    for (int q = 0; q < 64; ++q) a2 += h1s[tl * 64 + q] * p.in[22][q * 64 + r];
    WSP(float, OFF_HDN)[((size_t)s * 4096 + tau) * 64 + r] = sin_rad(p.in[24][r] * a2);
    __syncthreads();
  }
}
__device__ __forceinline__ void job_mod_final(const Params& p) {
  for (int e = blockIdx.x * NTHR + otid(); e < 4 * 5 * 6144; e += gridDim.x * NTHR) {
    const int l = e / 30720, rem = e - l * 30720, col = rem % 6144;
    float s = p.in[5][l * 6144 + col];
#pragma unroll
    for (int ks = 0; ks < 8; ++ks) s += WSP(float, OFF_MODP)[(size_t)ks * 4 * 30720 + e];
    WSP(float, OFF_MOD)[e] = s;
  }
}
__device__ __forceinline__ void job_gbuild(const Params& p, char* lds) {
  float* hd = (float*)lds;
  const int tid = otid();
  for (int it = blockIdx.x; it < 1024 + 64; it += gridDim.x) {
    const int s = it < 1024 ? 0 : 1, li = it - s * 1024, L = s ? 256 : 4096, tt = li >> 3, ct = li & 7;
    const int col = ct * 512 + tid, o = col >> 11, dir = (col >> 10) & 1, d = col & 1023;
    float w3c[64];
#pragma unroll
    for (int r = 0; r < 64; ++r) w3c[r] = p.in[25][r * 4096 + col];
    for (int e = tid; e < 2048; e += NTHR) hd[e] = WSP(float, OFF_HDN)[((size_t)s * 4096 + tt * 32) * 64 + e];
    __syncthreads();
    const float delta = 3.0701134573253945f + 12.280453829301578f * ((float)d / 1023.f);
    const float bias_o = p.in[26][o * 1024 + d];
    bf16_t* Gp = (s ? WSP(bf16_t, OFF_GCTX) : WSP(bf16_t, OFF_GLAT)) + (size_t)(o * 1024 + d) * (2 * L);
    for (int j = 0; j < 32; ++j) {
      const int tau = tt * 32 + j;
      float f = 0.f;
#pragma unroll
      for (int r = 0; r < 64; ++r) f += hd[j * 64 + r] * w3c[r];
      const float t01 = (float)tau / (float)(L - 1);
      float val = f * (__expf(-t01 * delta) + 0.05f);
      int xi;
      if (dir == 0) { if (tau == 0) val += bias_o; xi = L + tau; }
      else { if (tau == 0) { val = 0.f; xi = 0; } else xi = L - tau; }
      Gp[xi] = f2bf(val);
    }
    __syncthreads();
  }
}
__device__ __forceinline__ void job_init(const Params& p) {
  const size_t n4 = (size_t)T * 256;
  for (size_t i = (size_t)blockIdx.x * NTHR + otid(); i < n4; i += (size_t)gridDim.x * NTHR) {
    const int row = (int)(i >> 8), c = (int)(i & 255) * 4;
    const RowInfo ri = row_info(row);
    const float* src = ri.is_ctx ? p.in[2] + ((size_t)(ri.b * CTXL + ri.rb) * 1024 + c) : p.in[0] + ((size_t)(ri.b * SEQ + ri.pos) * 1024 + c);
    const float4 v = *(const float4*)src;
    *(float4*)(WSP(float, OFF_X) + (size_t)row * 1024 + c) = v;
    const float* md = WSP(float, OFF_MOD) + (size_t)ri.mrow * 6144;
    const float4 sh = *(const float4*)(md + c), sc = *(const float4*)(md + 1024 + c);
    u32x2 w = {cvtpk(v.x * (1.f + sc.x) + sh.x, v.y * (1.f + sc.y) + sh.y), cvtpk(v.z * (1.f + sc.z) + sh.z, v.w * (1.f + sc.w) + sh.w)};
    *(u32x2*)(WSP(bf16_t, OFF_H) + (size_t)row * 1024 + c) = w;
  }
}
__device__ __forceinline__ void job_mla_norm(const Params& p, int ia) {
  const int lane = otid() & 63, wg = blockIdx.x * 8 + (otid() >> 6), nw = gridDim.x * 8;
  const float* C1 = WSP(float, OFF_RA); bf16_t* CQN = WSP(bf16_t, OFF_RE); bf16_t* CKVN = WSP(bf16_t, OFF_RE) + (size_t)T * 768; bf16_t* KPE = WSP(bf16_t, OFF_RC) + (size_t)T * 1024;
  const float* qn = p.in[9] + ia * 768; const float* kn = p.in[12] + ia * 256;
  for (int row = wg; row < T; row += nw) {
    const float* cr = C1 + (size_t)row * 1152;
    float4 v[3]; float ss = 0.f;
#pragma unroll
    for (int j = 0; j < 3; ++j) { v[j] = *(const float4*)(cr + (j * 64 + lane) * 4); ss += v[j].x * v[j].x + v[j].y * v[j].y + v[j].z * v[j].z + v[j].w * v[j].w; }
    const float rq = rsqrtf(wsum(ss) * (1.f / 768.f) + 1e-6f);
#pragma unroll
    for (int j = 0; j < 3; ++j) { const int c = (j * 64 + lane) * 4; const float4 g = *(const float4*)(qn + c);
      u32x2 w = {cvtpk(v[j].x * rq * g.x, v[j].y * rq * g.y), cvtpk(v[j].z * rq * g.z, v[j].w * rq * g.w)}; *(u32x2*)(CQN + (size_t)row * 768 + c) = w; }
    const float4 kv = *(const float4*)(cr + 768 + lane * 4);
    const float rk = rsqrtf(wsum(kv.x * kv.x + kv.y * kv.y + kv.z * kv.z + kv.w * kv.w) * (1.f / 256.f) + 1e-6f);
    { const float4 g = *(const float4*)(kn + lane * 4);
      u32x2 w = {cvtpk(kv.x * rk * g.x, kv.y * rk * g.y), cvtpk(kv.z * rk * g.z, kv.w * rk * g.w)}; *(u32x2*)(CKVN + (size_t)row * 256 + lane * 4) = w; }
    if (lane < 32) {
      const float2 xp = *(const float2*)(cr + 1024 + 2 * lane);
      const RowInfo ri = row_info(row);
      float o0 = xp.x, o1 = xp.y;
      if (!ri.is_ctx) { float c, s; rope_cs(ri.pos, lane, 16, c, s); o0 = xp.x * c - xp.y * s; o1 = xp.x * s + xp.y * c; }
      *(unsigned*)(KPE + (size_t)row * 64 + 2 * lane) = cvtpk(o0, o1);
    }
  }
}
__device__ __forceinline__ void job_gqa_norm(const Params& p) {
  const int lane = otid() & 63, wg = blockIdx.x * 8 + (otid() >> 6), nw = gridDim.x * 8;
  const float* QKV = WSP(float, OFF_RA); bf16_t* Qb = WSP(bf16_t, OFF_RB); bf16_t* Kb = WSP(bf16_t, OFF_RC); bf16_t* Vb = WSP(bf16_t, OFF_RD);
  for (int row = wg; row < T; row += nw) {
    const float* cr = QKV + (size_t)row * 1536;
    const RowInfo ri = row_info(row);
    float rc = 1.f, rs = 0.f;
    if (!ri.is_ctx) rope_cs(ri.pos, lane, 32, rc, rs);
#pragma unroll 2
    for (int hh = 0; hh < 10; ++hh) {
      const float2 xp = *(const float2*)(cr + hh * 128 + 2 * lane);
      const float rinv = rsqrtf(wsum(xp.x * xp.x + xp.y * xp.y) * (1.f / 128.f) + 1e-6f);
      const float2 g = *(const float2*)((hh < 8 ? p.in[30] : p.in[31]) + 2 * lane);
      const float x0 = xp.x * rinv * g.x, x1 = xp.y * rinv * g.y;
      const unsigned w = cvtpk(x0 * rc - x1 * rs, x0 * rs + x1 * rc);
      if (hh < 8) *(unsigned*)(Qb + (size_t)row * 1024 + hh * 128 + 2 * lane) = w; else *(unsigned*)(Kb + (size_t)row * 256 + (hh - 8) * 128 + 2 * lane) = w;
    }
    const float4 v = *(const float4*)(cr + 1280 + lane * 4);
    u32x2 w = {cvtpk(v.x, v.y), cvtpk(v.z, v.w)}; *(u32x2*)(Vb + (size_t)row * 256 + lane * 4) = w;
  }
}
__device__ __forceinline__ void job_ln1(const Params& p, int layer) {
  const int lane = otid() & 63, wg = blockIdx.x * 8 + (otid() >> 6), nw = gridDim.x * 8;
  const float* lnw = p.in[6] + (size_t)(layer * 2) * 1024; const float* lnb = p.in[7] + (size_t)(layer * 2) * 1024;
  for (int row = wg; row < T; row += nw) {
    const RowInfo ri = row_info(row);
    const float* md = WSP(float, OFF_MOD) + ((size_t)layer * 5 + ri.mrow) * 6144;
    float* Xr = WSP(float, OFF_X) + (size_t)row * 1024; const float* Yr = WSP(float, OFF_Y) + (size_t)row * 1024;
    float r[16];
#pragma unroll
    for (int hf = 0; hf < 2; ++hf) { const int c0 = hf * 512 + lane * 8;
#pragma unroll
      for (int q = 0; q < 2; ++q) { const float4 xv = *(const float4*)(Xr + c0 + q * 4), yv = *(const float4*)(Yr + c0 + q * 4), gv = *(const float4*)(md + 2048 + c0 + q * 4);
        r[hf * 8 + q * 4 + 0] = ALPHA * xv.x + gv.x * yv.x; r[hf * 8 + q * 4 + 1] = ALPHA * xv.y + gv.y * yv.y; r[hf * 8 + q * 4 + 2] = ALPHA * xv.z + gv.z * yv.z; r[hf * 8 + q * 4 + 3] = ALPHA * xv.w + gv.w * yv.w; } }
    ln_row_finish(r, lane * 8, 512 + lane * 8, lnw, lnb, Xr, WSP(bf16_t, OFF_H) + (size_t)row * 1024, md + 3072, md + 4096, nullptr);
  }
}
__device__ __forceinline__ void job_attn_mla(const Params& p, char* lds) {
  const bf16_t* Qb = WSP(bf16_t, OFF_RB); const bf16_t* Kb = WSP(bf16_t, OFF_RC); const bf16_t* KPE = WSP(bf16_t, OFF_RC) + (size_t)T * 1024; const bf16_t* Vb = WSP(bf16_t, OFF_RD); bf16_t* AO = WSP(bf16_t, OFF_RF);
  for (int it = blockIdx.x; it < 544; it += gridDim.x) {
    int b, h, q0, seq;
    if (it < 512) { b = it >> 7; h = (it >> 4) & 7; q0 = b * RB + CTXL + (it & 15) * 256; seq = RB; } else { const int j = it - 512; b = j >> 3; h = j & 7; q0 = b * RB; seq = CTXL; }
    attn_body<192, 1536, 1024, 64, 1024, 1024, 1>(Qb + (size_t)q0 * 1536 + h * 192, Kb + (size_t)b * RB * 1024 + h * 128, KPE + (size_t)b * RB * 64, Vb + (size_t)b * RB * 1024 + h * 128,
                                                   AO + (size_t)q0 * 1024 + h * 128, seq, lds);
  }
}
__device__ __forceinline__ void job_attn_gqa(const Params& p, char* lds) {
  const bf16_t* Qb = WSP(bf16_t, OFF_RB); const bf16_t* Kb = WSP(bf16_t, OFF_RC); const bf16_t* Vb = WSP(bf16_t, OFF_RD); bf16_t* AO = WSP(bf16_t, OFF_RF);
  for (int it = blockIdx.x; it < 544; it += gridDim.x) {
    int b, h, q0, seq;
    if (it < 512) { b = it >> 7; h = (it >> 4) & 7; q0 = b * RB + CTXL + (it & 15) * 256; seq = RB; } else { const int j = it - 512; b = j >> 3; h = j & 7; q0 = b * RB; seq = CTXL; }
    attn_body<128, 1024, 256, 64, 256, 1024, 1>(Qb + (size_t)q0 * 1024 + h * 128, Kb + (size_t)b * RB * 256 + (h >> 2) * 128, nullptr, Vb + (size_t)b * RB * 256 + (h >> 2) * 128,
                                                 AO + (size_t)q0 * 1024 + h * 128, seq, lds);
  }
}
constexpr int HY_FCN = 8336, HY_VEN = 78 * 64;
constexpr int HY_LDS = 4 * HY_FCN * 2 + 2 * 4 * HY_VEN * 2;
__device__ __forceinline__ float hy_short(const bf16_t* zr, int t, int L, float w0, float w1, float w2, float cb) {
  float v = cb + w1 * bf2f(zr[t]);
  if (t > 0) v += w0 * bf2f(zr[t - 1]);
  if (t + 1 < L) v += w2 * bf2f(zr[t + 1]);
  return v;
}
__device__ __forceinline__ void hy_fill_seq(const Params& p, bf16_t* dst, int ch, int L, int nb, int seq0) {
  const bf16_t* ZT = WSP(bf16_t, OFF_RA);
  const float w0 = p.in[17][ch], w1 = p.in[17][3072 + ch], w2 = p.in[17][6144 + ch], cb = p.in[18][ch];
  const int cpb = (nb + 14) * 8;
  for (int e = otid(); e < 4 * cpb; e += NTHR) {
    const int b = e / cpb, ci = e - b * cpb, t0 = ci * 8 - 7 * 64;
    u32x4 w = {0u, 0u, 0u, 0u};
    if (t0 >= 0 && t0 < L) {
      const bf16_t* zr = ZT + (size_t)ch * T + b * RB + seq0;
      const u32x4 zc = *(const u32x4*)(zr + t0);
      float z[10];
      z[0] = t0 > 0 ? bf2f(zr[t0 - 1]) : 0.f; z[9] = (t0 + 8 < L) ? bf2f(zr[t0 + 8]) : 0.f;
      z[1] = bflo(zc[0]); z[2] = bfhi(zc[0]); z[3] = bflo(zc[1]); z[4] = bfhi(zc[1]); z[5] = bflo(zc[2]); z[6] = bfhi(zc[2]); z[7] = bflo(zc[3]); z[8] = bfhi(zc[3]);
      float o[8];
#pragma unroll
      for (int i = 0; i < 8; ++i) o[i] = cb + w0 * z[i] + w1 * z[i + 1] + w2 * z[i + 2];
      w = (u32x4){cvtpk(o[0], o[1]), cvtpk(o[2], o[3]), cvtpk(o[4], o[5]), cvtpk(o[6], o[7])};
    }
    *(u32x4*)(dst + (size_t)b * HY_VEN + ci * 8) = w;
  }
}
__device__ __forceinline__ void hy_fill_filter(bf16_t* FC, const bf16_t* Gp, int L) {
  const int OFF = L + 64, nch = (2 * L + 144) / 8;
  for (int e = otid(); e < 4 * nch; e += NTHR) {
    const int s = e / nch, u0 = (e - s * nch) * 8;
    unsigned short v[8];
#pragma unroll
    for (int i = 0; i < 8; ++i) { const int z = u0 + i - s - OFF; v[i] = (z > -L && z < L) ? Gp[L - z] : (unsigned short)0; }
    u32x4 w = {(unsigned)v[0] | ((unsigned)v[1] << 16), (unsigned)v[2] | ((unsigned)v[3] << 16), (unsigned)v[4] | ((unsigned)v[5] << 16), (unsigned)v[6] | ((unsigned)v[7] << 16)};
    *(u32x4*)(FC + (size_t)s * HY_FCN + u0) = w;
  }
}
__device__ __forceinline__ void hy_conv(f32x16 (&acc)[2], const bf16_t* FC, const bf16_t* SRC, int nb, int q, int r32, int hi) {
  acc[0] = f32x16{}; acc[1] = f32x16{};
  const int OFFL = nb * 64 + 64, s = r32 & 3, al = r32 >> 2, bb = r32 & 3;
  const int mlo = 8 * q - (nb - 1), mhi = (8 * q + 7 < nb - 1) ? 8 * q + 7 : nb - 1;
  const bf16_t* fbase = FC + (size_t)s * HY_FCN + (8 * hi - r32 + OFFL + s);
  const bf16_t* vbase = SRC + (size_t)bb * HY_VEN + (8 * q + al + 7) * 64 + 8 * hi;
  for (int m = mlo; m <= mhi; ++m) {
#pragma unroll
    for (int ks = 0; ks < 4; ++ks) {
      const bf16x8 bv = *(const bf16x8*)(vbase - m * 64 + ks * 16);
#pragma unroll
      for (int it = 0; it < 2; ++it) {
        const bf16_t* fp = fbase + ks * 16 - it * 32 - 64 * m;
        const s16x4 lo = *(const s16x4*)fp, hh = *(const s16x4*)(fp + 4);
        const bf16x8 av = {lo[0], lo[1], lo[2], lo[3], hh[0], hh[1], hh[2], hh[3]};
        acc[it] = __builtin_amdgcn_mfma_f32_32x32x16_bf16(av, bv, acc[it], 0, 0, 0);
      }
    }
  }
}
__device__ __forceinline__ void job_hyena(const Params& p, int ib, char* lds) {
  bf16_t* FC = (bf16_t*)lds; bf16_t* VE = FC + 4 * HY_FCN; bf16_t* ZE = VE + 4 * HY_VEN;
  bf16_t* YT = WSP(bf16_t, OFF_RB);
  const int tid = otid(), lane = tid & 63, q = tid >> 6, r32 = lane & 31, hi = lane >> 5;
  for (int it = blockIdx.x; it < 2048; it += gridDim.x) {
    const int s = it < 1024 ? 0 : 1, d = it & 1023, L = s ? 256 : 4096, nb = L >> 6, seq0 = s ? 0 : CTXL;
    const bf16_t* G0 = (s ? WSP(bf16_t, OFF_GCTX) : WSP(bf16_t, OFF_GLAT)) + (size_t)d * (2 * L); const bf16_t* G1 = G0 + (size_t)1024 * (2 * L);
    hy_fill_seq(p, VE, 2048 + d, L, nb, seq0);
    hy_fill_seq(p, ZE, d, L, nb, seq0);
    hy_fill_filter(FC, G0, L);
    __syncthreads();
    const bool active = 8 * q < nb;
    f32x16 acc[2];
    if (active) {
      hy_conv(acc, FC, VE, nb, q, r32, hi);
      const int a = 8 * q + (r32 >> 2), bb = r32 & 3;
      if (a < nb) {
#pragma unroll
        for (int i2 = 0; i2 < 2; ++i2)
#pragma unroll
          for (int r = 0; r < 16; ++r) { bf16_t* zp = ZE + (size_t)bb * HY_VEN + (a + 7) * 64 + i2 * 32 + crow(r, hi); *zp = f2bf(bf2f(*zp) * acc[i2][r]); }
      }
    }
    __syncthreads();
    hy_fill_seq(p, VE, 1024 + d, L, nb, seq0);
    hy_fill_filter(FC, G1, L);
    __syncthreads();
    if (active) {
      hy_conv(acc, FC, ZE, nb, q, r32, hi);
      const int a = 8 * q + (r32 >> 2), bb = r32 & 3;
      if (a < nb) {
#pragma unroll
        for (int i2 = 0; i2 < 2; ++i2)
#pragma unroll
          for (int r = 0; r < 16; ++r) { bf16_t* vp = VE + (size_t)bb * HY_VEN + (a + 7) * 64 + i2 * 32 + crow(r, hi); *vp = f2bf(bf2f(*vp) * acc[i2][r]); }
      }
    }
    __syncthreads();
    for (int e = tid; e < 4 * (L / 8); e += NTHR) {
      const int b = e / (L / 8), t0 = (e - b * (L / 8)) * 8;
      *(u32x4*)(YT + (size_t)d * T + b * RB + seq0 + t0) = *(const u32x4*)(VE + (size_t)b * HY_VEN + 7 * 64 + t0);
    }
    __syncthreads();
  }
}
__device__ __forceinline__ void job_transpose_y(const Params& p, char* lds) {
  bf16_t* tile = (bf16_t*)lds;
  const bf16_t* YT = WSP(bf16_t, OFF_RB); bf16_t* Ytr = WSP(bf16_t, OFF_RC);
  const int tid = otid();
  for (int it = blockIdx.x; it < 16 * 272; it += gridDim.x) {
    const int dt = it / 272, tt = it - dt * 272, d0 = dt * 64, t0 = tt * 64;
    for (int e = tid; e < 4096; e += NTHR) { const int dr = e >> 6, tc = e & 63; tile[dr * 66 + tc] = YT[(size_t)(d0 + dr) * T + t0 + tc]; }
    __syncthreads();
    for (int e = tid; e < 4096; e += NTHR) { const int tr = e >> 6, dc = e & 63; Ytr[(size_t)(t0 + tr) * 1024 + d0 + dc] = tile[dc * 66 + tr]; }
    __syncthreads();
  }
}
__device__ __forceinline__ void ins16(float (&L)[16], float x) {
#pragma unroll
  for (int i = 0; i < 16; ++i) { const float hi = __builtin_fmaxf(L[i], x); x = __builtin_fminf(L[i], x); L[i] = hi; }
}
__device__ __forceinline__ void job_topk(const Params& p) {
  const float* S = WSP(float, OFF_RA);
  const float NEG = -3.0e38f;
  for (int item = blockIdx.x * NTHR + otid(); item < T * 8; item += gridDim.x * NTHR) {
    const float* s1 = S + (size_t)item * 256;
    float L1[16], L2[16], L3[16];
#pragma unroll
    for (int i = 0; i < 16; ++i) { L1[i] = NEG; L2[i] = NEG; L3[i] = NEG; }
#pragma unroll 1
    for (int c = 0; c < 32; ++c) {
      const float4 v = *(const float4*)(s1 + c * 4);
      ins16(L1, __uint_as_float((__float_as_uint(v.x) & ~127u) | (unsigned)(c * 4 + 0)));
      ins16(L1, __uint_as_float((__float_as_uint(v.y) & ~127u) | (unsigned)(c * 4 + 1)));
      ins16(L1, __uint_as_float((__float_as_uint(v.z) & ~127u) | (unsigned)(c * 4 + 2)));
      ins16(L1, __uint_as_float((__float_as_uint(v.w) & ~127u) | (unsigned)(c * 4 + 3)));
    }
#pragma unroll 1
    for (int c = 0; c < 32; ++c) {
      const float4 v = *(const float4*)(s1 + 128 + c * 4);
      ins16(L2, __uint_as_float((__float_as_uint(v.x) & ~127u) | (unsigned)(c * 4 + 0)));
      ins16(L2, __uint_as_float((__float_as_uint(v.y) & ~127u) | (unsigned)(c * 4 + 1)));
      ins16(L2, __uint_as_float((__float_as_uint(v.z) & ~127u) | (unsigned)(c * 4 + 2)));
      ins16(L2, __uint_as_float((__float_as_uint(v.w) & ~127u) | (unsigned)(c * 4 + 3)));
    }
#pragma unroll
    for (int i = 0; i < 16; ++i)
#pragma unroll
      for (int j = 0; j < 16; ++j)
        if ((i + 1) * (j + 1) <= 16) {
          const float sum = __uint_as_float(__float_as_uint(L1[i]) & ~127u) + __uint_as_float(__float_as_uint(L2[j]) & ~127u);
          ins16(L3, __uint_as_float((__float_as_uint(sum) & ~255u) | (unsigned)(i * 16 + j)));
        }
    float ev[16]; float den = 0.f;
    const float mx = __uint_as_float(__float_as_uint(L3[0]) & ~255u);
#pragma unroll
    for (int k = 0; k < 16; ++k) { ev[k] = __expf(__uint_as_float(__float_as_uint(L3[k]) & ~255u) - mx); den += ev[k]; }
    const float rden = 1.f / den;
    int* ip = WSP(int, OFF_RC) + (size_t)item * 16; float* gp = WSP(float, OFF_RC + (size_t)T * 128 * 4) + (size_t)item * 16;
#pragma unroll
    for (int k = 0; k < 16; ++k) {
      const unsigned code = __float_as_uint(L3[k]) & 255u; const int ii = code >> 4, jj = code & 15;
      unsigned b1 = 0, b2 = 0;
#pragma unroll
      for (int i = 0; i < 16; ++i) { b1 = (ii == i) ? __float_as_uint(L1[i]) : b1; b2 = (jj == i) ? __float_as_uint(L2[i]) : b2; }
      ip[k] = (int)((b1 & 127u) * 128u + (b2 & 127u));
      gp[k] = ev[k] * rden;
    }
  }
}
__device__ __forceinline__ float gelu_as(float v) {
  const float t = __builtin_amdgcn_rcpf(fabsf(v) * 0.2316418882f + 1.0f);
  float q = t * 0.5307027145f + (-0.7265760135f); q = q * t + 0.7107068705f; q = q * t + (-0.142248368f); q = q * t + 0.127414796f; q = q * t;
  const float m = v * (q * __builtin_amdgcn_exp2f(v * v * (-0.72134752044f)));
  return v < 0.f ? m : v - m;
}
__device__ __forceinline__ void job_peer_gather(const Params& p, int layer) {
  const int lane = otid() & 63, wg = blockIdx.x * 8 + (otid() >> 6), nw = gridDim.x * 8;
  const unsigned char* U = WSP(unsigned char, OFF_PU) + (size_t)layer * 16384 * 1024; const unsigned char* V = WSP(unsigned char, OFF_PV) + (size_t)layer * 16384 * 1024;
  const float* SU = WSP(float, OFF_SU) + layer * 16384; const float* SV = WSP(float, OFF_SV) + layer * 16384;
  const float* lnw = p.in[6] + (size_t)(layer * 2 + 1) * 1024; const float* lnb = p.in[7] + (size_t)(layer * 2 + 1) * 1024;
  const bool last = layer == DEPTH - 1;
  for (int row = wg; row < T; row += nw) {
    const RowInfo ri = row_info(row);
    float hv[16];
    { const u32x4 a = *(const u32x4*)(WSP(bf16_t, OFF_H) + (size_t)row * 1024 + lane * 16), b = *(const u32x4*)(WSP(bf16_t, OFF_H) + (size_t)row * 1024 + lane * 16 + 8);
#pragma unroll
      for (int i = 0; i < 4; ++i) { hv[2 * i] = bflo(a[i]); hv[2 * i + 1] = bfhi(a[i]); hv[8 + 2 * i] = bflo(b[i]); hv[8 + 2 * i + 1] = bfhi(b[i]); } }
    float out[16];
    const int myidx0 = WSP(int, OFF_RC)[(size_t)row * 128 + lane], myidx1 = WSP(int, OFF_RC)[(size_t)row * 128 + 64 + lane];
    const float mysu0 = SU[myidx0], mysu1 = SU[myidx1];
    const float mygv0 = WSP(float, OFF_RC + (size_t)T * 128 * 4)[(size_t)row * 128 + lane] * SV[myidx0], mygv1 = WSP(float, OFF_RC + (size_t)T * 128 * 4)[(size_t)row * 128 + 64 + lane] * SV[myidx1];
#pragma unroll 1
    for (int rep_ = 0; rep_ < R_GATHER; ++rep_) {
#pragma unroll
    for (int i = 0; i < 16; ++i) out[i] = 0.f;
#pragma unroll 1
    for (int e0 = 0; e0 < 128; e0 += 8) {
      u32x4 uq[8], vq[8];
#pragma unroll
      for (int qq = 0; qq < 8; ++qq) {
        const int e = e0 + qq;
        const int id = __builtin_amdgcn_readlane(e0 < 64 ? myidx0 : myidx1, e & 63);
        uq[qq] = *(const u32x4*)(U + (size_t)id * 1024 + lane * 16); vq[qq] = *(const u32x4*)(V + (size_t)id * 1024 + lane * 16);
      }
      float d[8];
#pragma unroll
      for (int qq = 0; qq < 8; ++qq) {
        float dsum = 0.f;
#pragma unroll
        for (int i = 0; i < 4; ++i) { const f32x2_t lo = __builtin_amdgcn_cvt_pk_f32_fp8((int)uq[qq][i], false), hi = __builtin_amdgcn_cvt_pk_f32_fp8((int)uq[qq][i], true);
          dsum += hv[4 * i] * lo[0] + hv[4 * i + 1] * lo[1]; dsum += hv[4 * i + 2] * hi[0] + hv[4 * i + 3] * hi[1]; }
        d[qq] = dsum;
      }
      { const bool up = lane & 1;
#pragma unroll
        for (int j = 0; j < 4; ++j) { const float snd = up ? d[j] : d[j + 4], kp = up ? d[j + 4] : d[j]; d[j] = kp + __shfl_xor(snd, 1); } }
      { const bool up = lane & 2;
#pragma unroll
        for (int j = 0; j < 2; ++j) { const float snd = up ? d[j] : d[j + 2], kp = up ? d[j + 2] : d[j]; d[j] = kp + __shfl_xor(snd, 2); } }
      { const bool up = lane & 4; const float snd = up ? d[0] : d[1], kp = up ? d[1] : d[0]; d[0] = kp + __shfl_xor(snd, 4); }
      float tot = d[0];
      tot += __shfl_xor(tot, 8); tot += __shfl_xor(tot, 16); tot += __shfl_xor(tot, 32);
      const int ex = ((lane & 1) << 2) | (lane & 2) | ((lane >> 2) & 1);
      const float su_l = __shfl(e0 < 64 ? mysu0 : mysu1, (e0 + ex) & 63), gv_l = __shfl(e0 < 64 ? mygv0 : mygv1, (e0 + ex) & 63);
      const float cf_l = gv_l * gelu_as(tot * su_l);
#pragma unroll
      for (int qq = 0; qq < 8; ++qq) {
        const float cf = __uint_as_float(__builtin_amdgcn_readlane(__float_as_uint(cf_l), ((qq >> 2) & 1) | (((qq >> 1) & 1) << 1) | ((qq & 1) << 2)));
#pragma unroll
        for (int i = 0; i < 4; ++i) { const f32x2_t lo = __builtin_amdgcn_cvt_pk_f32_fp8((int)vq[qq][i], false), hi = __builtin_amdgcn_cvt_pk_f32_fp8((int)vq[qq][i], true);
          out[4 * i] += cf * lo[0]; out[4 * i + 1] += cf * lo[1]; out[4 * i + 2] += cf * hi[0]; out[4 * i + 3] += cf * hi[1]; }
      }
    }
    }
    const float* md = WSP(float, OFF_MOD) + ((size_t)layer * 5 + ri.mrow) * 6144;
    float* Xr = WSP(float, OFF_X) + (size_t)row * 1024;
    float r[16];
    { const int c0 = lane * 16;
#pragma unroll
      for (int i = 0; i < 16; ++i) r[i] = ALPHA * Xr[c0 + i] + md[5120 + c0 + i] * out[i]; }
    const float* mdn = WSP(float, OFF_MOD) + ((size_t)(last ? layer : layer + 1) * 5 + ri.mrow) * 6144;
    float* orow = (last && !ri.is_ctx) ? p.out + ((size_t)(ri.b * SEQ + ri.pos)) * 1024 : nullptr;
    ln_row_finish(r, lane * 16, lane * 16 + 8, lnw, lnb, Xr, last ? nullptr : WSP(bf16_t, OFF_H) + (size_t)row * 1024, mdn, mdn + 1024, orow);
  }
}

#define XB_TMO      128
#define XB_XCNT(j)  (256  + 64 * (j))
#define XB_XSUB(j)  (1280 + 64 * (j))
#define XB_XGEN(j)  (2304 + 64 * (j))
#define XB_TOP      3328
#define XB_TOPGEN   3392
#define XCD_BAR_WORDS 3456
#define XB_SPIN_CAP (1u << 22)
#define LAS __attribute__((address_space(3)))
__device__ __forceinline__ unsigned xb_ld(unsigned* p)              { return __hip_atomic_load(p, __ATOMIC_RELAXED, __HIP_MEMORY_SCOPE_AGENT); }
__device__ __forceinline__ unsigned xb_add(unsigned* p, unsigned v) { return __hip_atomic_fetch_add(p, v, __ATOMIC_RELAXED, __HIP_MEMORY_SCOPE_AGENT); }
__device__ __forceinline__ unsigned xb_xcc_id() { return (unsigned)__builtin_amdgcn_s_getreg((3 << 11) | 20) & 0xFu; }
#define XB_SPIN(cond, bar) do { unsigned _sp = 0; while (cond) { __builtin_amdgcn_s_sleep(1); \
    if ((++_sp & 255u) == 0u) { if (xb_ld(&(bar)[XB_TMO])) break; if (_sp > XB_SPIN_CAP) { atomicAdd(&(bar)[XB_TMO], 1u); break; } } } } while (0)
struct XcdBarrier { unsigned* bar; unsigned x; volatile LAS unsigned* st; };
__device__ __forceinline__ XcdBarrier xcd_barrier_post(unsigned* bar, volatile LAS unsigned* st) {
  XcdBarrier b; b.bar = bar; b.x = xb_xcc_id(); b.st = st;
  if (threadIdx.x == 0) (void)xb_add(&bar[XB_XCNT(b.x)], 1u);
  return b;
}
__device__ __forceinline__ void xcd_barrier_complete(unsigned* bar, unsigned x, unsigned& nloc, unsigned& nx) {
  const unsigned G = gridDim.x * gridDim.y * gridDim.z;
  unsigned sum, cnt, mine, sp = 0u;
  for (;;) {
    sum = 0u; cnt = 0u; mine = 0u;
#pragma unroll
    for (unsigned j = 0; j < 16; ++j) { const unsigned c = xb_ld(&bar[XB_XCNT(j)]); sum += c; cnt += (c > 0u) ? 1u : 0u; mine = (j == x) ? c : mine; }
    if (sum == G) break;
    __builtin_amdgcn_s_sleep(1);
    if ((++sp & 255u) == 0u) { if (xb_ld(&bar[XB_TMO])) break; if (sp > XB_SPIN_CAP) { atomicAdd(&bar[XB_TMO], 1u); break; } }
  }
  nloc = mine > 0u ? mine : 1u; nx = cnt > 0u ? cnt : 1u;
}
__device__ __forceinline__ void xcd_barrier(const XcdBarrier& b) {
  asm volatile("s_waitcnt vmcnt(0)" ::: "memory");
  __syncthreads();
  if (threadIdx.x == 0) {
    unsigned* bar = b.bar;
    __builtin_amdgcn_s_waitcnt(0);
    unsigned nloc = b.st[0], nx = b.st[1];
    if (nloc == 0u) { xcd_barrier_complete(bar, b.x, nloc, nx); b.st[0] = nloc; b.st[1] = nx; }
    const unsigned old = xb_add(&bar[XB_XSUB(b.x)], 1u);
    const unsigned gen = old / nloc;
    if (old + 1u == (gen + 1u) * nloc) {
      __builtin_amdgcn_fence(__ATOMIC_RELEASE, "agent");
      asm volatile("s_waitcnt vmcnt(0)" ::: "memory");
      const unsigned og = xb_add(&bar[XB_TOP], 1u);
      const unsigned tg = og / nx;
      if (og + 1u == (tg + 1u) * nx) xb_add(&bar[XB_TOPGEN], 1u);
      else XB_SPIN(xb_ld(&bar[XB_TOPGEN]) == tg, bar);
      __builtin_amdgcn_fence(__ATOMIC_ACQUIRE, "agent");
      xb_add(&bar[XB_XGEN(b.x)], 1u);
      asm volatile("s_waitcnt vmcnt(0)" ::: "memory");
    } else {
      XB_SPIN(xb_ld(&bar[XB_XGEN(b.x)]) == gen, bar);
      __builtin_amdgcn_fence(__ATOMIC_ACQUIRE, "agent");
      asm volatile("s_waitcnt vmcnt(0)" ::: "memory");
    }
  }
  __syncthreads();
}

constexpr int PARAM_LDS = 512;
constexpr int LDS_BYTES = PARAM_LDS + HY_LDS;
static_assert(HY_LDS >= ATT_LDS && HY_LDS >= 2 * G_ASZ + 2 * G_BSZ, "LDS budget");
static_assert(sizeof(Params) <= PARAM_LDS && sizeof(Params) == 41 * 8, "Params layout");
__device__ __forceinline__ Params load_params(const char* lds) {
  int off = 0; asm volatile("" : "+v"(off));
  const unsigned* lp = (const unsigned*)(lds + off);
  Params p;
#pragma unroll
  for (int k = 0; k < 38; ++k) {
    const unsigned lo = __builtin_amdgcn_readfirstlane(lp[2 * k]), hi = __builtin_amdgcn_readfirstlane(lp[2 * k + 1]);
    p.in[k] = (const float*)(((unsigned long long)hi << 32) | lo);
  }
  { const unsigned lo = __builtin_amdgcn_readfirstlane(lp[76]), hi = __builtin_amdgcn_readfirstlane(lp[77]); p.out = (float*)(((unsigned long long)hi << 32) | lo); }
  { const unsigned lo = __builtin_amdgcn_readfirstlane(lp[78]), hi = __builtin_amdgcn_readfirstlane(lp[79]); p.ws = (char*)(((unsigned long long)hi << 32) | lo); }
  p.ph_begin = 0; p.ph_end = 0;
  return p;
}
__global__ void __launch_bounds__(NTHR) mega(const Params kp) {
  extern __shared__ __attribute__((aligned(16))) char lds_all[];
  cg::grid_group grid = cg::this_grid();
  if (threadIdx.x == 0) {
    unsigned long long* lp = (unsigned long long*)lds_all;
#pragma unroll
    for (int k = 0; k < 38; ++k) lp[k] = (unsigned long long)kp.in[k];
    lp[38] = (unsigned long long)kp.out; lp[39] = (unsigned long long)kp.ws;
  }
  if (threadIdx.x == 0) { volatile LAS unsigned* st0 = (volatile LAS unsigned*)(lds_all + 384); st0[0] = 0u; st0[1] = 0u; st0[2] = 0u; st0[3] = 0u; }
  __syncthreads();
  char* lds = lds_all + PARAM_LDS;
  const int ph_begin = kp.ph_begin, ph_end = kp.ph_end;
  (void)xcd_barrier_post((unsigned*)(kp.ws + OFF_BAR), (volatile LAS unsigned*)(lds_all + 384));
  int ph = 0;
#define PHASER(reps, ...) do { if (ph >= ph_begin && ph < ph_end) { const Params p = load_params(lds_all); for (int rep_ = 0; rep_ < (reps); ++rep_) { __VA_ARGS__; } \
    if (ph + 1 < ph_end) { for (int rs_ = 0; rs_ < R_SYNC; ++rs_) { if (ph == 0) grid.sync(); else xcd_barrier(XcdBarrier{(unsigned*)(p.ws + OFF_BAR), xb_xcc_id(), (volatile LAS unsigned*)(lds_all + 384)}); } } } ++ph; } while (0)
#define PHASE(...) PHASER(1, __VA_ARGS__)
  PHASER(R_PRO, job_wconv(p, lds); job_adaln_partial(p, lds); job_hdn(p, lds); job_peer_conv(p));
  PHASER(R_PRO, job_mod_final(p); job_gbuild(p, lds));
  PHASER(R_PRO, job_init(p));
#pragma unroll 1
  for (int layer = 0; layer < DEPTH; ++layer) {
    const int kind = layer % 3;
    if (kind == 0) {
      const int ia = layer / 3;
      PHASER(R_GEMM, gemm_job(WSP(bf16_t, OFF_H), 1024, WSP(bf16_t, OFF_W1 + (size_t)ia * SZ_W1), 1024, T, 1152, 1024, false, EpiF32{WSP(float, OFF_RA), 1152, 1152, nullptr}, lds));
      PHASE(job_mla_norm(p, ia));
      PHASER(R_GEMM, gemm_job(WSP(bf16_t, OFF_RE), 768, WSP(bf16_t, OFF_WUQ + (size_t)ia * SZ_WUQ), 768, T, 1536, 768, false, EpiMlaQ{WSP(bf16_t, OFF_RB)}, lds);
            gemm_job(WSP(bf16_t, OFF_RE) + (size_t)T * 768, 256, WSP(bf16_t, OFF_WUKV + (size_t)ia * SZ_WUKV), 256, T, 2048, 256, false, EpiMlaKV{WSP(bf16_t, OFF_RC), WSP(bf16_t, OFF_RD)}, lds));
      PHASER(R_ATTN, job_attn_mla(p, lds));
      PHASER(R_GEMM, gemm_job(WSP(bf16_t, OFF_RF), 1024, WSP(bf16_t, OFF_WOA + (size_t)ia * SZ_WSQ), 1024, T, 1024, 1024, false, EpiF32{WSP(float, OFF_Y), 1024, 1024, nullptr}, lds));
      PHASE(job_ln1(p, layer));
    } else if (kind == 1) {
      PHASER(R_GEMM, gemm_job(WSP(bf16_t, OFF_WIN), 1024, WSP(bf16_t, OFF_H), 1024, 3072, T, 1024, false, EpiZT{WSP(bf16_t, OFF_RA), T, p.in[16]}, lds));
      PHASER(R_HYENA, job_hyena(p, 0, lds));
      PHASE(job_transpose_y(p, lds));
      PHASER(R_GEMM, gemm_job(WSP(bf16_t, OFF_RC), 1024, WSP(bf16_t, OFF_WOUT), 1024, T, 1024, 1024, false, EpiF32{WSP(float, OFF_Y), 1024, 1024, p.in[28]}, lds));
      PHASE(job_ln1(p, layer));
    } else {
      PHASER(R_GEMM, gemm_job(WSP(bf16_t, OFF_H), 1024, WSP(bf16_t, OFF_WQKV), 1024, T, 1536, 1024, false, EpiF32{WSP(float, OFF_RA), 1536, 1536, nullptr}, lds));
      PHASE(job_gqa_norm(p));
      PHASER(R_ATTN, job_attn_gqa(p, lds));
      PHASER(R_GEMM, gemm_job(WSP(bf16_t, OFF_RF), 1024, WSP(bf16_t, OFF_WOC), 1024, T, 1024, 1024, false, EpiF32{WSP(float, OFF_Y), 1024, 1024, nullptr}, lds));
      PHASE(job_ln1(p, layer));
    }
    PHASER(R_GEMM, gemm_job(WSP(bf16_t, OFF_H), 1024, WSP(bf16_t, OFF_WQ + (size_t)layer * SZ_WQ), 1024, T, 2048, 1024, false, EpiBf16{WSP(bf16_t, OFF_RB), 2048}, lds));
    PHASER(R_GEMM, gemm_job(WSP(bf16_t, OFF_RB), 2048, WSP(bf16_t, OFF_KEYS) + (size_t)layer * 16 * 16384, 128, T, 2048, 128, true, EpiF32{WSP(float, OFF_RA), 2048, 2048, nullptr}, lds));
    PHASER(R_TOPK, job_topk(p));
    PHASE(job_peer_gather(p, layer));
  }
#undef PHASE
#undef PHASER
}


#ifndef CUT_PHASE
#define CUT_PHASE NPHASES
#endif
#ifndef DUMP_OFF
#define DUMP_OFF OFF_RB
#endif
__global__ void __launch_bounds__(NTHR) dump_x(const Params p) {
  const size_t n4 = (size_t)NBATCH * SEQ * 256;
  for (size_t i = (size_t)blockIdx.x * NTHR + threadIdx.x; i < n4; i += (size_t)gridDim.x * NTHR)
    *(float4*)(p.out + i * 4) = *(const float4*)(WSP(float, DUMP_OFF) + i * 4);
}
extern "C" void kernel_launch(void* const* d_in, const int* in_sizes, int n_in, void* d_out, int out_size, void* d_ws, size_t ws_size, hipStream_t stream) {
  static int grid_blocks = 0;
  if (!grid_blocks) {
    int dev = 0, cus = 0, per_cu = 0;
    (void)hipGetDevice(&dev);
    (void)hipDeviceGetAttribute(&cus, hipDeviceAttributeMultiprocessorCount, dev);
    if (hipFuncSetAttribute((const void*)mega, hipFuncAttributeMaxDynamicSharedMemorySize, LDS_BYTES) != hipSuccess) fprintf(stderr, "kernel_launch: hipFuncSetAttribute failed\n");
    (void)hipOccupancyMaxActiveBlocksPerMultiprocessor(&per_cu, mega, NTHR, LDS_BYTES);
    if (per_cu < 1) { fprintf(stderr, "kernel_launch: occupancy query returned %d\n", per_cu); per_cu = 1; }
    if (per_cu > 1) per_cu = 1;
    grid_blocks = cus * per_cu;
  }
  if (n_in != 38 || WS_TOTAL > ws_size) { fprintf(stderr, "kernel_launch: bad call: n_in %d, workspace need %zu have %zu\n", n_in, (size_t)WS_TOTAL, ws_size); return; }
  Params p; memset(&p, 0, sizeof(p));
  for (int i = 0; i < 38; ++i) p.in[i] = (const float*)d_in[i];
  p.out = (float*)d_out; p.ws = (char*)d_ws;
  (void)hipMemsetAsync((char*)d_ws + OFF_BAR, 0, 16384, stream);
#if ONE_LAUNCH
  p.ph_begin = 0; p.ph_end = NPHASES;
  void* args[] = {(void*)&p};
  hipError_t e = hipLaunchCooperativeKernel((const void*)mega, dim3(grid_blocks), dim3(NTHR), args, LDS_BYTES, stream);
  if (e != hipSuccess) fprintf(stderr, "kernel_launch: cooperative launch failed: %s (grid %d)\n", hipGetErrorString(e), grid_blocks);
#else
  for (int ph = 0; ph < CUT_PHASE; ++ph) {
    p.ph_begin = ph; p.ph_end = ph + 1;
    hipLaunchKernelGGL(mega, dim3(grid_blocks), dim3(NTHR), LDS_BYTES, stream, p);
  }
  if (CUT_PHASE < NPHASES) hipLaunchKernelGGL(dump_x, dim3(1024), dim3(NTHR), 0, stream, p);
#endif
}
```

```cpp
#include <hip/hip_runtime.h>
#include <hip/hip_cooperative_groups.h>
#include <cstdio>
#include <cstdint>
#include <cstring>
namespace cg = cooperative_groups;

#ifndef ONE_LAUNCH
#define ONE_LAUNCH 1
#endif
#ifndef R_GEMM
#define R_GEMM 1
#endif
#ifndef R_ATTN
#define R_ATTN 1
#endif
#ifndef R_HYENA
#define R_HYENA 1
#endif
#ifndef R_TOPK
#define R_TOPK 1
#endif
#ifndef R_GATHER
#define R_GATHER 1
#endif
#ifndef R_SYNC
#define R_SYNC 1
#endif
#ifndef R_PRO
#define R_PRO 1
#endif
#ifndef PROBE_PH
#define PROBE_PH -1
#endif

constexpr int D = 1024, NBATCH = 4, SEQ = 4096, CTXL = 256, RB = 4352, T = 17408, DEPTH = 4;
constexpr float ALPHA = 1.6817928305074290f;
constexpr int NTHR = 512;
constexpr int NPHASES = 37;

typedef unsigned short bf16_t;
#define LAS __attribute__((address_space(3)))
#define GAS __attribute__((address_space(1)))
using bf16x8 = __attribute__((ext_vector_type(8))) short;
using s16x4  = __attribute__((ext_vector_type(4))) short;
using f32x16 = __attribute__((ext_vector_type(16))) float;
using u32x4  = __attribute__((ext_vector_type(4))) unsigned;
using u32x2  = __attribute__((ext_vector_type(2))) unsigned;

typedef __bf16 bf16x2_t __attribute__((ext_vector_type(2)));
typedef float f32x2_t __attribute__((ext_vector_type(2)));
typedef _Float16 h16x2 __attribute__((ext_vector_type(2)));
__device__ __forceinline__ unsigned cvtpk(float lo, float hi) { f32x2_t v = {lo, hi}; bf16x2_t b = __builtin_convertvector(v, bf16x2_t); return __builtin_bit_cast(unsigned, b); }
__device__ __forceinline__ bf16_t f2bf(float x) { __bf16 b = (__bf16)x; return __builtin_bit_cast(unsigned short, b); }
__device__ __forceinline__ unsigned cvtpk_asm(float lo, float hi) { unsigned r; asm volatile("v_cvt_pk_bf16_f32 %0, %1, %2" : "=v"(r) : "v"(lo), "v"(hi)); return r; }
__device__ __forceinline__ float bf2f(bf16_t u) { return __uint_as_float(((unsigned)u) << 16); }
__device__ __forceinline__ float bflo(unsigned w) { return __uint_as_float(w << 16); }
__device__ __forceinline__ float bfhi(unsigned w) { return __uint_as_float(w & 0xffff0000u); }
__device__ __forceinline__ int crow(int r, int hi) { return (r & 3) + 8 * (r >> 2) + 4 * hi; }
__device__ __forceinline__ int xl1(int x) { return __builtin_amdgcn_update_dpp(x, x, 0xB1, 0xF, 0xF, false); }
__device__ __forceinline__ int xl2(int x) { return __builtin_amdgcn_update_dpp(x, x, 0x4E, 0xF, 0xF, false); }
__device__ __forceinline__ int xl4(int x) { const int t = __builtin_amdgcn_update_dpp(x, x, 0x104, 0xF, 0x5, false); return __builtin_amdgcn_update_dpp(t, x, 0x114, 0xF, 0xA, false); }
__device__ __forceinline__ int xl8(int x) { return __builtin_amdgcn_update_dpp(x, x, 0x128, 0xF, 0xF, false); }
__device__ __forceinline__ float xl1f(float x) { return __int_as_float(xl1(__float_as_int(x))); }
__device__ __forceinline__ float xl2f(float x) { return __int_as_float(xl2(__float_as_int(x))); }
__device__ __forceinline__ float xl4f(float x) { return __int_as_float(xl4(__float_as_int(x))); }
__device__ __forceinline__ float xl8f(float x) { return __int_as_float(xl8(__float_as_int(x))); }
__device__ __forceinline__ int sum_x16(int x) { const auto r = __builtin_amdgcn_permlane16_swap((unsigned)x, (unsigned)x, false, false); return (int)r[0] + (int)r[1]; }
__device__ __forceinline__ int sum_x32(int x) { const auto r = __builtin_amdgcn_permlane32_swap((unsigned)x, (unsigned)x, false, false); return (int)r[0] + (int)r[1]; }
__device__ __forceinline__ float sum_x16f(float x) { const auto r = __builtin_amdgcn_permlane16_swap(__float_as_uint(x), __float_as_uint(x), false, false); return __uint_as_float(r[0]) + __uint_as_float(r[1]); }
__device__ __forceinline__ float sum_x32f(float x) { const auto r = __builtin_amdgcn_permlane32_swap(__float_as_uint(x), __float_as_uint(x), false, false); return __uint_as_float(r[0]) + __uint_as_float(r[1]); }
__device__ __forceinline__ float max_x16f(float x) { const auto r = __builtin_amdgcn_permlane16_swap(__float_as_uint(x), __float_as_uint(x), false, false); return fmaxf(__uint_as_float(r[0]), __uint_as_float(r[1])); }
__device__ __forceinline__ float max_x32f(float x) { const auto r = __builtin_amdgcn_permlane32_swap(__float_as_uint(x), __float_as_uint(x), false, false); return fmaxf(__uint_as_float(r[0]), __uint_as_float(r[1])); }
__device__ __forceinline__ float wsum(float v) { v += xl1f(v); v += xl2f(v); v += xl4f(v); v += xl8f(v); v = sum_x16f(v); return sum_x32f(v); }
__device__ __forceinline__ float wmax(float v) { v = fmaxf(v, xl1f(v)); v = fmaxf(v, xl2f(v)); v = fmaxf(v, xl4f(v)); v = fmaxf(v, xl8f(v)); v = max_x16f(v); return max_x32f(v); }
__device__ __forceinline__ int otid() { int t = threadIdx.x; asm volatile("" : "+v"(t)); return t; }
__device__ __forceinline__ float sin_rev(float rev) { return __builtin_amdgcn_sinf(rev); }
__device__ __forceinline__ float cos_rev(float rev) { return __builtin_amdgcn_cosf(rev); }
__device__ __forceinline__ float sin_rad(float x) { return __builtin_amdgcn_sinf(x * 0.15915494309189535f); }

struct Params { const float* in[38]; float* out; char* ws; int ph_begin, ph_end; };
constexpr size_t al256c(size_t x) { return (x + 255) & ~(size_t)255; }
constexpr size_t SZ_W1 = al256c((size_t)1152 * 1024 * 2), SZ_WUQ = al256c((size_t)1536 * 768 * 2), SZ_WUKV = al256c((size_t)2048 * 256 * 2), SZ_WSQ = al256c((size_t)1024 * 1024 * 2),
                 SZ_WQ = al256c((size_t)2048 * 1024 * 2);
constexpr size_t OFF_BAR  = 0;
constexpr size_t OFF_MODP = 16384;
constexpr size_t OFF_MOD  = OFF_MODP + al256c((size_t)8 * 4 * 5 * 6144 * 4);
constexpr size_t OFF_HDN  = OFF_MOD + al256c((size_t)4 * 5 * 6144 * 4);
constexpr size_t OFF_GLAT = OFF_HDN + al256c((size_t)2 * 4096 * 64 * 4);
constexpr size_t OFF_GCTX = OFF_GLAT + al256c((size_t)2 * 1024 * 8336 * 2);
constexpr size_t OFF_W1   = OFF_GCTX + al256c((size_t)2 * 1024 * 656 * 2);
constexpr size_t OFF_WUQ  = OFF_W1 + 2 * SZ_W1;
constexpr size_t OFF_WUKV = OFF_WUQ + 2 * SZ_WUQ;
constexpr size_t OFF_WOA  = OFF_WUKV + 2 * SZ_WUKV;
constexpr size_t OFF_WIN  = OFF_WOA + 2 * SZ_WSQ;
constexpr size_t OFF_WOUT = OFF_WIN + al256c((size_t)3072 * 1024 * 2);
constexpr size_t OFF_WQKV = OFF_WOUT + SZ_WSQ;
constexpr size_t OFF_WOC  = OFF_WQKV + al256c((size_t)1536 * 1024 * 2);
constexpr size_t OFF_WQ   = OFF_WOC + SZ_WSQ;
constexpr size_t OFF_KEYS = OFF_WQ + 4 * SZ_WQ;
constexpr size_t OFF_PU   = OFF_KEYS + al256c((size_t)4 * 16 * 16384 * 2);
constexpr size_t OFF_PV   = OFF_PU + (size_t)4 * 16384 * 1024;
constexpr size_t OFF_SU   = OFF_PV + (size_t)4 * 16384 * 1024;
constexpr size_t OFF_SV   = OFF_SU + (size_t)4 * 16384 * 4;
constexpr size_t OFF_X    = OFF_SV + (size_t)4 * 16384 * 4;
constexpr size_t OFF_H    = OFF_X + (size_t)T * 1024 * 4;
constexpr size_t OFF_Y    = OFF_H + (size_t)T * 1024 * 2;
constexpr size_t OFF_RA   = OFF_Y + (size_t)T * 1024 * 4;
constexpr size_t OFF_RB   = OFF_RA + (size_t)T * 2048 * 4;
constexpr size_t OFF_RC   = OFF_RB + (size_t)T * 2048 * 2;
constexpr size_t OFF_RD   = OFF_RC + (size_t)T * 1536 * 2;
constexpr size_t OFF_RE   = OFF_RD + (size_t)T * 1024 * 2;
constexpr size_t OFF_RF   = OFF_RE + (size_t)T * 1024 * 2;
constexpr size_t OFF_LST  = OFF_RF + (size_t)T * 1024 * 2;
constexpr size_t WS_TOTAL = OFF_LST + al256c((size_t)T * 2 * 4);
#define WSP(type, off) ((type*)(p.ws + (off)))

struct RowInfo { int b, rb, is_ctx, pos, mrow; };
__device__ __forceinline__ RowInfo row_info(int row) {
  RowInfo r; r.b = row / RB; r.rb = row - r.b * RB; r.is_ctx = r.rb < CTXL; r.pos = r.rb - CTXL; r.mrow = r.is_ctx ? 4 : r.b; return r;
}
__device__ __forceinline__ void rope_cs(int pos, int i, int quarter, float& c, float& s) {
  const int j = i < quarter ? i : i - quarter;
  const float inv = exp2f(-13.287712379549449f * (float)j / (float)quarter);
  const float p = (float)(i < quarter ? (pos >> 6) : (pos & 63));
  const float rev = p * inv * 0.15915494309189535f;
  c = cos_rev(rev); s = sin_rev(rev);
}

__device__ __forceinline__ void ce_desc(float& a, float& b) { const float hi = __builtin_fmaxf(a, b), lo = __builtin_fminf(a, b); a = hi; b = lo; }
__device__ __forceinline__ void bmerge16(float (&a)[16]) {
#pragma unroll
  for (int j = 8; j > 0; j >>= 1)
#pragma unroll
    for (int i = 0; i < 16; ++i) if ((i & j) == 0) ce_desc(a[i], a[i | j]);
}
__device__ __forceinline__ void bsort16(float (&a)[16]) {
#pragma unroll
  for (int k = 2; k <= 16; k <<= 1)
#pragma unroll
    for (int j = k >> 1; j > 0; j >>= 1)
#pragma unroll
      for (int i = 0; i < 16; ++i) { const int l = i ^ j; if (l > i) { if ((i & k) == 0 || k == 16) ce_desc(a[i], a[l]); else ce_desc(a[l], a[i]); } }
}
__device__ __forceinline__ void merge_top16(float (&top)[16], const float (&g)[16]) {
#pragma unroll
  for (int i = 0; i < 16; ++i) top[i] = __builtin_fmaxf(top[i], g[15 - i]);
  bmerge16(top);
}
struct EpiPeerTopk { static constexpr bool QUAD = false, TOPK = true, RESID = false; const bf16_t* keys; float* topl;
  __device__ __forceinline__ void operator()(int, int, float) const {} };
template <int WSH, int NI, int NJ>
__device__ __forceinline__ void peer_topk_epilogue(const f32x16 (&acc)[NI][NJ], const EpiPeerTopk& e, int m0, int n0, char* lds) {
  constexpr int BM = (8 >> WSH) * NI * 32;
  const int tid = otid(), lane = tid & 63, wid = tid >> 6, wm = wid >> WSH, wn = wid & ((1 << WSH) - 1), r32 = lane & 31, hi = lane >> 5;
  char* Qs = lds; char* Ks = lds + 65536;
#pragma unroll
  for (int i = 0; i < NI; ++i)
#pragma unroll
    for (int j = 0; j < NJ; ++j)
#pragma unroll
      for (int r = 0; r < 16; ++r) { const int row = wm * (NI * 32) + i * 32 + crow(r, hi), col = wn * (NJ * 32) + j * 32 + r32;
        *(bf16_t*)(Qs + row * 256 + (((col >> 3) ^ (row & 7)) << 4) + (col & 7) * 2) = f2bf(acc[i][j][r]); }
  const bf16_t* kg = e.keys + (size_t)(n0 >> 7) * 16384;
#pragma unroll
  for (int c = 0; c < 4; ++c) { const int id = tid + NTHR * c, row = id >> 4, ch = id & 15; *(u32x4*)(Ks + row * 256 + ((ch ^ (row & 7)) << 4)) = *(const u32x4*)(kg + row * 128 + ch * 8); }
  __syncthreads();
  if (wid * 32 < BM) {
    bf16x8 bq[8];
#pragma unroll
    for (int ks = 0; ks < 8; ++ks) bq[ks] = *(const bf16x8*)(Qs + (wid * 32 + r32) * 256 + (((ks * 2 + hi) ^ (r32 & 7)) << 4));
    float top[16];
#pragma unroll
    for (int kt = 0; kt < 4; ++kt) {
      f32x16 sc = f32x16{};
#pragma unroll
      for (int ks = 0; ks < 8; ++ks) { const bf16x8 a = *(const bf16x8*)(Ks + (kt * 32 + r32) * 256 + (((ks * 2 + hi) ^ (r32 & 7)) << 4)); sc = __builtin_amdgcn_mfma_f32_32x32x16_bf16(a, bq[ks], sc, 0, 0, 0); }
      float g[16];
#pragma unroll
      for (int r = 0; r < 16; ++r) g[r] = __uint_as_float((__float_as_uint(sc[r]) & ~127u) | (unsigned)(kt * 32 + crow(r, hi)));
      bsort16(g);
      if (kt == 0) {
#pragma unroll
        for (int q = 0; q < 16; ++q) top[q] = g[q];
      } else merge_top16(top, g);
    }
    float oth[16];
#pragma unroll
    for (int q = 0; q < 16; ++q) { const auto r_ = __builtin_amdgcn_permlane32_swap(__float_as_uint(top[q]), __float_as_uint(top[q]), false, false); oth[q] = __uint_as_float(hi ? r_[0] : r_[1]); }
    merge_top16(top, oth);
    if (hi == 0) {
      float* dst = e.topl + ((size_t)(m0 + wid * 32 + r32) * 16 + (n0 >> 7)) * 16;
#pragma unroll
      for (int q = 0; q < 4; ++q) *(float4*)(dst + 4 * q) = make_float4(top[4 * q], top[4 * q + 1], top[4 * q + 2], top[4 * q + 3]);
    }
  }
  __syncthreads();
}

struct EpiResid { static constexpr bool QUAD = false, TOPK = false, RESID = true; bf16_t* X; const float* gmod  ; const float* bias;
  __device__ __forceinline__ void operator()(int, int, float) const {} };
template <int WSH, int NI, int NJ>
__device__ __forceinline__ void resid_epilogue(const f32x16 (&acc)[NI][NJ], const EpiResid& e, int m0, int n0) {
  const int tid = otid(), lane = tid & 63, wid = tid >> 6, wm = wid >> WSH, wn = wid & ((1 << WSH) - 1), r32 = lane & 31, hi = lane >> 5;
  const float* g = e.gmod + (size_t)row_info(m0).mrow * 6144;
#pragma unroll
  for (int j = 0; j < NJ; ++j) {
    const int col = n0 + wn * (NJ * 32) + j * 32 + r32;
    const float gj = g[col], bj = e.bias ? e.bias[col] : 0.f;
#pragma unroll
    for (int i = 0; i < NI; ++i) {
      float xv[16];
#pragma unroll
      for (int r = 0; r < 16; ++r) xv[r] = bf2f(e.X[(size_t)(m0 + wm * (NI * 32) + i * 32 + crow(r, hi)) * 1024 + col]);
#pragma unroll
      for (int r = 0; r < 16; ++r) e.X[(size_t)(m0 + wm * (NI * 32) + i * 32 + crow(r, hi)) * 1024 + col] = f2bf(ALPHA * xv[r] + gj * (acc[i][j][r] + bj));
    }
  }
}

__device__ __forceinline__ int gswz(int row, int chunk) { return row * 128 + ((chunk ^ ((row >> 1) & 7)) << 4); }
constexpr int G_ASZ = 256 * 128, G_BSZ = 128 * 128;
template <class Epi, int WSH, int NI, int NJ>
__device__ __forceinline__ void gemm_tile(const bf16_t* __restrict__ A, int lda, const bf16_t* __restrict__ Bt, int ldb, int K, int m0, int n0, int acol0,
                                          const Epi& epi, char* lds) {
  constexpr int BM = (8 >> WSH) * NI * 32, CA = BM / 64;
  constexpr int KH = (BM == 64) ? 2 : 1;
  constexpr int A_ST = KH == 1 ? G_ASZ : KH * BM * 128, B_ST = KH == 1 ? G_BSZ : KH * 128 * 128;
  static_assert((1 << WSH) * NJ * 32 == 128, "BN is 128");
  static_assert(2 * A_ST + 2 * B_ST <= 2 * G_ASZ + 2 * G_BSZ, "LDS");
  const int tid = otid(), lane = tid & 63, wid = tid >> 6, wm = wid >> WSH, wn = wid & ((1 << WSH) - 1), r32 = lane & 31, hi = lane >> 5;
  char* As = lds; char* Bs = lds + 2 * A_ST;
  f32x16 acc[NI][NJ];
#pragma unroll
  for (int i = 0; i < NI; ++i)
#pragma unroll
    for (int j = 0; j < NJ; ++j) acc[i][j] = f32x16{};
  u32x4 ra[KH][CA], rb[KH][2];
  const int srow = tid >> 3, sch = tid & 7;
  const bf16_t* Ap = A + (size_t)(m0 + srow) * lda + acol0 + sch * 8;
  const bf16_t* Bp = Bt + (size_t)(n0 + srow) * ldb + sch * 8;
  const int nk = K / (64 * KH);
#define G_LOAD(kt) do { _Pragma("unroll") for (int h_ = 0; h_ < KH; ++h_) { \
                        _Pragma("unroll") for (int c_ = 0; c_ < CA; ++c_) ra[h_][c_] = *(const u32x4*)(Ap + (size_t)(c_ * 64) * lda + ((kt) * KH + h_) * 64); \
                        _Pragma("unroll") for (int c_ = 0; c_ < 2; ++c_) rb[h_][c_] = *(const u32x4*)(Bp + (size_t)(c_ * 64) * ldb + ((kt) * KH + h_) * 64); } } while (0)
#define G_STORE(buf) do { _Pragma("unroll") for (int h_ = 0; h_ < KH; ++h_) { \
                          _Pragma("unroll") for (int c_ = 0; c_ < CA; ++c_) *(u32x4*)(As + (buf) * A_ST + h_ * (BM * 128) + gswz(srow + c_ * 64, sch)) = ra[h_][c_]; \
                          _Pragma("unroll") for (int c_ = 0; c_ < 2; ++c_) *(u32x4*)(Bs + (buf) * B_ST + h_ * (128 * 128) + gswz(srow + c_ * 64, sch)) = rb[h_][c_]; } } while (0)
  G_LOAD(0); G_STORE(0); __syncthreads();
  for (int kt = 0; kt < nk; ++kt) {
    if (kt + 1 < nk) G_LOAD(kt + 1);
    __builtin_amdgcn_sched_barrier(0);
#pragma unroll
    for (int h = 0; h < KH; ++h) {
      const char* Ab = As + (kt & 1) * A_ST + h * (BM * 128); const char* Bb = Bs + (kt & 1) * B_ST + h * (128 * 128);
#pragma unroll
      for (int ks = 0; ks < 4; ++ks) {
        bf16x8 af[NI], bfr[NJ];
#pragma unroll
        for (int i = 0; i < NI; ++i) af[i] = *(const bf16x8*)(Ab + gswz(wm * (NI * 32) + i * 32 + r32, ks * 2 + hi));
#pragma unroll
        for (int j = 0; j < NJ; ++j) bfr[j] = *(const bf16x8*)(Bb + gswz(wn * (NJ * 32) + j * 32 + r32, ks * 2 + hi));
#pragma unroll
        for (int i = 0; i < NI; ++i)
#pragma unroll
          for (int j = 0; j < NJ; ++j) acc[i][j] = __builtin_amdgcn_mfma_f32_32x32x16_bf16(af[i], bfr[j], acc[i][j], 0, 0, 0);
      }
    }
    __builtin_amdgcn_sched_barrier(0);
    if (kt + 1 < nk) G_STORE((kt + 1) & 1);
    __syncthreads();
  }
#undef G_LOAD
#undef G_STORE
  if constexpr (Epi::TOPK) { peer_topk_epilogue<WSH, NI, NJ>(acc, epi, m0, n0, lds); return; }
  if constexpr (Epi::RESID) { resid_epilogue<WSH, NI, NJ>(acc, epi, m0, n0); return; }
  if constexpr (Epi::QUAD) {
#pragma unroll
    for (int i = 0; i < NI; ++i)
#pragma unroll
      for (int j = 0; j < NJ; ++j)
#pragma unroll
        for (int g = 0; g < 4; ++g) epi.quad(m0 + wm * (NI * 32) + i * 32 + 8 * g + 4 * hi, n0 + wn * (NJ * 32) + j * 32 + r32, acc[i][j][4 * g], acc[i][j][4 * g + 1], acc[i][j][4 * g + 2], acc[i][j][4 * g + 3]);
  } else {
#pragma unroll
    for (int i = 0; i < NI; ++i)
#pragma unroll
      for (int j = 0; j < NJ; ++j)
#pragma unroll
        for (int r = 0; r < 16; ++r) epi(m0 + wm * (NI * 32) + i * 32 + crow(r, hi), n0 + wn * (NJ * 32) + j * 32 + r32, acc[i][j][r]);
  }
}
template <class Epi>
__device__ __forceinline__ void gemm_job(const bf16_t* A, int lda, const bf16_t* Bt, int ldb, int M, int N, int K, bool grouped, bool tok_n, const Epi& epi, char* lds, bool skip_ctx = false) {
  const int ntn = N / 128, ntm = M / 256;
  if ((gridDim.x & 7) == 0) {
    const int xcd = blockIdx.x & 7, local = blockIdx.x >> 3, nloc = gridDim.x >> 3;
    const int ntok = tok_n ? ntn : ntm, nw = tok_n ? ntm : ntn, np = (ntok - xcd + 7) >> 3;
    for (int j = local; j < np * nw; j += nloc) {
      const int pl = j / nw, wt = j - pl * nw, tk = xcd + 8 * pl;
      const int mt = tok_n ? wt : tk, n_t = tok_n ? tk : wt;
      if (!tok_n && (mt % 17) == 0) continue;
      gemm_tile<Epi, 1, 2, 2>(A, lda, Bt, ldb, K, mt * 256, n_t * 128, grouped ? n_t * 128 : 0, epi, lds);
    }
    if (!tok_n && !skip_ctx) {
      const int rb = ((nloc - 1 - local) << 3) | xcd;
      for (int s = rb; s < 16 * ntn; s += gridDim.x) {
        const int cp = s / (4 * ntn), rem = s - cp * (4 * ntn), sub = rem / ntn, n_t = rem - sub * ntn;
        gemm_tile<Epi, 2, 1, 1>(A, lda, Bt, ldb, K, cp * (17 * 256) + sub * 64, n_t * 128, grouped ? n_t * 128 : 0, epi, lds);
      }
    }
  } else {
    const int nt = ntn * ntm;
    for (int it = blockIdx.x; it < nt; it += gridDim.x) {
      const int mt = it / ntn, n_t = it - mt * ntn;
      if (skip_ctx && (mt % 17) == 0) continue;
      gemm_tile<Epi, 1, 2, 2>(A, lda, Bt, ldb, K, mt * 256, n_t * 128, grouped ? n_t * 128 : 0, epi, lds);
    }
  }
}
struct EpiF32 { static constexpr bool QUAD = false, TOPK = false, RESID = false; float* C; int ldc, ncols; const float* bias;
  __device__ __forceinline__ void operator()(int row, int col, float v) const { if (col < ncols) C[(size_t)row * ldc + col] = v + (bias ? bias[col] : 0.f); } };
struct EpiBf16 { static constexpr bool QUAD = false, TOPK = false, RESID = false; bf16_t* C; int ldc;
  __device__ __forceinline__ void operator()(int row, int col, float v) const { C[(size_t)row * ldc + col] = f2bf(v); } };
struct EpiZT { static constexpr bool QUAD = true, TOPK = false, RESID = false; bf16_t* C; int ldt; const float* bias;
  __device__ __forceinline__ void quad(int row0, int col, float a, float b, float c, float d) const { const float bb = bias[col]; u32x2 w = {cvtpk(a + bb, b + bb), cvtpk(c + bb, d + bb)}; *(u32x2*)(C + (size_t)col * ldt + row0) = w; }
  __device__ __forceinline__ void operator()(int, int, float) const {} };
struct EpiMlaQ { static constexpr bool QUAD = false, TOPK = false, RESID = false; bf16_t* Q;
  __device__ __forceinline__ void operator()(int row, int col, float v) const {
    const float partner = xl1f(v);
    const int w = col % 192;
    const RowInfo ri = row_info(row);
    float o = v;
    if (w >= 128 && !ri.is_ctx) { float c, s; rope_cs(ri.pos, (w - 128) >> 1, 16, c, s); o = (col & 1) ? (partner * s + v * c) : (v * c - partner * s); }
    Q[(size_t)row * 1536 + col] = f2bf(o);
  } };
struct EpiMlaKV { static constexpr bool QUAD = false, TOPK = false, RESID = false; bf16_t* Kb; bf16_t* Vb;
  __device__ __forceinline__ void operator()(int row, int col, float v) const {
    const int h = col >> 8, w = col & 255;
    if (w < 128) Kb[(size_t)row * 1024 + h * 128 + w] = f2bf(v); else Vb[(size_t)row * 1024 + h * 128 + (w - 128)] = f2bf(v);
  } };

struct EpiF32T { static constexpr bool QUAD = true, TOPK = false, RESID = false; float* C; int ldt;
  __device__ __forceinline__ void quad(int row0, int col, float a, float b, float c, float d) const { *(float4*)(C + (size_t)col * ldt + row0) = make_float4(a, b, c, d); }
  __device__ __forceinline__ void operator()(int, int, float) const {} };


namespace pg8 {
typedef float f32x4 __attribute__((ext_vector_type(4)));
constexpr int BM = 256, BK = 64, HALF = 128, HTB = HALF * BK * 2  , STAGE_BYTES = 8 * HTB;
__device__ __forceinline__ int lds_byte(int r, int c) { const int st = (r >> 4) * 2 + (c >> 5), rr = r & 15, cc = c & 31, ob = rr * 64 + cc * 2; return st * 1024 + (ob ^ (((ob >> 9) & 1) << 5)); }
__device__ __forceinline__ void stage_rc(int b, int& R, int& C) { const int st = b / 1024, sb = b % 1024, swz = sb ^ (((sb >> 9) & 1) << 5); R = (st >> 1) * 16 + swz / 64; C = (st & 1) * 32 + (swz % 64) / 2; }
__device__ __forceinline__ int perm32(int rho) { const int n = rho >> 4, i = rho & 15; return 8 * (i >> 2) + 4 * n + (i & 3); }
struct Unit { int pm, pn; };
struct Gemm { const bf16_t* A; const bf16_t* Bt; int lda, ldb, K; };
struct LatOrder {
  int nw, tok_n, ctx_main, single, n1;
  __device__ __forceinline__ bool next(int i, Unit& u) const {
    if (single >= 0) { if (i > 0) return false; i = single; }
    int mt, wt;
    if ((gridDim.x & 7) == 0) {
      const int xcd = blockIdx.x & 7, local = blockIdx.x >> 3, nloc = gridDim.x >> 3;
      int j = local + nloc * i; const int nlat = 8 * nw;
      if (n1 > 0 && nloc == 32) {
        const int m = 32 - n1, R = nlat - n1, base = R / m, extra = R - base * m;
        int st, cnt;
        if (local < n1) { st = local; cnt = 1; } else { const int q = local - n1; st = n1 + q * base + (q < extra ? q : extra); cnt = base + (q < extra ? 1 : 0); }
        if (i >= cnt) return false;
        j = st + i;
      }
      if (j < nlat) { const int pl = j / nw; wt = j - pl * nw; const int lp = xcd + 8 * pl; mt = lp + (lp >> 4) + 1; }
      else { if (!ctx_main) return false; const int cu = (j - nlat) * 8 + xcd; if (cu >= 4 * nw) return false; const int cp = cu / nw; wt = cu - cp * nw; mt = 17 * cp; }
    } else {
      const int L = blockIdx.x + gridDim.x * i;
      if (L < 64 * nw) { const int lp = L / nw; wt = L - lp * nw; mt = lp + (lp >> 4) + 1; }
      else { if (!ctx_main) return false; const int cu = L - 64 * nw; if (cu >= 4 * nw) return false; const int cp = cu / nw; wt = cu - cp * nw; mt = 17 * cp; }
    }
    u.pm = tok_n ? wt : mt; u.pn = tok_n ? mt : wt; return true;
  }
};

template <class Epi, class Sched, bool ALIGN_EPI, bool SP2>
__device__ __forceinline__ void gemm_phase(LAS unsigned char* lds, const Gemm g, const Sched& S, const Epi& E) {
    const int tid = otid(), wid = __builtin_amdgcn_readfirstlane(tid >> 6), lane = tid & 63, wr = wid >> 2, wc = wid & 3, fr = lane & 15, fq = lane >> 4;
    int K = g.K; asm volatile("" : "+s"(K));
    const int nt = K / BK;
    unsigned voffA[2], voffB[2];
#pragma unroll
    for (int i = 0; i < 2; ++i) { int R, C; stage_rc(tid * 16 + i * 8192, R, C); const int Rb = Epi::PERM ? ((R & ~31) + perm32(R & 31)) : R;
        voffA[i] = (unsigned)(R * g.lda + C) * 2u; voffB[i] = (unsigned)(Rb * g.ldb + C) * 2u; }
    const size_t kstep = (size_t)(BK * 2);
    const size_t hstepA = (size_t)HALF * g.lda * 2, hstepB = (size_t)HALF * g.ldb * 2;
    const size_t tstepA = 2 * hstepA, tstepB = 2 * hstepB;
    const unsigned ldsw = (unsigned)wid * 1024u;
    const int aoff = lds_byte(wr * 64 + fr, fq * 8), boff = lds_byte(wc * 32 + fr, fq * 8);
#define PG8_SA(b, h) (((b) * 2 + (h)) * HTB)
#define PG8_SB(b, h) ((4 + (b) * 2 + (h)) * HTB)
#define PG8_STAGE(bufoff, gbase, voff) do { _Pragma("unroll") for (int _i = 0; _i < 2; ++_i) \
        __builtin_amdgcn_global_load_lds((const unsigned*)((const char*)(gbase) + (voff)[_i]), (LAS unsigned*)(lds + (bufoff) + ldsw + _i * 8192), 16, 0, 0); } while (0)
#define PG8_LDA(dst, b, h) do { _Pragma("unroll") for (int m = 0; m < 4; ++m) _Pragma("unroll") for (int k = 0; k < 2; ++k) dst[m][k] = *(const LAS bf16x8*)(lds + PG8_SA(b, h) + aoff + m * 2048 + k * 1024); } while (0)
#define PG8_LDB(dst, b, h) do { _Pragma("unroll") for (int n = 0; n < 2; ++n) _Pragma("unroll") for (int k = 0; k < 2; ++k) dst[n][k] = *(const LAS bf16x8*)(lds + PG8_SB(b, h) + boff + n * 2048 + k * 1024); } while (0)
#define PG8_MMA(ai, bj, At, Bt) do { __builtin_amdgcn_s_setprio(1); _Pragma("unroll") for (int m = 0; m < 4; ++m) _Pragma("unroll") for (int n = 0; n < 2; ++n) _Pragma("unroll") for (int k = 0; k < 2; ++k) \
        acc[ai][bj][m][n] = __builtin_amdgcn_mfma_f32_16x16x32_bf16(Bt[n][k], At[m][k], acc[ai][bj][m][n], 0, 0, 0); __builtin_amdgcn_s_setprio(0); } while (0)
#define PG8_WAIT_V(n) asm volatile("s_waitcnt vmcnt(" #n ")" ::: "memory")
#define PG8_WAIT_L(n) asm volatile("s_waitcnt lgkmcnt(" #n ")" ::: "memory")
#define PG8_BAR __builtin_amdgcn_s_barrier()
#define PG8_SCHED __builtin_amdgcn_sched_barrier(0)
    Unit cur, nxt; int ui = 0;
    if (!S.next(0, cur)) return;
    f32x4 acc[2][2][4][2];
#pragma unroll
    for (int a = 0; a < 2; ++a)
#pragma unroll
        for (int b = 0; b < 2; ++b)
#pragma unroll
            for (int m = 0; m < 4; ++m)
#pragma unroll
                for (int n = 0; n < 2; ++n) acc[a][b][m][n] = (f32x4){0.f, 0.f, 0.f, 0.f};
    bf16x8 At[4][2], B0[2][2], B1[2][2];
    const char* cA = (const char*)g.A + (size_t)cur.pm * tstepA; const char* cB = (const char*)g.Bt + (size_t)cur.pn * tstepB;
    if constexpr (SP2) {
        PG8_STAGE(PG8_SB(0, 0), cB, voffB); PG8_STAGE(PG8_SB(0, 1), cB + hstepB, voffB); PG8_STAGE(PG8_SA(0, 0), cA, voffA); PG8_STAGE(PG8_SA(0, 1), cA + hstepA, voffA);
        if (wr == 1) PG8_BAR;
        PG8_WAIT_V(2); PG8_BAR;
        PG8_STAGE(PG8_SB(1, 0), cB + kstep, voffB); PG8_STAGE(PG8_SA(1, 0), cA + kstep, voffA); PG8_STAGE(PG8_SB(1, 1), cB + hstepB + kstep, voffB);
        PG8_WAIT_V(6); PG8_BAR;
    } else {
        PG8_STAGE(PG8_SB(0, 0), cB, voffB); PG8_STAGE(PG8_SA(0, 0), cA, voffA); PG8_STAGE(PG8_SB(0, 1), cB + hstepB, voffB); PG8_STAGE(PG8_SA(0, 1), cA + hstepA, voffA);
        if (wr == 1) PG8_BAR;
        PG8_WAIT_V(4); PG8_BAR;
        PG8_STAGE(PG8_SB(1, 0), cB + kstep, voffB); PG8_STAGE(PG8_SA(1, 0), cA + kstep, voffA); PG8_STAGE(PG8_SB(1, 1), cB + hstepB + kstep, voffB);
        PG8_WAIT_V(6); PG8_BAR;
    }
    for (;;) {
        const bool has_next = S.next(ui + 1, nxt);
        const char* nA = has_next ? (const char*)g.A + (size_t)nxt.pm * tstepA : cA; const char* nB = has_next ? (const char*)g.Bt + (size_t)nxt.pn * tstepB : cB;
        for (int t = 0; t < nt; t += 2) {
            const bool last = (t == nt - 2);
            const char* a1 = cA + (size_t)(t + 1) * kstep;
            const char* a2 = last ? nA : cA + (size_t)(t + 2) * kstep; const char* b2 = last ? nB : cB + (size_t)(t + 2) * kstep;
            const char* a3 = a2 + kstep; const char* b3 = b2 + kstep;
            if constexpr (SP2) {
            PG8_LDB(B0, 0, 0); PG8_LDB(B1, 0, 1); PG8_SCHED; PG8_LDA(At, 0, 0); PG8_STAGE(PG8_SA(1, 1), a1 + hstepA, voffA);
            PG8_WAIT_V(8); PG8_WAIT_L(0); PG8_BAR; PG8_MMA(0, 0, At, B0); PG8_MMA(0, 1, At, B1); PG8_BAR; PG8_SCHED;
            PG8_LDA(At, 0, 1); PG8_STAGE(PG8_SB(0, 0), b2, voffB); PG8_STAGE(PG8_SB(0, 1), b2 + hstepB, voffB); PG8_STAGE(PG8_SA(0, 0), a2, voffA);
            PG8_WAIT_V(8); PG8_WAIT_L(0); PG8_BAR; PG8_MMA(1, 0, At, B0); PG8_MMA(1, 1, At, B1); PG8_BAR; PG8_SCHED;
            PG8_LDB(B0, 1, 0); PG8_LDB(B1, 1, 1); PG8_SCHED; PG8_LDA(At, 1, 0); PG8_STAGE(PG8_SA(0, 1), a2 + hstepA, voffA);
            PG8_WAIT_V(8); PG8_WAIT_L(0); PG8_BAR; PG8_MMA(0, 0, At, B0); PG8_MMA(0, 1, At, B1); PG8_BAR; PG8_SCHED;
            PG8_LDA(At, 1, 1); PG8_STAGE(PG8_SB(1, 0), b3, voffB); PG8_STAGE(PG8_SB(1, 1), b3 + hstepB, voffB); PG8_STAGE(PG8_SA(1, 0), a3, voffA);
            PG8_WAIT_V(8); PG8_WAIT_L(0); PG8_BAR; PG8_MMA(1, 0, At, B0); PG8_MMA(1, 1, At, B1); PG8_BAR; PG8_SCHED;
            } else {
            PG8_LDB(B0, 0, 0); PG8_SCHED; PG8_LDA(At, 0, 0); PG8_STAGE(PG8_SA(1, 1), a1 + hstepA, voffA);
            PG8_WAIT_L(8); PG8_BAR; PG8_WAIT_L(0); PG8_MMA(0, 0, At, B0); PG8_BAR; PG8_SCHED;
            PG8_LDB(B1, 0, 1); PG8_STAGE(PG8_SB(0, 0), b2, voffB);
            PG8_BAR; PG8_WAIT_L(0); PG8_MMA(0, 1, At, B1); PG8_BAR;
            PG8_LDA(At, 0, 1); PG8_STAGE(PG8_SA(0, 0), a2, voffA);
            PG8_BAR; PG8_WAIT_L(0); PG8_MMA(1, 0, At, B0); PG8_BAR; PG8_SCHED;
            PG8_STAGE(PG8_SB(0, 1), b2 + hstepB, voffB);
            PG8_WAIT_V(6); PG8_BAR; PG8_MMA(1, 1, At, B1); PG8_BAR;
            PG8_LDB(B0, 1, 0); PG8_SCHED; PG8_LDA(At, 1, 0); PG8_STAGE(PG8_SA(0, 1), a2 + hstepA, voffA);
            PG8_WAIT_L(8); PG8_BAR; PG8_WAIT_L(0); PG8_MMA(0, 0, At, B0); PG8_BAR; PG8_SCHED;
            PG8_LDB(B1, 1, 1); PG8_STAGE(PG8_SB(1, 0), b3, voffB);
            PG8_BAR; PG8_WAIT_L(0); PG8_MMA(0, 1, At, B1); PG8_BAR;
            PG8_LDA(At, 1, 1); PG8_STAGE(PG8_SA(1, 0), a3, voffA);
            PG8_BAR; PG8_WAIT_L(0); PG8_MMA(1, 0, At, B0); PG8_BAR; PG8_SCHED;
            PG8_STAGE(PG8_SB(1, 1), b3 + hstepB, voffB);
            PG8_WAIT_V(6); PG8_BAR; PG8_MMA(1, 1, At, B1); PG8_BAR;
            }
        }
        if constexpr (ALIGN_EPI) { if (wr == 0) PG8_BAR; }
        if constexpr (!Epi::AFTER_DRAIN) { E(acc, cur, wr, wc, fr, fq); }
        if (!has_next) break;
#pragma unroll
        for (int a = 0; a < 2; ++a)
#pragma unroll
            for (int b = 0; b < 2; ++b)
#pragma unroll
                for (int m = 0; m < 4; ++m)
#pragma unroll
                    for (int n = 0; n < 2; ++n) acc[a][b][m][n] = (f32x4){0.f, 0.f, 0.f, 0.f};
        cur = nxt; cA = nA; cB = nB; ++ui;
        if constexpr (ALIGN_EPI) { if (wr == 1) PG8_BAR; }
    }
    PG8_WAIT_V(0);
    if constexpr (!ALIGN_EPI) { if (wr == 0) PG8_BAR; }
    PG8_BAR;
    if constexpr (Epi::AFTER_DRAIN) { E.fused(acc, cur, wr, wc, fr, fq, (char*)lds, wid, lane); }
#undef PG8_SA
#undef PG8_SB
#undef PG8_STAGE
#undef PG8_LDA
#undef PG8_LDB
#undef PG8_MMA
#undef PG8_WAIT_V
#undef PG8_WAIT_L
#undef PG8_BAR
#undef PG8_SCHED
}

#define PG8_FOR_AM _Pragma("unroll") for (int ai = 0; ai < 2; ++ai) _Pragma("unroll") for (int m = 0; m < 4; ++m)
__device__ __forceinline__ u32x4 pack8(const f32x4& a, const f32x4& b) { u32x4 w; w.x = cvtpk(a[0], a[1]); w.y = cvtpk(a[2], a[3]); w.z = cvtpk(b[0], b[1]); w.w = cvtpk(b[2], b[3]); return w; }
struct E8Resid { static constexpr bool PERM = true, AFTER_DRAIN = false; bf16_t* X; const float* gmod; const float* bias;
  __device__ __forceinline__ void operator()(const f32x4 (&acc)[2][2][4][2], const Unit& u, int wr, int wc, int fr, int fq) const {
    const float* g = gmod + (size_t)row_info(u.pm * BM).mrow * 6144;
    const int col0 = u.pn * BM + wc * 32 + 8 * fq;
    f32x4 gv[2][2], bv[2][2];
#pragma unroll
    for (int bj = 0; bj < 2; ++bj)
#pragma unroll
      for (int n = 0; n < 2; ++n) { gv[bj][n] = *(const f32x4*)(g + col0 + bj * HALF + 4 * n); bv[bj][n] = bias ? *(const f32x4*)(bias + col0 + bj * HALF + 4 * n) : (f32x4){0.f, 0.f, 0.f, 0.f}; }
    PG8_FOR_AM { bf16_t* rowp = X + (size_t)(u.pm * BM + ai * HALF + wr * 64 + m * 16 + fr) * 1024 + col0;
#pragma unroll
      for (int bj = 0; bj < 2; ++bj) { const u32x4 xw = *(const u32x4*)(rowp + bj * HALF);
        const f32x4 x0 = {bflo(xw.x), bfhi(xw.x), bflo(xw.y), bfhi(xw.y)}, x1 = {bflo(xw.z), bfhi(xw.z), bflo(xw.w), bfhi(xw.w)};
        const f32x4 o0 = x0 * ALPHA + gv[bj][0] * (acc[ai][bj][m][0] + bv[bj][0]), o1 = x1 * ALPHA + gv[bj][1] * (acc[ai][bj][m][1] + bv[bj][1]);
        *(u32x4*)(rowp + bj * HALF) = pack8(o0, o1); } }
  } };
struct E8Bf16 { static constexpr bool PERM = true, AFTER_DRAIN = false; bf16_t* C; int ldc; const float* rowbias;
  __device__ __forceinline__ void operator()(const f32x4 (&acc)[2][2][4][2], const Unit& u, int wr, int wc, int fr, int fq) const {
    const int col0 = u.pn * BM + wc * 32 + 8 * fq;
    PG8_FOR_AM { const int row = u.pm * BM + ai * HALF + wr * 64 + m * 16 + fr; const float rb = rowbias ? rowbias[row] : 0.f; bf16_t* rowp = C + (size_t)row * ldc + col0;
#pragma unroll
      for (int bj = 0; bj < 2; ++bj) *(u32x4*)(rowp + bj * HALF) = pack8(acc[ai][bj][m][0] + rb, acc[ai][bj][m][1] + rb); }
  } };
struct E8MlaKV { static constexpr bool PERM = true, AFTER_DRAIN = false; bf16_t* Kb; bf16_t* Vb;
  __device__ __forceinline__ void operator()(const f32x4 (&acc)[2][2][4][2], const Unit& u, int wr, int wc, int fr, int fq) const {
    const int col0 = u.pn * HALF + wc * 32 + 8 * fq;
    PG8_FOR_AM { const size_t off = (size_t)(u.pm * BM + ai * HALF + wr * 64 + m * 16 + fr) * 1024 + col0;
      *(u32x4*)(Kb + off) = pack8(acc[ai][0][m][0], acc[ai][0][m][1]); *(u32x4*)(Vb + off) = pack8(acc[ai][1][m][0], acc[ai][1][m][1]); }
  } };
struct E8MlaQ { static constexpr bool PERM = true, AFTER_DRAIN = false; bf16_t* Q;
  __device__ __forceinline__ void operator()(const f32x4 (&acc)[2][2][4][2], const Unit& u, int wr, int wc, int fr, int fq) const {
    const RowInfo r0 = row_info(u.pm * BM);
    PG8_FOR_AM { const int row = u.pm * BM + ai * HALF + wr * 64 + m * 16 + fr; const int pos = r0.pos + ai * HALF + wr * 64 + m * 16 + fr;
#pragma unroll
      for (int bj = 0; bj < 2; ++bj) { const int col0 = u.pn * BM + bj * HALF + wc * 32 + 8 * fq, w = col0 % 192;
        f32x4 v0 = acc[ai][bj][m][0], v1 = acc[ai][bj][m][1];
        if (w >= 128 && !r0.is_ctx) { const int i0 = (w - 128) >> 1; float c, s;
          rope_cs(pos, i0, 16, c, s);     { const float a = v0[0], b = v0[1]; v0[0] = a * c - b * s; v0[1] = a * s + b * c; }
          rope_cs(pos, i0 + 1, 16, c, s); { const float a = v0[2], b = v0[3]; v0[2] = a * c - b * s; v0[3] = a * s + b * c; }
          rope_cs(pos, i0 + 2, 16, c, s); { const float a = v1[0], b = v1[1]; v1[0] = a * c - b * s; v1[1] = a * s + b * c; }
          rope_cs(pos, i0 + 3, 16, c, s); { const float a = v1[2], b = v1[3]; v1[2] = a * c - b * s; v1[3] = a * s + b * c; } }
        *(u32x4*)(Q + (size_t)row * 1536 + col0) = pack8(v0, v1); } }
  } };
struct E8PeerTopk { static constexpr bool PERM = true, AFTER_DRAIN = true; const bf16_t* keys; float* topl;
  __device__ __forceinline__ void fused(const f32x4 (&acc)[2][2][4][2], const Unit& u, int wr, int wc, int fr, int fq, char* lds, int wid, int lane) const {
    const int r32 = lane & 31, hi = lane >> 5, tid = wid * 64 + lane;
    char* Qs = lds; char* Ks = lds + 65536;
#pragma unroll
    for (int bj = 0; bj < 2; ++bj) {
      const int hs = u.pn * 2 + bj;
      PG8_FOR_AM { const int row = ai * HALF + wr * 64 + m * 16 + fr; *(u32x4*)(Qs + row * 256 + (((wc * 4 + fq) ^ (row & 7)) << 4)) = pack8(acc[ai][bj][m][0], acc[ai][bj][m][1]); }
      const bf16_t* kg = keys + (size_t)hs * 16384;
#pragma unroll
      for (int c = 0; c < 4; ++c) { const int id = tid + NTHR * c, row = id >> 4, ch = id & 15; *(u32x4*)(Ks + row * 256 + ((ch ^ (row & 7)) << 4)) = *(const u32x4*)(kg + row * 128 + ch * 8); }
      __syncthreads();
      {
        bf16x8 bq[8];
#pragma unroll
        for (int ks = 0; ks < 8; ++ks) bq[ks] = *(const bf16x8*)(Qs + (wid * 32 + r32) * 256 + (((ks * 2 + hi) ^ (r32 & 7)) << 4));
        float top[16];
#pragma unroll
        for (int kt = 0; kt < 4; ++kt) {
          f32x16 sc = f32x16{};
#pragma unroll
          for (int ks = 0; ks < 8; ++ks) { const bf16x8 a = *(const bf16x8*)(Ks + (kt * 32 + r32) * 256 + (((ks * 2 + hi) ^ (r32 & 7)) << 4)); sc = __builtin_amdgcn_mfma_f32_32x32x16_bf16(a, bq[ks], sc, 0, 0, 0); }
          float g[16];
#pragma unroll
          for (int r = 0; r < 16; ++r) g[r] = __uint_as_float((__float_as_uint(sc[r]) & ~127u) | (unsigned)(kt * 32 + crow(r, hi)));
          bsort16(g);
          if (kt == 0) {
#pragma unroll
            for (int q = 0; q < 16; ++q) top[q] = g[q];
          } else merge_top16(top, g);
        }
        float oth[16];
#pragma unroll
        for (int q = 0; q < 16; ++q) { const auto r_ = __builtin_amdgcn_permlane32_swap(__float_as_uint(top[q]), __float_as_uint(top[q]), false, false); oth[q] = __uint_as_float(hi ? r_[0] : r_[1]); }
        merge_top16(top, oth);
        if (hi == 0) {
          float* dst = topl + ((size_t)(u.pm * BM + wid * 32 + r32) * 16 + hs) * 16;
#pragma unroll
          for (int q = 0; q < 4; ++q) *(float4*)(dst + 4 * q) = make_float4(top[4 * q], top[4 * q + 1], top[4 * q + 2], top[4 * q + 3]);
        }
      }
      __syncthreads();
    }
  } };
}


template <class Epi>
__device__ __forceinline__ void gemm_ctx_job(const bf16_t* A, int lda, const bf16_t* Bt, int ldb, int N, int K, const Epi& epi, char* lds) {
  const int ntn = N / 128;
  for (int s = blockIdx.x; s < 16 * ntn; s += gridDim.x) {
    const int cp = s / (4 * ntn), rem = s - cp * (4 * ntn), sub = rem / ntn, n_t = rem - sub * ntn;
    gemm_tile<Epi, 2, 1, 1>(A, lda, Bt, ldb, K, cp * (17 * 256) + sub * 64, n_t * 128, 0, epi, lds);
  }
}
template <class E8, class Epi>
__device__ __forceinline__ void gemm8_job(const bf16_t* A, int lda, const bf16_t* Bt, int ldb, int N, int K, const E8& e8, const Epi& epi, char* lds, bool ctx_main, bool skip_ctx, int n1 = 0) {
  const pg8::LatOrder S{N / 256, 0, (ctx_main && !skip_ctx) ? 1 : 0, -1, n1};
  pg8::gemm_phase<E8, pg8::LatOrder, true, true>((LAS unsigned char*)lds, pg8::Gemm{A, Bt, lda, ldb, K}, S, e8);
  __syncthreads();
  if (!ctx_main && !skip_ctx) gemm_ctx_job(A, lda, Bt, ldb, N, K, epi, lds);
}
template <class E8, class Epi>
__device__ __forceinline__ void gemm8t_job(const bf16_t* W, const bf16_t* Act, int N, int K, const E8& e8, const Epi& epi, char* lds) {
  const pg8::LatOrder S{N / 256, 1, 0, -1, 0};
  pg8::gemm_phase<E8, pg8::LatOrder, true, true>((LAS unsigned char*)lds, pg8::Gemm{W, Act, K, K, K}, S, e8);
  __syncthreads();
  gemm_ctx_job(Act, K, W, K, N, K, epi, lds);
}
template <class E8, class Epi>
__device__ __forceinline__ void gemm8d_job(const bf16_t* A, int lda, const bf16_t* Bt, int ldb, int N, int K, const E8& e8, const Epi& epi, char* lds, bool skip_ctx) {
  const int nw = N / 256;
  for (int rnd = 0; rnd * (int)gridDim.x < 64 * nw; ++rnd) {
    const pg8::LatOrder S{nw, 0, 0, rnd, 0};
    pg8::gemm_phase<E8, pg8::LatOrder, false, true>((LAS unsigned char*)lds, pg8::Gemm{A, Bt, lda, ldb, K}, S, e8);
    __syncthreads();
  }
  if (!skip_ctx) gemm_ctx_job(A, lda, Bt, ldb, N, K, epi, lds);
}

#define SBAR() __builtin_amdgcn_sched_barrier(0)
constexpr float ATT_THR = 8.f;
__device__ __forceinline__ void partialSM(f32x16& p0, f32x16& p1, float& m_reg, float& mn, float& alpha, const float C, const float thr_s) {
  float pmax = p0[0];
#pragma unroll
  for (int r = 1; r < 16; ++r) pmax = fmaxf(pmax, p0[r]);
#pragma unroll
  for (int r = 0; r < 16; ++r) pmax = fmaxf(pmax, p1[r]);
  { auto rr = __builtin_amdgcn_permlane32_swap(__float_as_uint(pmax), __float_as_uint(pmax), false, false);
    pmax = fmaxf(__uint_as_float(rr[0]), __uint_as_float(rr[1])); }
  if (__builtin_expect(__all(pmax - m_reg <= thr_s), 1)) { mn = m_reg; alpha = 1.f; }
  else { mn = fmaxf(m_reg, pmax); alpha = __builtin_amdgcn_exp2f((m_reg - mn) * C); m_reg = mn; }
  const float mnC = -mn * C;
#pragma unroll
  for (int r = 0; r < 16; ++r) p0[r] = fmaf(p0[r], C, mnC);
#pragma unroll
  for (int r = 0; r < 16; ++r) p1[r] = fmaf(p1[r], C, mnC);
#pragma unroll
  for (int r = 0; r < 16; ++r) p0[r] = __builtin_amdgcn_exp2f(p0[r]);
}
__device__ __forceinline__ void finishSM(f32x16& p0, f32x16& p1, float alpha, float& l_reg, bf16x8& pa0, bf16x8& pa1, bf16x8& pa2, bf16x8& pa3) {
#pragma unroll
  for (int r = 0; r < 16; ++r) p1[r] = __builtin_amdgcn_exp2f(p1[r]);
  float ps = 0;
#pragma unroll
  for (int r = 0; r < 16; ++r) ps += p0[r];
#pragma unroll
  for (int r = 0; r < 16; ++r) ps += p1[r];
  { auto rr = __builtin_amdgcn_permlane32_swap(__float_as_uint(ps), __float_as_uint(ps), false, false);
    ps = __uint_as_float(rr[0]) + __uint_as_float(rr[1]); }
  l_reg = l_reg * alpha + ps;
#define PK4(P, BASE, OUT) do { unsigned a0 = cvtpk_asm(P[BASE + 0], P[BASE + 1]), a1 = cvtpk_asm(P[BASE + 2], P[BASE + 3]);   \
    unsigned b0 = cvtpk_asm(P[BASE + 4], P[BASE + 5]), b1 = cvtpk_asm(P[BASE + 6], P[BASE + 7]);                              \
    auto r0 = __builtin_amdgcn_permlane32_swap(a0, b0, false, false); auto r1 = __builtin_amdgcn_permlane32_swap(a1, b1, false, false); \
    u32x4 w = {r0[0], r1[0], r0[1], r1[1]}; OUT = *reinterpret_cast<bf16x8*>(&w); } while (0)
  PK4(p0, 0, pa0); PK4(p0, 8, pa1); PK4(p1, 0, pa2); PK4(p1, 8, pa3);
#undef PK4
}
template <int DQ>
__device__ __forceinline__ void qkt(f32x16& p0, f32x16& p1, const char* Ks, const char* KRs, const bf16x8* qr, const bf16x8* qrope  , int r32, int hi) {
  p0 = f32x16{}; p1 = f32x16{};
  const int sw = (r32 & 7) << 4;
#pragma unroll
  for (int d0 = 0; d0 < 8; ++d0) { const int cb = (d0 * 32 + hi * 16) ^ sw;
    bf16x8 b0 = *reinterpret_cast<const bf16x8*>(Ks + r32 * 256 + cb);
    bf16x8 b1 = *reinterpret_cast<const bf16x8*>(Ks + (32 + r32) * 256 + cb);
    p0 = __builtin_amdgcn_mfma_f32_32x32x16_bf16(b0, qr[d0], p0, 0, 0, 0);
    p1 = __builtin_amdgcn_mfma_f32_32x32x16_bf16(b1, qr[d0], p1, 0, 0, 0); }
  if constexpr (DQ == 192) {
#pragma unroll
    for (int d0 = 0; d0 < 4; ++d0) { const int cb = (d0 * 32 + hi * 16) ^ sw;
      bf16x8 b0 = *reinterpret_cast<const bf16x8*>(KRs + r32 * 128 + cb);
      bf16x8 b1 = *reinterpret_cast<const bf16x8*>(KRs + (32 + r32) * 128 + cb);
      const bf16x8 qf = qrope[d0 * 64];
      p0 = __builtin_amdgcn_mfma_f32_32x32x16_bf16(b0, qf, p0, 0, 0, 0);
      p1 = __builtin_amdgcn_mfma_f32_32x32x16_bf16(b1, qf, p1, 0, 0, 0); }
  }
}
__device__ __forceinline__ int v_st(int k, int c) { const int kk = (k & ~0xC) | ((k & 4) << 1) | ((k & 8) >> 1); return ((kk >> 3) * 4 + (c >> 5)) * 512 + ((kk & 7) * 32 + (c & 31)) * 2; }
__device__ __forceinline__ int v_rd_base(int lane) { return ((lane & 3) << 3) | (((lane >> 2) & 3) << 6) | (((lane >> 4) & 1) << 5) | (((lane >> 5) & 1) << 8); }
constexpr int v_rd_off(int d0, int ks, int half) { return d0 * 512 + ks * 4096 + half * 2048; }
template <int OFF> __device__ __forceinline__ s16x4 tr_read(int vb) {
  s16x4 r; asm volatile("ds_read_b64_tr_b16 %0, %1 offset:%2" : "=&v"(r) : "v"(vb), "i"(OFF) : "memory"); return r;
}
template <int D0> __device__ __forceinline__ void pv_one(f32x16& od, int vb, bf16x8 pa0, bf16x8 pa1, bf16x8 pa2, bf16x8 pa3) {
  const s16x4 l0 = tr_read<v_rd_off(D0, 0, 0)>(vb), h0 = tr_read<v_rd_off(D0, 0, 1)>(vb), l1 = tr_read<v_rd_off(D0, 1, 0)>(vb), h1 = tr_read<v_rd_off(D0, 1, 1)>(vb);
  const s16x4 l2 = tr_read<v_rd_off(D0, 2, 0)>(vb), h2 = tr_read<v_rd_off(D0, 2, 1)>(vb), l3 = tr_read<v_rd_off(D0, 3, 0)>(vb), h3 = tr_read<v_rd_off(D0, 3, 1)>(vb);
  asm volatile("s_waitcnt lgkmcnt(0)" ::: "memory"); SBAR();
#define PKV(L, H) (bf16x8){L[0], L[1], L[2], L[3], H[0], H[1], H[2], H[3]}
  od = __builtin_amdgcn_mfma_f32_32x32x16_bf16(pa0, PKV(l0, h0), od, 0, 0, 0);
  od = __builtin_amdgcn_mfma_f32_32x32x16_bf16(pa1, PKV(l1, h1), od, 0, 0, 0);
  od = __builtin_amdgcn_mfma_f32_32x32x16_bf16(pa2, PKV(l2, h2), od, 0, 0, 0);
  od = __builtin_amdgcn_mfma_f32_32x32x16_bf16(pa3, PKV(l3, h3), od, 0, 0, 0);
#undef PKV
}
__device__ __forceinline__ void pv_d0(f32x16* o, int vb, bf16x8 pa0, bf16x8 pa1, bf16x8 pa2, bf16x8 pa3) {
  pv_one<0>(o[0], vb, pa0, pa1, pa2, pa3); pv_one<1>(o[1], vb, pa0, pa1, pa2, pa3); pv_one<2>(o[2], vb, pa0, pa1, pa2, pa3); pv_one<3>(o[3], vb, pa0, pa1, pa2, pa3);
}
constexpr int ATT_LDS = 2 * 16384 + 2 * 16384 + 2 * 8192 + 2048 + 32768;
template <int DQ, int LDQ, int LDK, int LDKR, int LDV, int LDO, int SDEPTH>
__device__ __forceinline__ void attn_body(const bf16_t* __restrict__ Qb, const bf16_t* __restrict__ Kh, const bf16_t* __restrict__ Krh, const bf16_t* __restrict__ Vh,
                                          bf16_t* __restrict__ Ob, int seq, char* lds) {
  constexpr int SHM_V = 16384, SHM_K = 16384, SHM_KR = 8192;
  constexpr bool ROPE = DQ == 192;
  constexpr float scale = ROPE ? 0.07216878364870322f : 0.08838834764831845f;
  constexpr float C = scale * 1.4426950408889634f, thr_s = ATT_THR / scale;
  const int tid = otid();
  const int wid = tid >> 6, lane = tid & 63, r32 = lane & 31, hi = lane >> 5;
  char* V_lds = lds; char* K_lds = lds + 2 * SHM_V; char* KR_lds = K_lds + 2 * SHM_K;
  float* ws = (float*)(KR_lds + 2 * SHM_KR) + wid * 64; float* li_l = ws; float* al_l = ws + 32;
  float m_reg = -1e30f, l_reg = 0; f32x16 o[4] = {}; bf16x8 qr[8];
  const bf16_t* Qw = Qb + (long)(wid * 32 + r32) * LDQ + hi * 8;
#pragma unroll
  for (int d0 = 0; d0 < 8; ++d0) qr[d0] = *reinterpret_cast<const bf16x8*>(Qw + d0 * 16);
  bf16x8* qrope = (bf16x8*)(KR_lds + 2 * SHM_KR + 2048) + wid * 256 + lane;
  if constexpr (ROPE) {
#pragma unroll
    for (int d0 = 0; d0 < 4; ++d0) qrope[d0 * 64] = *reinterpret_cast<const bf16x8*>(Qw + 128 + d0 * 16);
  }
  const int sr = tid >> 4, sc = tid & 15;
  const unsigned voffK = (unsigned)(sr * LDK + sc * 8) * 2u, voffV = (unsigned)(sr * LDV + sc * 8) * 2u, voffKR = (unsigned)((tid >> 3) * LDKR + (tid & 7) * 8) * 2u;
  const int kst0 = sr * 256 + ((sc * 16) ^ ((sr & 7) << 4)), vst0 = v_st(sr, sc * 8), vst1 = v_st(32 + sr, sc * 8);
  const int krst = (tid >> 3) * 128 + (((tid & 7) * 16) ^ (((tid >> 3) & 7) << 4));
  const int vb0 = (int)(uintptr_t)V_lds + v_rd_base(lane);
  struct { bf16x8 v0, v1, k0, k1, kr; } sr_[SDEPTH];
#define SLOAD(i, kk) do { const char* vb_ = (const char*)Vh + (size_t)(kk) * (LDV * 2); const char* kb_ = (const char*)Kh + (size_t)(kk) * (LDK * 2); \
    sr_[i].v0 = *reinterpret_cast<const bf16x8*>(vb_ + voffV); sr_[i].v1 = *reinterpret_cast<const bf16x8*>(vb_ + voffV + 32 * LDV * 2); \
    sr_[i].k0 = *reinterpret_cast<const bf16x8*>(kb_ + voffK); sr_[i].k1 = *reinterpret_cast<const bf16x8*>(kb_ + voffK + 32 * LDK * 2); \
    if constexpr (ROPE) sr_[i].kr = *reinterpret_cast<const bf16x8*>((const char*)Krh + (size_t)(kk) * (LDKR * 2) + voffKR); } while (0)
#define SWRITE(b, i) do { *(bf16x8*)(V_lds + (b) * SHM_V + vst0) = sr_[i].v0; *(bf16x8*)(V_lds + (b) * SHM_V + vst1) = sr_[i].v1; \
    *(bf16x8*)(K_lds + (b) * SHM_K + kst0) = sr_[i].k0; *(bf16x8*)(K_lds + (b) * SHM_K + kst0 + 8192) = sr_[i].k1; \
    if constexpr (ROPE) *(bf16x8*)(KR_lds + (b) * SHM_KR + krst) = sr_[i].kr; } while (0)
#define SWAIT() do { if constexpr (SDEPTH == 2) { if constexpr (ROPE) asm volatile("s_waitcnt vmcnt(5)" ::: "memory"); else asm volatile("s_waitcnt vmcnt(4)" ::: "memory"); } \
    else asm volatile("s_waitcnt vmcnt(0)" ::: "memory"); } while (0)
#define RESC(a) do { if (__any((a) < 1.f)) { if (hi == 0) al_l[r32] = (a); asm volatile("s_waitcnt lgkmcnt(0)" ::: "memory"); \
    _Pragma("unroll") for (int d = 0; d < 4; ++d) _Pragma("unroll") for (int r = 0; r < 16; ++r) o[d][r] *= al_l[crow(r, hi)]; } } while (0)
  f32x16 pA0, pA1, pB0, pB1; float mnA, mnB, alA, alB; bf16x8 pa0, pa1, pa2, pa3; const int NT = seq / 64;
  constexpr int SE = 0, SO = SDEPTH - 1;
  SLOAD(SE, 0); asm volatile("s_waitcnt vmcnt(0)" ::: "memory"); SWRITE(0, SE); __syncthreads();
  qkt<DQ>(pA0, pA1, K_lds, KR_lds, qr, qrope, r32, hi); partialSM(pA0, pA1, m_reg, mnA, alA, C, thr_s);
  SLOAD(SO, 64); if constexpr (SDEPTH == 2) { if (2 < NT) SLOAD(SE, 2 * 64); }
  SWAIT(); SWRITE(1, SO); __syncthreads();
  for (int j = 1; j + 1 < NT; j += 2) {
    SBAR(); if constexpr (!ROPE) SLOAD(SO, (j + SDEPTH) * 64); SBAR();
    qkt<DQ>(pB0, pB1, K_lds + SHM_K, KR_lds + SHM_KR, qr, qrope, r32, hi);
    finishSM(pA0, pA1, alA, l_reg, pa0, pa1, pa2, pa3); SBAR();
    if constexpr (ROPE) SLOAD(SO, (j + SDEPTH) * 64); SBAR();
    pv_d0(o, vb0, pa0, pa1, pa2, pa3); partialSM(pB0, pB1, m_reg, mnB, alB, C, thr_s);
    __syncthreads(); SWAIT(); SWRITE(0, SE);
    RESC(alB); __syncthreads();
    SBAR(); if constexpr (!ROPE) { if (SDEPTH == 1 || j + 3 < NT) SLOAD(SE, (j + 1 + SDEPTH) * 64); } SBAR();
    qkt<DQ>(pA0, pA1, K_lds, KR_lds, qr, qrope, r32, hi);
    finishSM(pB0, pB1, alB, l_reg, pa0, pa1, pa2, pa3); SBAR();
    if constexpr (ROPE) { if (SDEPTH == 1 || j + 3 < NT) SLOAD(SE, (j + 1 + SDEPTH) * 64); } SBAR();
    pv_d0(o, vb0 + SHM_V, pa0, pa1, pa2, pa3); partialSM(pA0, pA1, m_reg, mnA, alA, C, thr_s);
    __syncthreads(); SWAIT(); SWRITE(1, SO);
    RESC(alA); __syncthreads();
  }
  SBAR(); qkt<DQ>(pB0, pB1, K_lds + SHM_K, KR_lds + SHM_KR, qr, qrope, r32, hi);
  finishSM(pA0, pA1, alA, l_reg, pa0, pa1, pa2, pa3); SBAR();
  pv_d0(o, vb0, pa0, pa1, pa2, pa3); partialSM(pB0, pB1, m_reg, mnB, alB, C, thr_s);
  __syncthreads(); RESC(alB);
  finishSM(pB0, pB1, alB, l_reg, pa0, pa1, pa2, pa3); SBAR();
  pv_d0(o, vb0 + SHM_V, pa0, pa1, pa2, pa3);
  if (hi == 0) li_l[r32] = l_reg; asm volatile("s_waitcnt lgkmcnt(0)" ::: "memory");
  bf16_t* Ow = Ob + (long)(wid * 32) * LDO + r32;
#pragma unroll
  for (int r = 0; r < 16; ++r) { const int orow = crow(r, hi); const float rl = __builtin_amdgcn_rcpf(li_l[orow]);
#pragma unroll
    for (int d0 = 0; d0 < 4; ++d0) Ow[(long)orow * LDO + d0 * 32] = f2bf(o[d0][r] * rl); }
#undef SLOAD
#undef SWRITE
#undef SWAIT
#undef RESC
  __syncthreads();
}

__device__ __forceinline__ void ln_row_finish(float (&r)[16], int cA, int cB, const float* lnw, const float* lnb, bf16_t* Xrow  , bf16_t* Hrow, const float* sh, const float* sc, float* orow, float* stat_out = nullptr) {
  float s = 0.f;
#pragma unroll
  for (int i = 0; i < 16; ++i) s += r[i];
  const float mean = wsum(s) * (1.f / 1024.f);
  float q = 0.f;
#pragma unroll
  for (int i = 0; i < 16; ++i) { r[i] -= mean; q += r[i] * r[i]; }
  const float rstd = rsqrtf(wsum(q) * (1.f / 1024.f) + 1e-5f);
  if (stat_out) *(float2*)stat_out = make_float2(mean, rstd);
#pragma unroll
  for (int hf = 0; hf < 2; ++hf) {
    const int c0 = hf ? cB : cA;
    float xn[8];
#pragma unroll
    for (int i = 0; i < 8; ++i) xn[i] = r[hf * 8 + i] * rstd * lnw[c0 + i] + lnb[c0 + i];
    if (Xrow) { u32x4 xw = {cvtpk(xn[0], xn[1]), cvtpk(xn[2], xn[3]), cvtpk(xn[4], xn[5]), cvtpk(xn[6], xn[7])}; *(u32x4*)(Xrow + c0) = xw; }
    if (orow) { *(float4*)(orow + c0) = make_float4(xn[0], xn[1], xn[2], xn[3]); *(float4*)(orow + c0 + 4) = make_float4(xn[4], xn[5], xn[6], xn[7]); }
    if (Hrow) {
      float hv[8];
#pragma unroll
      for (int i = 0; i < 8; ++i) hv[i] = xn[i] * (1.f + sc[c0 + i]) + sh[c0 + i];
      u32x4 w = {cvtpk(hv[0], hv[1]), cvtpk(hv[2], hv[3]), cvtpk(hv[4], hv[5]), cvtpk(hv[6], hv[7])};
      *(u32x4*)(Hrow + c0) = w;
    }
  }
}

struct WDesc { const float* src; bf16_t* dst; int K, N, Npad; };
constexpr int wd_tiles_of(int K, int Npad) { return (K / 64) * (Npad / 64); }
constexpr int WT_MLA = wd_tiles_of(1024, 768) + wd_tiles_of(1024, 384) + wd_tiles_of(768, 1536) + wd_tiles_of(256, 2048) + wd_tiles_of(1024, 1024);
constexpr int WT_HY = wd_tiles_of(1024, 3072) + wd_tiles_of(1024, 1024), WT_GQA = wd_tiles_of(1024, 1536) + wd_tiles_of(1024, 1024), WT_PQ = wd_tiles_of(1024, 2048);
constexpr int WD_TILES = 2 * WT_MLA + WT_HY + WT_GQA + 4 * WT_PQ;
__device__ __forceinline__ void wconv_desc(const Params& p, int it, WDesc& w, int& k0, int& n0) {
  int lt = it;
  if (lt < 2 * WT_MLA) {
    const int i = lt / WT_MLA; lt -= i * WT_MLA;
    if (lt < wd_tiles_of(1024, 768)) w = WDesc{p.in[8] + (size_t)i * 1024 * 768, WSP(bf16_t, OFF_W1 + (size_t)i * SZ_W1), 1024, 768, 768};
    else if ((lt -= wd_tiles_of(1024, 768)) < wd_tiles_of(1024, 384)) w = WDesc{p.in[11] + (size_t)i * 1024 * 320, WSP(bf16_t, OFF_W1 + (size_t)i * SZ_W1) + (size_t)768 * 1024, 1024, 320, 384};
    else if ((lt -= wd_tiles_of(1024, 384)) < wd_tiles_of(768, 1536)) w = WDesc{p.in[10] + (size_t)i * 768 * 1536, WSP(bf16_t, OFF_WUQ + (size_t)i * SZ_WUQ), 768, 1536, 1536};
    else if ((lt -= wd_tiles_of(768, 1536)) < wd_tiles_of(256, 2048)) w = WDesc{p.in[13] + (size_t)i * 256 * 2048, WSP(bf16_t, OFF_WUKV + (size_t)i * SZ_WUKV), 256, 2048, 2048};
    else { lt -= wd_tiles_of(256, 2048); w = WDesc{p.in[14] + (size_t)i * 1024 * 1024, WSP(bf16_t, OFF_WOA + (size_t)i * SZ_WSQ), 1024, 1024, 1024}; }
  } else if ((lt -= 2 * WT_MLA) < WT_HY) {
    if (lt < wd_tiles_of(1024, 3072)) w = WDesc{p.in[15], WSP(bf16_t, OFF_WIN), 1024, 3072, 3072};
    else { lt -= wd_tiles_of(1024, 3072); w = WDesc{p.in[27], WSP(bf16_t, OFF_WOUT), 1024, 1024, 1024}; }
  } else if ((lt -= WT_HY) < WT_GQA) {
    if (lt < wd_tiles_of(1024, 1536)) w = WDesc{p.in[29], WSP(bf16_t, OFF_WQKV), 1024, 1536, 1536};
    else { lt -= wd_tiles_of(1024, 1536); w = WDesc{p.in[32], WSP(bf16_t, OFF_WOC), 1024, 1024, 1024}; }
  } else {
    lt -= WT_GQA; const int l = lt / WT_PQ; lt -= l * WT_PQ;
    w = WDesc{p.in[33] + (size_t)l * 1024 * 2048, WSP(bf16_t, OFF_WQ + (size_t)l * SZ_WQ), 1024, 2048, 2048};
  }
  const int tn = w.Npad / 64, kt = lt / tn, nt = lt - kt * tn; k0 = kt * 64; n0 = nt * 64;
}
constexpr int WB = 4;
static_assert(WD_TILES % WB == 0, "wconv batches");
__device__ __forceinline__ void job_wconv(const Params& p, char* lds) {
  float* tile = (float*)lds;
  const int tid = otid();
  for (int it = blockIdx.x * WB; it < WD_TILES; it += gridDim.x * WB) {
    float4 v4[WB][2];
#pragma unroll
    for (int b = 0; b < WB; ++b) {
      WDesc w; int k0, n0; wconv_desc(p, it + b, w, k0, n0);
#pragma unroll
      for (int i = 0; i < 2; ++i) { const int e = tid + NTHR * i, k = e >> 4, n = (e & 15) * 4; v4[b][i] = (n0 + n < w.N) ? *(const float4*)(w.src + (size_t)(k0 + k) * w.N + n0 + n) : make_float4(0.f, 0.f, 0.f, 0.f); }
    }
#pragma unroll
    for (int b = 0; b < WB; ++b)
#pragma unroll
      for (int i = 0; i < 2; ++i) { const int e = tid + NTHR * i, k = e >> 4, n = (e & 15) * 4; float* tb = tile + b * (64 * 65); tb[k * 65 + n] = v4[b][i].x; tb[k * 65 + n + 1] = v4[b][i].y; tb[k * 65 + n + 2] = v4[b][i].z; tb[k * 65 + n + 3] = v4[b][i].w; }
    __syncthreads();
#pragma unroll
    for (int b = 0; b < WB; ++b) {
      WDesc w; int k0, n0; wconv_desc(p, it + b, w, k0, n0);
      const float* tb = tile + b * (64 * 65);
      const int n = tid >> 3, kc = (tid & 7) * 8;
      u32x4 o = {cvtpk(tb[kc * 65 + n], tb[(kc + 1) * 65 + n]), cvtpk(tb[(kc + 2) * 65 + n], tb[(kc + 3) * 65 + n]), cvtpk(tb[(kc + 4) * 65 + n], tb[(kc + 5) * 65 + n]), cvtpk(tb[(kc + 6) * 65 + n], tb[(kc + 7) * 65 + n])};
      *(u32x4*)(w.dst + (size_t)(n0 + n) * w.K + k0 + kc) = o;
    }
    __syncthreads();
  }
}
__device__ __forceinline__ void job_peer_conv(const Params& p) {
  const int tid = otid();
  const size_t gt = (size_t)blockIdx.x * NTHR + tid, gs = (size_t)gridDim.x * NTHR;
  const size_t nk8 = (size_t)4 * 16 * 16384 / 8;
  for (size_t i = gt; i < nk8; i += gs) {
    const size_t e = i * 8; const int blk = (int)(e >> 14), off = (int)(e & 16383); const int l = blk >> 4, h = (blk >> 1) & 7, side = blk & 1;
    const float* src = (side ? p.in[35] : p.in[34]) + ((size_t)(l * 8 + h) << 14) + off;
    const float4 a = *(const float4*)src, b = *(const float4*)(src + 4);
    u32x4 w = {cvtpk(a.x, a.y), cvtpk(a.z, a.w), cvtpk(b.x, b.y), cvtpk(b.z, b.w)};
    *(u32x4*)(WSP(bf16_t, OFF_KEYS) + e) = w;
  }
  const int lane = tid & 63, wg = blockIdx.x * 8 + (tid >> 6), nw = gridDim.x * 8;
  for (int r0 = wg; r0 < 2 * 4 * 16384; r0 += 4 * nw) {
    float4 x[4][4];
#pragma unroll
    for (int u = 0; u < 4; ++u) { const int r = r0 + u * nw; if (r < 2 * 4 * 16384) {
      const int isv = r >= 4 * 16384, row = isv ? r - 4 * 16384 : r;
      const float* src = (isv ? p.in[37] : p.in[36]) + (size_t)row * 1024 + lane * 16;
#pragma unroll
      for (int j = 0; j < 4; ++j) x[u][j] = *(const float4*)(src + 4 * j); } }
#pragma unroll
    for (int u = 0; u < 4; ++u) { const int r = r0 + u * nw; if (r < 2 * 4 * 16384) {
      const int isv = r >= 4 * 16384, row = isv ? r - 4 * 16384 : r;
      float am = 0.f;
#pragma unroll
      for (int j = 0; j < 4; ++j) am = fmaxf(am, fmaxf(fmaxf(fabsf(x[u][j].x), fabsf(x[u][j].y)), fmaxf(fabsf(x[u][j].z), fabsf(x[u][j].w))));
      am = wmax(am);
      u32x4 w; float isc;
      if (isv) {
        int e = (int)((__float_as_uint(am) >> 23) & 255u) - 127; e = e < -100 ? -100 : (e > 100 ? 100 : e);
        const int k = 7 - e;
        const float sc = __uint_as_float((unsigned)(k + 127) << 23); isc = __uint_as_float((unsigned)(127 - k) << 23);
#pragma unroll
        for (int j = 0; j < 4; ++j) { int q = 0; q = __builtin_amdgcn_cvt_pk_fp8_f32(x[u][j].x * sc, x[u][j].y * sc, q, false); q = __builtin_amdgcn_cvt_pk_fp8_f32(x[u][j].z * sc, x[u][j].w * sc, q, true); w[j] = (unsigned)q; }
      } else {
        const float sc = am > 0.f ? 127.f / am : 0.f; isc = am * (1.f / 127.f);
#pragma unroll
        for (int j = 0; j < 4; ++j) { const int q0 = (int)__builtin_rintf(x[u][j].x * sc), q1 = (int)__builtin_rintf(x[u][j].y * sc), q2 = (int)__builtin_rintf(x[u][j].z * sc), q3 = (int)__builtin_rintf(x[u][j].w * sc);
          w[j] = ((unsigned)q0 & 255u) | (((unsigned)q1 & 255u) << 8) | (((unsigned)q2 & 255u) << 16) | ((unsigned)q3 << 24); }
      }
      *(u32x4*)(WSP(unsigned char, OFF_PU) + (size_t)row * 2048 + (isv ? 1024 : 0) + lane * 16) = w;
      if (lane == 0) (isv ? WSP(float, OFF_SV) : WSP(float, OFF_SU))[row] = isc;
    } }
  }
}
__device__ __forceinline__ void job_adaln_partial(const Params& p, char* lds) {
  float* sl = (float*)lds;
  float* red = (float*)lds + 1024;
  const int tid = otid();
  for (int it = blockIdx.x; it < 768; it += gridDim.x) {
    const int l = it / 192, rem = it - l * 192, cgp = rem >> 3, ks = rem & 7;
    const int cq = tid & 63, kg = tid >> 6;
    float4 wv[16];
#pragma unroll
    for (int i = 0; i < 16; ++i) wv[i] = *(const float4*)(p.in[4] + ((size_t)l * 1024 + ks * 128 + kg * 16 + i) * 6144 + cgp * 256 + cq * 4);
    __builtin_amdgcn_sched_barrier(0);
    for (int e = tid; e < 640; e += NTHR) { const int r = e >> 7, k = e & 127; const float v = (r < 4) ? p.in[1][r * 1024 + ks * 128 + k] : p.in[3][ks * 128 + k]; sl[e] = v / (1.f + __expf(-v)); }
    __syncthreads();
    float4 acc[5];
#pragma unroll
    for (int r = 0; r < 5; ++r) acc[r] = make_float4(0.f, 0.f, 0.f, 0.f);
#pragma unroll
    for (int i = 0; i < 16; ++i) {
      const int k = kg * 16 + i;
      const float4 w = wv[i];
#pragma unroll
      for (int r = 0; r < 5; ++r) { const float sv = sl[r * 128 + k]; acc[r].x += sv * w.x; acc[r].y += sv * w.y; acc[r].z += sv * w.z; acc[r].w += sv * w.w; }
    }
#pragma unroll
    for (int r = 0; r < 5; ++r) *(float4*)(red + (kg * 5 + r) * 256 + cq * 4) = acc[r];
    __syncthreads();
    for (int e = tid; e < 1280; e += NTHR) {
      const int r = e >> 8, col = e & 255; float s = 0.f;
#pragma unroll
      for (int g = 0; g < 8; ++g) s += red[(g * 5 + r) * 256 + col];
      WSP(float, OFF_MODP)[((size_t)(ks * 4 + l) * 5 + r) * 6144 + cgp * 256 + col] = s;
    }
    __syncthreads();
  }
}
__device__ __forceinline__ void job_hdn(const Params& p, char* lds) {
  float* h1s = (float*)lds;
  const int tid = otid(), tl = tid >> 6, r = tid & 63;
  for (int it = blockIdx.x; it < 544; it += gridDim.x) {
    const int s = it < 512 ? 0 : 1, chunk = it - s * 512, L = s ? 256 : 4096, tau = chunk * 8 + tl;
    float a1 = p.in[20][r] + ((float)tau / (float)(L - 1)) * p.in[19][r];
#pragma unroll 4
    for (int k = 0; k < 16; ++k) {
      const float f = 1e-4f + (float)k * ((15.f - 1e-4f) / 15.f);
      const float rev = f * (float)tau / (float)L;
      a1 += cos_rev(rev) * p.in[19][(1 + k) * 64 + r] - sin_rev(rev) * p.in[19][(17 + k) * 64 + r];
    }
    h1s[tl * 64 + r] = sin_rad(p.in[21][r] * a1);
    __syncthreads();
    float a2 = p.in[23][r];
    for (int q = 0; q < 64; ++q) a2 += h1s[tl * 64 + q] * p.in[22][q * 64 + r];
    WSP(float, OFF_HDN)[((size_t)s * 4096 + tau) * 64 + r] = sin_rad(p.in[24][r] * a2);
    __syncthreads();
  }
}
__device__ __forceinline__ void job_mod_final(const Params& p) {
  for (int e = blockIdx.x * NTHR + otid(); e < 4 * 5 * 6144; e += gridDim.x * NTHR) {
    const int l = e / 30720, rem = e - l * 30720, col = rem % 6144;
    float s = p.in[5][l * 6144 + col];
#pragma unroll
    for (int ks = 0; ks < 8; ++ks) s += WSP(float, OFF_MODP)[(size_t)ks * 4 * 30720 + e];
    WSP(float, OFF_MOD)[e] = s;
  }
}
__device__ __forceinline__ void job_gbuild(const Params& p, char* lds) {
  float* hd = (float*)lds;
  const int tid = otid();
  for (int it = blockIdx.x; it < 1024 + 64; it += gridDim.x) {
    const int s = it < 1024 ? 0 : 1, li = it - s * 1024, L = s ? 256 : 4096, tt = li >> 3, ct = li & 7;
    const int col = ct * 512 + tid, o = col >> 11, dir = (col >> 10) & 1, d = col & 1023;
    float w3c[64];
#pragma unroll
    for (int r = 0; r < 64; ++r) w3c[r] = p.in[25][r * 4096 + col];
    for (int e = tid; e < 2048; e += NTHR) hd[e] = WSP(float, OFF_HDN)[((size_t)s * 4096 + tt * 32) * 64 + e];
    __syncthreads();
    const float delta = 3.0701134573253945f + 12.280453829301578f * ((float)d / 1023.f);
    const float bias_o = p.in[26][o * 1024 + d];
    const int FCNs = 2 * L + 144, OFFs = L + 64;
    bf16_t* st = (bf16_t*)(lds + 8192);
    for (int j = 0; j < 32; ++j) {
      const int tau = tt * 32 + j;
      float f = 0.f;
#pragma unroll
      for (int r = 0; r < 64; ++r) f += hd[j * 64 + r] * w3c[r];
      const float t01 = (float)tau / (float)(L - 1);
      float val = f * (__expf(-t01 * delta) + 0.05f);
      if (dir == 0 && tau == 0) val += bias_o;
      st[j * 514 + tid] = f2bf(val);
    }
    __syncthreads();
    bf16_t* Gbase = (s ? WSP(bf16_t, OFF_GCTX) : WSP(bf16_t, OFF_GLAT));
    for (int e = tid; e < 512 * 32; e += NTHR) {
      const int cl = e >> 5, i = e & 31, colg = ct * 512 + cl, og = colg >> 11, dirg = (colg >> 10) & 1, dg = colg & 1023;
      bf16_t* Gp = Gbase + (size_t)(og * 1024 + dg) * FCNs;
      if (dirg == 0) Gp[OFFs - tt * 32 - 31 + i] = st[(31 - i) * 514 + cl];
      else if (tt * 32 + i > 0) Gp[OFFs + tt * 32 + i] = st[i * 514 + cl];
    }
    if (tt == 0) {
      bf16_t* Gp = Gbase + (size_t)(o * 1024 + d) * FCNs;
      if (dir == 0) { for (int w = 0; w <= 64; ++w) Gp[w] = 0; } else { for (int w = 2 * L + 64; w < FCNs; ++w) Gp[w] = 0; }
    }
    __syncthreads();
  }
}
__device__ __forceinline__ void job_init(const Params& p) {
  const size_t n4 = (size_t)T * 256;
  for (size_t i = (size_t)blockIdx.x * NTHR + otid(); i < n4; i += (size_t)gridDim.x * NTHR) {
    const int row = (int)(i >> 8), c = (int)(i & 255) * 4;
    const RowInfo ri = row_info(row);
    const float* src = ri.is_ctx ? p.in[2] + ((size_t)(ri.b * CTXL + ri.rb) * 1024 + c) : p.in[0] + ((size_t)(ri.b * SEQ + ri.pos) * 1024 + c);
    const float4 v = *(const float4*)src;
    { u32x2 xw = {cvtpk(v.x, v.y), cvtpk(v.z, v.w)}; *(u32x2*)(WSP(bf16_t, OFF_X) + (size_t)row * 1024 + c) = xw; }
    const float* md = WSP(float, OFF_MOD) + (size_t)ri.mrow * 6144;
    const float4 sh = *(const float4*)(md + c), sc = *(const float4*)(md + 1024 + c);
    u32x2 w = {cvtpk(v.x * (1.f + sc.x) + sh.x, v.y * (1.f + sc.y) + sh.y), cvtpk(v.z * (1.f + sc.z) + sh.z, v.w * (1.f + sc.w) + sh.w)};
    *(u32x2*)(WSP(bf16_t, OFF_H) + (size_t)row * 1024 + c) = w;
  }
}
__device__ __forceinline__ void job_mla_norm(const Params& p, int ia) {
  const int lane = otid() & 63, wg = blockIdx.x * 8 + (otid() >> 6), nw = gridDim.x * 8;
  const bf16_t* C1 = WSP(bf16_t, OFF_RA); bf16_t* CQN = WSP(bf16_t, OFF_RE); bf16_t* CKVN = WSP(bf16_t, OFF_RE) + (size_t)T * 768; bf16_t* KPE = WSP(bf16_t, OFF_RC) + (size_t)T * 1024;
  const float* qn = p.in[9] + ia * 768; const float* kn = p.in[12] + ia * 256;
  for (int row0 = wg; row0 < T; row0 += 2 * nw) {
    u32x2 vq[2][3], kvq[2]; unsigned xpq[2];
#pragma unroll
    for (int u = 0; u < 2; ++u) { const int row = row0 + u * nw; if (row < T) { const bf16_t* cr = C1 + (size_t)row * 1152;
#pragma unroll
      for (int j = 0; j < 3; ++j) vq[u][j] = *(const u32x2*)(cr + (j * 64 + lane) * 4);
      kvq[u] = *(const u32x2*)(cr + 768 + lane * 4); xpq[u] = *(const unsigned*)(cr + 1024 + 2 * (lane & 31)); } }
#pragma unroll
    for (int u = 0; u < 2; ++u) { const int row = row0 + u * nw; if (row < T) {
    float4 v[3]; float ss = 0.f;
#pragma unroll
    for (int j = 0; j < 3; ++j) { v[j] = make_float4(bflo(vq[u][j][0]), bfhi(vq[u][j][0]), bflo(vq[u][j][1]), bfhi(vq[u][j][1])); ss += v[j].x * v[j].x + v[j].y * v[j].y + v[j].z * v[j].z + v[j].w * v[j].w; }
    const float rq = rsqrtf(wsum(ss) * (1.f / 768.f) + 1e-6f);
#pragma unroll
    for (int j = 0; j < 3; ++j) { const int c = (j * 64 + lane) * 4; const float4 g = *(const float4*)(qn + c);
      u32x2 w = {cvtpk(v[j].x * rq * g.x, v[j].y * rq * g.y), cvtpk(v[j].z * rq * g.z, v[j].w * rq * g.w)}; *(u32x2*)(CQN + (size_t)row * 768 + c) = w; }
    const float4 kv = make_float4(bflo(kvq[u][0]), bfhi(kvq[u][0]), bflo(kvq[u][1]), bfhi(kvq[u][1]));
    const float rk = rsqrtf(wsum(kv.x * kv.x + kv.y * kv.y + kv.z * kv.z + kv.w * kv.w) * (1.f / 256.f) + 1e-6f);
    { const float4 g = *(const float4*)(kn + lane * 4);
      u32x2 w = {cvtpk(kv.x * rk * g.x, kv.y * rk * g.y), cvtpk(kv.z * rk * g.z, kv.w * rk * g.w)}; *(u32x2*)(CKVN + (size_t)row * 256 + lane * 4) = w; }
    if (lane < 32) {
      const float x0 = bflo(xpq[u]), x1 = bfhi(xpq[u]);
      const RowInfo ri = row_info(row);
      float o0 = x0, o1 = x1;
      if (!ri.is_ctx) { float c, s; rope_cs(ri.pos, lane, 16, c, s); o0 = x0 * c - x1 * s; o1 = x0 * s + x1 * c; }
      *(unsigned*)(KPE + (size_t)row * 64 + 2 * lane) = cvtpk(o0, o1);
    }
    } }
  }
}
__device__ __forceinline__ void job_gqa_norm(const Params& p) {
  const int lane = otid() & 63, wg = blockIdx.x * 8 + (otid() >> 6), nw = gridDim.x * 8;
  const bf16_t* QKV = WSP(bf16_t, OFF_RA); bf16_t* Qb = WSP(bf16_t, OFF_RB); bf16_t* Kb = WSP(bf16_t, OFF_RC); bf16_t* Vb = WSP(bf16_t, OFF_RD);
  for (int row = wg; row < T; row += nw) {
    const bf16_t* cr = QKV + (size_t)row * 1536;
    const RowInfo ri = row_info(row);
    float rc = 1.f, rs = 0.f;
    if (!ri.is_ctx) rope_cs(ri.pos, lane, 32, rc, rs);
    float2 xpa[10];
#pragma unroll
    for (int hh = 0; hh < 10; ++hh) { const unsigned w_ = *(const unsigned*)(cr + hh * 128 + 2 * lane); xpa[hh] = make_float2(bflo(w_), bfhi(w_)); }
    const u32x2 vraw = *(const u32x2*)(cr + 1280 + lane * 4);
#pragma unroll
    for (int hh = 0; hh < 10; ++hh) {
      const float2 xp = xpa[hh];
      const float rinv = rsqrtf(wsum(xp.x * xp.x + xp.y * xp.y) * (1.f / 128.f) + 1e-6f);
      const float2 g = *(const float2*)((hh < 8 ? p.in[30] : p.in[31]) + 2 * lane);
      const float x0 = xp.x * rinv * g.x, x1 = xp.y * rinv * g.y;
      const unsigned w = cvtpk(x0 * rc - x1 * rs, x0 * rs + x1 * rc);
      if (hh < 8) *(unsigned*)(Qb + (size_t)row * 1024 + hh * 128 + 2 * lane) = w; else *(unsigned*)(Kb + (size_t)row * 256 + (hh - 8) * 128 + 2 * lane) = w;
    }
    *(u32x2*)(Vb + (size_t)row * 256 + lane * 4) = vraw;
  }
}
__device__ __forceinline__ void job_ln1(const Params& p, int layer) {
  const bool skip_ctx = layer == DEPTH - 1;
  const int lane = otid() & 63, wg = blockIdx.x * 8 + (otid() >> 6), nw = gridDim.x * 8;
  const float* lnw = p.in[6] + (size_t)(layer * 2) * 1024; const float* lnb = p.in[7] + (size_t)(layer * 2) * 1024;
  for (int row0 = wg; row0 < T; row0 += 2 * nw) {
    u32x4 xv[2][2];
#pragma unroll
    for (int u = 0; u < 2; ++u) { const int row = row0 + u * nw; if (row < T && !(skip_ctx && row_info(row).is_ctx)) {
      const bf16_t* Xr = WSP(bf16_t, OFF_X) + (size_t)row * 1024;
      xv[u][0] = *(const u32x4*)(Xr + lane * 8); xv[u][1] = *(const u32x4*)(Xr + 512 + lane * 8); } }
#pragma unroll
    for (int u = 0; u < 2; ++u) { const int row = row0 + u * nw; if (row < T && !(skip_ctx && row_info(row).is_ctx)) {
      const RowInfo ri = row_info(row);
      const float* md = WSP(float, OFF_MOD) + ((size_t)layer * 5 + ri.mrow) * 6144;
      float r[16];
#pragma unroll
      for (int q = 0; q < 4; ++q) { r[2 * q] = bflo(xv[u][0][q]); r[2 * q + 1] = bfhi(xv[u][0][q]); r[8 + 2 * q] = bflo(xv[u][1][q]); r[8 + 2 * q + 1] = bfhi(xv[u][1][q]); }
      ln_row_finish(r, lane * 8, 512 + lane * 8, lnw, lnb, nullptr, WSP(bf16_t, OFF_H) + (size_t)row * 1024, md + 3072, md + 4096, nullptr, WSP(float, OFF_LST) + (size_t)row * 2);
    } }
  }
}
__device__ __forceinline__ void job_attn_mla(const Params& p, char* lds, bool skip_ctx) {
  const bf16_t* Qb = WSP(bf16_t, OFF_RB); const bf16_t* Kb = WSP(bf16_t, OFF_RC); const bf16_t* KPE = WSP(bf16_t, OFF_RC) + (size_t)T * 1024; const bf16_t* Vb = WSP(bf16_t, OFF_RD); bf16_t* AO = WSP(bf16_t, OFF_RF);
  for (int it0 = blockIdx.x; it0 < (skip_ctx ? 512 : 544); it0 += gridDim.x) {
    int it = it0;
    if ((gridDim.x & 7) == 0 && gridDim.x == 256 && it0 < 512) { const int xcd = it0 & 7, j = ((it0 & 255) >> 3) + 32 * (it0 >> 8); it = (xcd * 4 + (j >> 4)) * 16 + (j & 15); }
    int b, h, q0, seq;
    if (it < 512) { b = it >> 7; h = (it >> 4) & 7; q0 = b * RB + CTXL + (it & 15) * 256; seq = RB; } else { const int j = it - 512; b = j >> 3; h = j & 7; q0 = b * RB; seq = CTXL; }
    attn_body<192, 1536, 1024, 64, 1024, 1024, 1>(Qb + (size_t)q0 * 1536 + h * 192, Kb + (size_t)b * RB * 1024 + h * 128, KPE + (size_t)b * RB * 64, Vb + (size_t)b * RB * 1024 + h * 128,
                                                   AO + (size_t)q0 * 1024 + h * 128, seq, lds);
  }
}
__device__ __forceinline__ void job_attn_gqa(const Params& p, char* lds) {
  const bf16_t* Qb = WSP(bf16_t, OFF_RB); const bf16_t* Kb = WSP(bf16_t, OFF_RC); const bf16_t* Vb = WSP(bf16_t, OFF_RD); bf16_t* AO = WSP(bf16_t, OFF_RF);
  for (int it0 = blockIdx.x; it0 < 544; it0 += gridDim.x) {
    int it = it0;
    if ((gridDim.x & 7) == 0 && gridDim.x == 256 && it0 < 512) { const int xcd = it0 & 7, j = ((it0 & 255) >> 3) + 32 * (it0 >> 8); it = (xcd * 4 + (j >> 4)) * 16 + (j & 15); }
    int b, h, q0, seq;
    if (it < 512) { b = it >> 7; h = (it >> 4) & 7; q0 = b * RB + CTXL + (it & 15) * 256; seq = RB; } else { const int j = it - 512; b = j >> 3; h = j & 7; q0 = b * RB; seq = CTXL; }
    attn_body<128, 1024, 256, 64, 256, 1024, 1>(Qb + (size_t)q0 * 1024 + h * 128, Kb + (size_t)b * RB * 256 + (h >> 2) * 128, nullptr, Vb + (size_t)b * RB * 256 + (h >> 2) * 128,
                                                 AO + (size_t)q0 * 1024 + h * 128, seq, lds);
  }
}
constexpr int HY_FCN = 8352, HY_BS = 72, HY_VEN = 78 * HY_BS + 48;
static_assert(HY_FCN % 128 == 32 && HY_VEN % 128 == 32, "bank-spreading strides");
constexpr int HY_LDS = 4 * HY_FCN * 2 + 2 * 4 * HY_VEN * 2;
__device__ __forceinline__ float hy_short(const bf16_t* zr, int t, int L, float w0, float w1, float w2, float cb) {
  float v = cb + w1 * bf2f(zr[t]);
  if (t > 0) v += w0 * bf2f(zr[t - 1]);
  if (t + 1 < L) v += w2 * bf2f(zr[t + 1]);
  return v;
}
struct SeqPre { u32x4 zc[5]; unsigned zl[5], zr[5]; };
__device__ __forceinline__ void hy_seq_load(const Params& p, SeqPre& s, int ch, int L, int nb, int seq0) {
  const bf16_t* ZT = WSP(bf16_t, OFF_RA);
  const int cpb = (nb + 14) * 8, tid = otid();
#pragma unroll
  for (int i = 0; i < 5; ++i) {
    const int e = tid + NTHR * i, b = e / cpb, ci = e - b * cpb, t0 = ci * 8 - 7 * 64;
    s.zc[i] = (u32x4){0u, 0u, 0u, 0u}; s.zl[i] = 0u; s.zr[i] = 0u;
    if (e < 4 * cpb && t0 >= 0 && t0 < L) {
      const bf16_t* zr = ZT + (size_t)ch * T + b * RB + seq0;
      s.zc[i] = *(const u32x4*)(zr + t0);
      if (t0 > 0) s.zl[i] = zr[t0 - 1];
      if (t0 + 8 < L) s.zr[i] = zr[t0 + 8];
    }
  }
}
__device__ __forceinline__ void hy_seq_store(const Params& p, const SeqPre& s, bf16_t* dst, int ch, int L, int nb) {
  const float w0 = p.in[17][ch], w1 = p.in[17][3072 + ch], w2 = p.in[17][6144 + ch], cb = p.in[18][ch];
  const int cpb = (nb + 14) * 8, tid = otid();
#pragma unroll
  for (int i = 0; i < 5; ++i) {
    const int e = tid + NTHR * i, b = e / cpb, ci = e - b * cpb, t0 = ci * 8 - 7 * 64, lo = (ci >> 3) * HY_BS + (ci & 7) * 8;
    if (e < 4 * cpb) {
      u32x4 w = {0u, 0u, 0u, 0u};
      if (t0 >= 0 && t0 < L) {
        const u32x4 zc = s.zc[i];
        float z[10];
        z[0] = bflo(s.zl[i]); z[9] = bflo(s.zr[i]);
        z[1] = bflo(zc[0]); z[2] = bfhi(zc[0]); z[3] = bflo(zc[1]); z[4] = bfhi(zc[1]); z[5] = bflo(zc[2]); z[6] = bfhi(zc[2]); z[7] = bflo(zc[3]); z[8] = bfhi(zc[3]);
        float o[8];
#pragma unroll
        for (int k = 0; k < 8; ++k) o[k] = cb + w0 * z[k] + w1 * z[k + 1] + w2 * z[k + 2];
        w = (u32x4){cvtpk(o[0], o[1]), cvtpk(o[2], o[3]), cvtpk(o[4], o[5]), cvtpk(o[6], o[7])};
      }
      *(u32x4*)(dst + (size_t)b * HY_VEN + lo) = w;
    }
  }
}
struct FilPre { u32x4 cur[3], prv[3]; };
__device__ __forceinline__ void hy_fil_load(FilPre& f, const bf16_t* Gp, int L) {
  const int nch = (2 * L + 144) / 8, tid = otid();
#pragma unroll
  for (int i = 0; i < 3; ++i) {
    const int c = tid + NTHR * i;
    f.cur[i] = (u32x4){0u, 0u, 0u, 0u}; f.prv[i] = (u32x4){0u, 0u, 0u, 0u};
    if (c < nch) { f.cur[i] = *(const u32x4*)(Gp + c * 8); if (c > 0) f.prv[i] = *(const u32x4*)(Gp + c * 8 - 8); }
  }
}
__device__ __forceinline__ void hy_fil_store(const FilPre& f, bf16_t* FC, int L) {
  const int nch = (2 * L + 144) / 8, tid = otid();
#pragma unroll
  for (int i = 0; i < 3; ++i) {
    const int c = tid + NTHR * i;
    if (c < nch) {
      const u32x4 cur = f.cur[i]; const unsigned W3 = f.prv[i][3], W2 = f.prv[i][2];
      const u32x4 c1 = {__builtin_amdgcn_alignbyte(cur[0], W3, 2), __builtin_amdgcn_alignbyte(cur[1], cur[0], 2), __builtin_amdgcn_alignbyte(cur[2], cur[1], 2), __builtin_amdgcn_alignbyte(cur[3], cur[2], 2)};
      const u32x4 c2 = {W3, cur[0], cur[1], cur[2]};
      const u32x4 c3 = {__builtin_amdgcn_alignbyte(W3, W2, 2), __builtin_amdgcn_alignbyte(cur[0], W3, 2), __builtin_amdgcn_alignbyte(cur[1], cur[0], 2), __builtin_amdgcn_alignbyte(cur[2], cur[1], 2)};
      *(u32x4*)(FC + c * 8) = cur; *(u32x4*)(FC + HY_FCN + c * 8) = c1; *(u32x4*)(FC + 2 * HY_FCN + c * 8) = c2; *(u32x4*)(FC + 3 * HY_FCN + c * 8) = c3;
    }
  }
}
__device__ __forceinline__ void hy_conv(f32x16 (&acc)[2], const bf16_t* FC, const bf16_t* SRC, int nb, int q, int r32, int hi) {
  acc[0] = f32x16{}; acc[1] = f32x16{};
  const int OFFL = nb * 64 + 64, s = r32 & 3, al = r32 >> 2, bb = r32 & 3;
  const int mlo = 8 * q - (nb - 1), mhi = (8 * q + 7 < nb - 1) ? 8 * q + 7 : nb - 1;
  const bf16_t* fbase = FC + (size_t)s * HY_FCN + (8 * hi - r32 + OFFL + s);
  const bf16_t* vbase = SRC + (size_t)bb * HY_VEN + (8 * q + al + 7) * HY_BS + 8 * hi;
  typedef const volatile __attribute__((address_space(3))) s16x4* lds_v64;
  bf16x8 Wc[6], Bc[4], Wn[6], Bn[4];
#define HY_LOADM(W_, B_, mm) do { _Pragma("unroll") for (int x_ = 0; x_ < 6; ++x_) { const bf16_t* fp_ = fbase - 16 * (4 * (mm) + x_ - 3); const s16x4 lo_ = *(lds_v64)fp_, hh_ = *(lds_v64)(fp_ + 4); \
      W_[x_] = (bf16x8){lo_[0], lo_[1], lo_[2], lo_[3], hh_[0], hh_[1], hh_[2], hh_[3]}; } \
    _Pragma("unroll") for (int ks_ = 0; ks_ < 4; ++ks_) B_[ks_] = *(const bf16x8*)(vbase - (mm) * HY_BS + ks_ * 16); } while (0)
#define HY_MMA(W_, B_) do { _Pragma("unroll") for (int ks_ = 0; ks_ < 4; ++ks_) _Pragma("unroll") for (int it_ = 0; it_ < 2; ++it_) acc[it_] = __builtin_amdgcn_mfma_f32_32x32x16_bf16(W_[2 * it_ - ks_ + 3], B_[ks_], acc[it_], 0, 0, 0); \
    _Pragma("unroll") for (int i_ = 0; i_ < 8; ++i_) { __builtin_amdgcn_sched_group_barrier(0x008, 1, 0); __builtin_amdgcn_sched_group_barrier(0x100, 2, 0); } } while (0)
  HY_LOADM(Wc, Bc, mlo);
  int m = mlo;
  for (; m + 1 <= mhi; m += 2) {
    HY_LOADM(Wn, Bn, m + 1); HY_MMA(Wc, Bc);
    const int m2 = m + 2 <= mhi ? m + 2 : mhi;
    HY_LOADM(Wc, Bc, m2); HY_MMA(Wn, Bn);
  }
  if (m <= mhi) {
#pragma unroll
    for (int ks = 0; ks < 4; ++ks)
#pragma unroll
      for (int it = 0; it < 2; ++it) acc[it] = __builtin_amdgcn_mfma_f32_32x32x16_bf16(Wc[2 * it - ks + 3], Bc[ks], acc[it], 0, 0, 0);
  }
#undef HY_MMA
#undef HY_LOADM
}
__device__ __forceinline__ void hy_item(int it, int& s, int& d, int& L, int& nb, int& seq0) { s = it < 1024 ? 0 : 1; d = it & 1023; L = s ? 256 : 4096; nb = L >> 6; seq0 = s ? 0 : CTXL; }
__device__ __forceinline__ const bf16_t* hy_gptr(const Params& p, int s, int d, int L, int o) { return (s ? WSP(bf16_t, OFF_GCTX) : WSP(bf16_t, OFF_GLAT)) + (size_t)(o * 1024 + d) * (2 * L + 144); }
__device__ __forceinline__ void job_hyena(const Params& p, int ib, char* lds) {
  bf16_t* FC = (bf16_t*)lds; bf16_t* VE = FC + 4 * HY_FCN; bf16_t* ZE = VE + 4 * HY_VEN;
  bf16_t* YT = WSP(bf16_t, OFF_RB);
  const int tid = otid(), lane = tid & 63, q = tid >> 6, r32 = lane & 31, hi = lane >> 5;
  SeqPre pa, pb; FilPre pf;
  int s, d, L, nb, seq0;
  if ((int)blockIdx.x < 2048) { hy_item(blockIdx.x, s, d, L, nb, seq0); hy_seq_load(p, pa, 2048 + d, L, nb, seq0); hy_seq_load(p, pb, d, L, nb, seq0); hy_fil_load(pf, hy_gptr(p, s, d, L, 0), L); }
  for (int it = blockIdx.x; it < 2048; it += gridDim.x) {
    hy_item(it, s, d, L, nb, seq0);
    hy_seq_store(p, pa, VE, 2048 + d, L, nb);
    hy_seq_store(p, pb, ZE, d, L, nb);
    hy_fil_store(pf, FC, L);
    __syncthreads();
    hy_seq_load(p, pa, 1024 + d, L, nb, seq0);
    hy_fil_load(pf, hy_gptr(p, s, d, L, 1), L);
    const bool active = 8 * q < nb;
    f32x16 acc[2];
    if (active) {
      hy_conv(acc, FC, VE, nb, q, r32, hi);
      const int a = 8 * q + (r32 >> 2), bb = r32 & 3;
      if (a < nb) {
#pragma unroll
        for (int i2 = 0; i2 < 2; ++i2)
#pragma unroll
          for (int r = 0; r < 16; ++r) { bf16_t* zp = ZE + (size_t)bb * HY_VEN + (a + 7) * HY_BS + i2 * 32 + crow(r, hi); *zp = f2bf(bf2f(*zp) * acc[i2][r]); }
      }
    }
    __syncthreads();
    hy_seq_store(p, pa, VE, 1024 + d, L, nb);
    hy_fil_store(pf, FC, L);
    __syncthreads();
    { const int nit = it + gridDim.x;
      if (nit < 2048) { int s2, d2, L2, nb2, sq2; hy_item(nit, s2, d2, L2, nb2, sq2); hy_seq_load(p, pa, 2048 + d2, L2, nb2, sq2); hy_seq_load(p, pb, d2, L2, nb2, sq2); hy_fil_load(pf, hy_gptr(p, s2, d2, L2, 0), L2); } }
    if (active) {
      hy_conv(acc, FC, ZE, nb, q, r32, hi);
      const int a = 8 * q + (r32 >> 2), bb = r32 & 3;
      if (a < nb) {
#pragma unroll
        for (int i2 = 0; i2 < 2; ++i2)
#pragma unroll
          for (int r = 0; r < 16; ++r) { bf16_t* vp = VE + (size_t)bb * HY_VEN + (a + 7) * HY_BS + i2 * 32 + crow(r, hi); *vp = f2bf(bf2f(*vp) * acc[i2][r]); }
      }
    }
    __syncthreads();
    for (int e = tid; e < 4 * (L / 8); e += NTHR) {
      const int b = e / (L / 8), t0 = (e - b * (L / 8)) * 8;
      *(u32x4*)(YT + (size_t)d * T + b * RB + seq0 + t0) = *(const u32x4*)(VE + (size_t)b * HY_VEN + (7 + (t0 >> 6)) * HY_BS + (t0 & 63));
    }
    __syncthreads();
  }
}
__device__ __forceinline__ void job_transpose_y(const Params& p, char* lds) {
  bf16_t* tile = (bf16_t*)lds;
  const bf16_t* YT = WSP(bf16_t, OFF_RB); bf16_t* Ytr = WSP(bf16_t, OFF_RC);
  const int tid = otid();
  for (int it = blockIdx.x; it < 16 * 68; it += gridDim.x) {
    const int dt = it / 68, tt = it - dt * 68, d0 = dt * 64, t0 = tt * 256;
    u32x4 v[4];
#pragma unroll
    for (int i = 0; i < 4; ++i) { const int e = tid + NTHR * i, dr = e >> 5, c = e & 31; v[i] = *(const u32x4*)(YT + (size_t)(d0 + dr) * T + t0 + c * 8); }
#pragma unroll
    for (int i = 0; i < 4; ++i) { const int e = tid + NTHR * i, dr = e >> 5, c = e & 31; *(u32x4*)(tile + dr * 264 + c * 8) = v[i]; }
    __syncthreads();
#pragma unroll
    for (int i = 0; i < 4; ++i) {
      const int e = tid + NTHR * i, tr = e >> 3, c = e & 7;
      unsigned short q[8];
#pragma unroll
      for (int k = 0; k < 8; ++k) q[k] = tile[(c * 8 + k) * 264 + tr];
      u32x4 w = {(unsigned)q[0] | ((unsigned)q[1] << 16), (unsigned)q[2] | ((unsigned)q[3] << 16), (unsigned)q[4] | ((unsigned)q[5] << 16), (unsigned)q[6] | ((unsigned)q[7] << 16)};
      *(u32x4*)(Ytr + (size_t)(t0 + tr) * 1024 + d0 + c * 8) = w;
    }
    __syncthreads();
  }
}
__device__ __forceinline__ void job_topk(const Params& p, bool skip_ctx) {
  const float* TL = WSP(float, OFF_RA);
  const float NEG = -3.0e38f;
  for (int item = blockIdx.x * NTHR + otid(); item < T * 8; item += gridDim.x * NTHR) {
    const int t = item >> 3, h = item & 7;
    if (skip_ctx && row_info(t).is_ctx) continue;
    float L1[16], L2[16], L3[16];
    { const float4* s = (const float4*)(TL + (size_t)item * 32);
#pragma unroll
      for (int q = 0; q < 4; ++q) { const float4 a = s[q], b = s[4 + q]; L1[4 * q] = a.x; L1[4 * q + 1] = a.y; L1[4 * q + 2] = a.z; L1[4 * q + 3] = a.w; L2[4 * q] = b.x; L2[4 * q + 1] = b.y; L2[4 * q + 2] = b.z; L2[4 * q + 3] = b.w; } }
    {
      float c[4][16];
      int n = 0;
#pragma unroll
      for (int i = 0; i < 16; ++i)
#pragma unroll
        for (int j = 0; j < 16; ++j)
          if ((i + 1) * (j + 1) <= 16) {
            const float sum = __uint_as_float(__float_as_uint(L1[i]) & ~127u) + __uint_as_float(__float_as_uint(L2[j]) & ~127u);
            c[n >> 4][n & 15] = __uint_as_float((__float_as_uint(sum) & ~255u) | (unsigned)(i * 16 + j));
            ++n;
          }
#pragma unroll
      for (int q = 50; q < 64; ++q) c[q >> 4][q & 15] = NEG;
      bsort16(c[0]); bsort16(c[1]); bsort16(c[2]); bsort16(c[3]);
#pragma unroll
      for (int q = 0; q < 16; ++q) L3[q] = c[0][q];
      merge_top16(L3, c[1]); merge_top16(L3, c[2]); merge_top16(L3, c[3]);
    }
    float ev[16]; float den = 0.f;
    const float mx = __uint_as_float(__float_as_uint(L3[0]) & ~255u);
#pragma unroll
    for (int k = 0; k < 16; ++k) { ev[k] = __expf(__uint_as_float(__float_as_uint(L3[k]) & ~255u) - mx); den += ev[k]; }
    const float rden = 1.f / den;
    int* ip = WSP(int, OFF_RC) + ((size_t)t * 8 + h) * 16; float* gp = WSP(float, OFF_RC + (size_t)T * 128 * 4) + ((size_t)t * 8 + h) * 16;
#pragma unroll
    for (int k = 0; k < 16; ++k) {
      const unsigned code = __float_as_uint(L3[k]) & 255u; const int ii = code >> 4, jj = code & 15;
      unsigned b1 = 0, b2 = 0;
#pragma unroll
      for (int i = 0; i < 16; ++i) { b1 = (ii == i) ? __float_as_uint(L1[i]) : b1; b2 = (jj == i) ? __float_as_uint(L2[i]) : b2; }
      ip[k] = (int)((b1 & 127u) * 128u + (b2 & 127u));
      gp[k] = ev[k] * rden;
    }
  }
}
__device__ __forceinline__ float gelu_as(float v) {
  const float t = __builtin_amdgcn_rcpf(fabsf(v) * 0.2316418882f + 1.0f);
  float q = t * 0.5307027145f + (-0.7265760135f); q = q * t + 0.7107068705f; q = q * t + (-0.142248368f); q = q * t + 0.127414796f; q = q * t;
  const float m = v * (q * __builtin_amdgcn_exp2f(v * v * (-0.72134752044f)));
  return v < 0.f ? m : v - m;
}
__device__ __forceinline__ void job_peer_gather(const Params& p, int layer) {
  const int lane = otid() & 63, wg = blockIdx.x * 8 + (otid() >> 6), nw = gridDim.x * 8;
  const unsigned char* U = WSP(unsigned char, OFF_PU) + (size_t)layer * 16384 * 2048;
  const float* SU = WSP(float, OFF_SU) + layer * 16384; const float* SV = WSP(float, OFF_SV) + layer * 16384;
  const float* lnw = p.in[6] + (size_t)(layer * 2 + 1) * 1024; const float* lnb = p.in[7] + (size_t)(layer * 2 + 1) * 1024;
  const float* lnw0 = p.in[6] + (size_t)(layer * 2) * 1024; const float* lnb0 = p.in[7] + (size_t)(layer * 2) * 1024;
  const bool last = layer == DEPTH - 1;
  const int NV = last ? NBATCH * SEQ : T;
#define VROW(v) (last ? (((v) >> 12) * RB + CTXL + ((v) & 4095)) : (v))
  const int nfull = NV / nw, nrem = NV - nfull * nw, xper = nrem / (int)gridDim.x, wv = otid() >> 6;
  const int nmine = nfull + ((nrem % (int)gridDim.x) == 0 && wv < xper ? 1 : 0) + ((nrem % (int)gridDim.x) != 0 && wg < nrem ? 1 : 0);
#define VIDX(k) ((k) < nfull ? wg + (k) * nw : (((nrem % (int)gridDim.x) == 0) ? nfull * nw + (int)blockIdx.x * xper + wv : nfull * nw + wg))
  int nidx0 = 0, nidx1 = 0; float ng0 = 0.f, ng1 = 0.f, nsu0 = 0.f, nsu1 = 0.f, nsv0 = 0.f, nsv1 = 0.f; u32x4 nha = {0u, 0u, 0u, 0u}, nhb = {0u, 0u, 0u, 0u};
  int nh8[4] = {0, 0, 0, 0}; float nsh = 0.f;
#define GQUANT() do { float hv_[16]; _Pragma("unroll") for (int i_ = 0; i_ < 4; ++i_) { hv_[2 * i_] = bflo(nha[i_]); hv_[2 * i_ + 1] = bfhi(nha[i_]); hv_[8 + 2 * i_] = bflo(nhb[i_]); hv_[8 + 2 * i_ + 1] = bfhi(nhb[i_]); } \
    float am_ = 0.f; _Pragma("unroll") for (int i_ = 0; i_ < 16; ++i_) am_ = fmaxf(am_, fabsf(hv_[i_])); \
    am_ = wmax(am_); \
    const float qs_ = am_ > 0.f ? 127.f / am_ : 0.f; nsh = am_ * (1.f / 127.f); \
    _Pragma("unroll") for (int i_ = 0; i_ < 4; ++i_) { const int q0_ = (int)__builtin_rintf(hv_[4 * i_] * qs_), q1_ = (int)__builtin_rintf(hv_[4 * i_ + 1] * qs_), q2_ = (int)__builtin_rintf(hv_[4 * i_ + 2] * qs_), q3_ = (int)__builtin_rintf(hv_[4 * i_ + 3] * qs_); \
      nh8[i_] = (int)(((unsigned)q0_ & 255u) | (((unsigned)q1_ & 255u) << 8) | (((unsigned)q2_ & 255u) << 16) | ((unsigned)q3_ << 24)); } } while (0)
  if (nmine > 0) {
    const int wg_ = VROW(VIDX(0));
    nidx0 = WSP(int, OFF_RC)[(size_t)wg_ * 128 + lane]; nidx1 = WSP(int, OFF_RC)[(size_t)wg_ * 128 + 64 + lane];
    ng0 = WSP(float, OFF_RC + (size_t)T * 128 * 4)[(size_t)wg_ * 128 + lane]; ng1 = WSP(float, OFF_RC + (size_t)T * 128 * 4)[(size_t)wg_ * 128 + 64 + lane];
    nha = *(const u32x4*)(WSP(bf16_t, OFF_H) + (size_t)wg_ * 1024 + lane * 16); nhb = *(const u32x4*)(WSP(bf16_t, OFF_H) + (size_t)wg_ * 1024 + lane * 16 + 8);
    nsu0 = SU[nidx0]; nsu1 = SU[nidx1]; nsv0 = SV[nidx0]; nsv1 = SV[nidx1];
    GQUANT();
  }
  for (int kk = 0; kk < nmine; ++kk) {
    const int vr = VIDX(kk), row = VROW(vr);
    const RowInfo ri = row_info(row);
    const int h8[4] = {nh8[0], nh8[1], nh8[2], nh8[3]}; const float shq = nsh;
    float out[16];
    const int myidx0 = nidx0, myidx1 = nidx1;
    const float mysu0 = nsu0 * shq, mysu1 = nsu1 * shq, mygv0 = ng0, mygv1 = ng1, mysv0 = nsv0, mysv1 = nsv1;
    bf16_t* Xr = WSP(bf16_t, OFF_X) + (size_t)row * 1024;
    float4 xr[4];
    { const u32x4 xa = *(const u32x4*)(Xr + lane * 16), xb = *(const u32x4*)(Xr + lane * 16 + 8);
      xr[0] = make_float4(bflo(xa[0]), bfhi(xa[0]), bflo(xa[1]), bfhi(xa[1])); xr[1] = make_float4(bflo(xa[2]), bfhi(xa[2]), bflo(xa[3]), bfhi(xa[3]));
      xr[2] = make_float4(bflo(xb[0]), bfhi(xb[0]), bflo(xb[1]), bfhi(xb[1])); xr[3] = make_float4(bflo(xb[2]), bfhi(xb[2]), bflo(xb[3]), bfhi(xb[3])); }
    const bool hasn = kk + 1 < nmine; const int nvr = hasn ? VIDX(kk + 1) : 0, nrow = VROW(nvr);
    if (hasn) {
      nidx0 = WSP(int, OFF_RC)[(size_t)nrow * 128 + lane]; nidx1 = WSP(int, OFF_RC)[(size_t)nrow * 128 + 64 + lane];
      ng0 = WSP(float, OFF_RC + (size_t)T * 128 * 4)[(size_t)nrow * 128 + lane]; ng1 = WSP(float, OFF_RC + (size_t)T * 128 * 4)[(size_t)nrow * 128 + 64 + lane];
      nha = *(const u32x4*)(WSP(bf16_t, OFF_H) + (size_t)nrow * 1024 + lane * 16); nhb = *(const u32x4*)(WSP(bf16_t, OFF_H) + (size_t)nrow * 1024 + lane * 16 + 8);
    }
#pragma unroll 1
    for (int rep_ = 0; rep_ < R_GATHER; ++rep_) {
    h16x2 outh[8];
#pragma unroll
    for (int i = 0; i < 8; ++i) outh[i] = (h16x2){(_Float16)0.f, (_Float16)0.f};
#pragma unroll 1
    for (int e0 = 0; e0 < 128; e0 += 8) {
      u32x4 uq[8], vq[8];
#pragma unroll
      for (int qq = 0; qq < 8; ++qq) {
        const int e = e0 + qq;
        const int id = __builtin_amdgcn_readlane(e0 < 64 ? myidx0 : myidx1, e & 63);
        const unsigned char* rp = U + (size_t)id * 2048 + lane * 16; uq[qq] = *(const u32x4*)rp; vq[qq] = *(const u32x4*)(rp + 1024);
      }
      int d[8];
#pragma unroll
      for (int qq = 0; qq < 8; ++qq) {
        int a = 0;
#pragma unroll
        for (int i = 0; i < 4; ++i) a = __builtin_amdgcn_sdot4((int)uq[qq][i], h8[i], a, false);
        d[qq] = a;
      }
      { const bool up = lane & 1;
#pragma unroll
        for (int j = 0; j < 4; ++j) { const int snd = up ? d[j] : d[j + 4], kp = up ? d[j + 4] : d[j]; d[j] = kp + xl1(snd); } }
      { const bool up = lane & 2;
#pragma unroll
        for (int j = 0; j < 2; ++j) { const int snd = up ? d[j] : d[j + 2], kp = up ? d[j + 2] : d[j]; d[j] = kp + xl2(snd); } }
      { const bool up = lane & 4; const int snd = up ? d[0] : d[1], kp = up ? d[1] : d[0]; d[0] = kp + xl4(snd); }
      int toti = d[0];
      toti += xl8(toti); toti = sum_x16(toti); toti = sum_x32(toti);
      const int ex = ((lane & 1) << 2) | (lane & 2) | ((lane >> 2) & 1);
      const float su_l = __shfl(e0 < 64 ? mysu0 : mysu1, (e0 + ex) & 63), gv_l = __shfl(e0 < 64 ? mygv0 : mygv1, (e0 + ex) & 63);
      const float cf_l = gv_l * gelu_as((float)toti * su_l);
#pragma unroll
      for (int qq = 0; qq < 8; ++qq) {
        const float cf = __uint_as_float(__builtin_amdgcn_readlane(__float_as_uint(cf_l), ((qq >> 2) & 1) | (((qq >> 1) & 1) << 1) | ((qq & 1) << 2)));
        const float svq = __uint_as_float(__builtin_amdgcn_readlane(__float_as_uint(e0 < 64 ? mysv0 : mysv1), (e0 + qq) & 63));
        const h16x2 cfh = {(_Float16)cf, (_Float16)cf};
#pragma unroll
        for (int i = 0; i < 4; ++i) { const h16x2 lo = __builtin_amdgcn_cvt_scalef32_pk_f16_fp8((int)vq[qq][i], svq, false), hi = __builtin_amdgcn_cvt_scalef32_pk_f16_fp8((int)vq[qq][i], svq, true);
          outh[2 * i] = __builtin_elementwise_fma(cfh, lo, outh[2 * i]); outh[2 * i + 1] = __builtin_elementwise_fma(cfh, hi, outh[2 * i + 1]); }
      }
    }
#pragma unroll
    for (int i = 0; i < 4; ++i) { out[4 * i] = (float)outh[2 * i][0]; out[4 * i + 1] = (float)outh[2 * i][1]; out[4 * i + 2] = (float)outh[2 * i + 1][0]; out[4 * i + 3] = (float)outh[2 * i + 1][1]; }
    }
    if (hasn) { nsu0 = SU[nidx0]; nsu1 = SU[nidx1]; nsv0 = SV[nidx0]; nsv1 = SV[nidx1]; GQUANT(); }
    const float* md = WSP(float, OFF_MOD) + ((size_t)layer * 5 + ri.mrow) * 6144;
    float r[16];
    { const int c0 = lane * 16;
      const float2 st1 = *(const float2*)(WSP(float, OFF_LST) + (size_t)row * 2);
#pragma unroll
      for (int i = 0; i < 4; ++i) { const float4 g4 = *(const float4*)(md + 5120 + c0 + 4 * i), w4 = *(const float4*)(lnw0 + c0 + 4 * i), b4 = *(const float4*)(lnb0 + c0 + 4 * i);
        r[4 * i] = ALPHA * ((xr[i].x - st1.x) * st1.y * w4.x + b4.x) + g4.x * out[4 * i]; r[4 * i + 1] = ALPHA * ((xr[i].y - st1.x) * st1.y * w4.y + b4.y) + g4.y * out[4 * i + 1];
        r[4 * i + 2] = ALPHA * ((xr[i].z - st1.x) * st1.y * w4.z + b4.z) + g4.z * out[4 * i + 2]; r[4 * i + 3] = ALPHA * ((xr[i].w - st1.x) * st1.y * w4.w + b4.w) + g4.w * out[4 * i + 3]; } }
    const float* mdn = WSP(float, OFF_MOD) + ((size_t)(last ? layer : layer + 1) * 5 + ri.mrow) * 6144;
    float* orow = (last && !ri.is_ctx) ? p.out + ((size_t)(ri.b * SEQ + ri.pos)) * 1024 : nullptr;
    ln_row_finish(r, lane * 16, lane * 16 + 8, lnw, lnb, Xr, last ? nullptr : WSP(bf16_t, OFF_H) + (size_t)row * 1024, mdn, mdn + 1024, orow);
  }
#undef GQUANT
#undef VROW
#undef VIDX
}

#define XB_TMO      128
#define XB_XCNT(j)  (256  + 64 * (j))
#define XB_XSUB(j)  (1280 + 64 * (j))
#define XB_XGEN(j)  (2304 + 64 * (j))
#define XB_TOP      3328
#define XB_TOPGEN   3392
#define XCD_BAR_WORDS 3456
#define XB_SPIN_CAP (1u << 22)
__device__ __forceinline__ unsigned xb_ld(unsigned* p)              { return __hip_atomic_load(p, __ATOMIC_RELAXED, __HIP_MEMORY_SCOPE_AGENT); }
__device__ __forceinline__ unsigned xb_add(unsigned* p, unsigned v) { return __hip_atomic_fetch_add(p, v, __ATOMIC_RELAXED, __HIP_MEMORY_SCOPE_AGENT); }
__device__ __forceinline__ unsigned xb_xcc_id() { return (unsigned)__builtin_amdgcn_s_getreg((3 << 11) | 20) & 0xFu; }
#define XB_SPIN(cond, bar) do { unsigned _sp = 0; while (cond) { __builtin_amdgcn_s_sleep(1); \
    if ((++_sp & 255u) == 0u) { if (xb_ld(&(bar)[XB_TMO])) break; if (_sp > XB_SPIN_CAP) { atomicAdd(&(bar)[XB_TMO], 1u); break; } } } } while (0)
struct XcdBarrier { unsigned* bar; unsigned x; volatile LAS unsigned* st; };
__device__ __forceinline__ XcdBarrier xcd_barrier_post(unsigned* bar, volatile LAS unsigned* st) {
  XcdBarrier b; b.bar = bar; b.x = xb_xcc_id(); b.st = st;
  if (threadIdx.x == 0) (void)xb_add(&bar[XB_XCNT(b.x)], 1u);
  return b;
}
__device__ __forceinline__ void xcd_barrier_complete(unsigned* bar, unsigned x, unsigned& nloc, unsigned& nx) {
  const unsigned G = gridDim.x * gridDim.y * gridDim.z;
  unsigned sum, cnt, mine, sp = 0u;
  for (;;) {
    sum = 0u; cnt = 0u; mine = 0u;
#pragma unroll
    for (unsigned j = 0; j < 16; ++j) { const unsigned c = xb_ld(&bar[XB_XCNT(j)]); sum += c; cnt += (c > 0u) ? 1u : 0u; mine = (j == x) ? c : mine; }
    if (sum == G) break;
    __builtin_amdgcn_s_sleep(1);
    if ((++sp & 255u) == 0u) { if (xb_ld(&bar[XB_TMO])) break; if (sp > XB_SPIN_CAP) { atomicAdd(&bar[XB_TMO], 1u); break; } }
  }
  nloc = mine > 0u ? mine : 1u; nx = cnt > 0u ? cnt : 1u;
}
__device__ __forceinline__ void xcd_barrier(const XcdBarrier& b) {
  asm volatile("s_waitcnt vmcnt(0)" ::: "memory");
  __syncthreads();
  if (threadIdx.x == 0) {
    unsigned* bar = b.bar;
    __builtin_amdgcn_s_waitcnt(0);
    unsigned nloc = b.st[0], nx = b.st[1];
    if (nloc == 0u) { xcd_barrier_complete(bar, b.x, nloc, nx); b.st[0] = nloc; b.st[1] = nx; }
    const unsigned old = xb_add(&bar[XB_XSUB(b.x)], 1u);
    const unsigned gen = old / nloc;
    if (old + 1u == (gen + 1u) * nloc) {
      __builtin_amdgcn_fence(__ATOMIC_RELEASE, "agent");
      asm volatile("s_waitcnt vmcnt(0)" ::: "memory");
      const unsigned og = xb_add(&bar[XB_TOP], 1u);
      const unsigned tg = og / nx;
      if (og + 1u == (tg + 1u) * nx) xb_add(&bar[XB_TOPGEN], 1u);
      else XB_SPIN(xb_ld(&bar[XB_TOPGEN]) == tg, bar);
      __builtin_amdgcn_fence(__ATOMIC_ACQUIRE, "agent");
      xb_add(&bar[XB_XGEN(b.x)], 1u);
      asm volatile("s_waitcnt vmcnt(0)" ::: "memory");
    } else {
      XB_SPIN(xb_ld(&bar[XB_XGEN(b.x)]) == gen, bar);
      __builtin_amdgcn_fence(__ATOMIC_ACQUIRE, "agent");
      asm volatile("s_waitcnt vmcnt(0)" ::: "memory");
    }
  }
  __syncthreads();
}

constexpr int PARAM_LDS = 512;
constexpr int LDS_BYTES = PARAM_LDS + HY_LDS;
static_assert(HY_LDS >= ATT_LDS && HY_LDS >= 2 * G_ASZ + 2 * G_BSZ, "LDS budget");
static_assert(sizeof(Params) <= PARAM_LDS && sizeof(Params) == 41 * 8, "Params layout");
__device__ __forceinline__ Params load_params(const char* lds) {
  int off = 0; asm volatile("" : "+v"(off));
  const unsigned* lp = (const unsigned*)(lds + off);
  Params p;
#pragma unroll
  for (int k = 0; k < 38; ++k) {
    const unsigned lo = __builtin_amdgcn_readfirstlane(lp[2 * k]), hi = __builtin_amdgcn_readfirstlane(lp[2 * k + 1]);
    p.in[k] = (const float*)(const float GAS*)(((unsigned long long)hi << 32) | lo);
  }
  { const unsigned lo = __builtin_amdgcn_readfirstlane(lp[76]), hi = __builtin_amdgcn_readfirstlane(lp[77]); p.out = (float*)(float GAS*)(((unsigned long long)hi << 32) | lo); }
  { const unsigned lo = __builtin_amdgcn_readfirstlane(lp[78]), hi = __builtin_amdgcn_readfirstlane(lp[79]); p.ws = (char*)(char GAS*)(((unsigned long long)hi << 32) | lo); }
  p.ph_begin = 0; p.ph_end = 0;
  return p;
}
__global__ void __launch_bounds__(NTHR) mega(const Params kp) {
  extern __shared__ __attribute__((aligned(16))) char lds_all[];
  cg::grid_group grid = cg::this_grid();
  if (threadIdx.x == 0) {
    unsigned long long* lp = (unsigned long long*)lds_all;
#pragma unroll
    for (int k = 0; k < 38; ++k) lp[k] = (unsigned long long)kp.in[k];
    lp[38] = (unsigned long long)kp.out; lp[39] = (unsigned long long)kp.ws;
  }
  if (threadIdx.x == 0) { volatile LAS unsigned* st0 = (volatile LAS unsigned*)(lds_all + 384); st0[0] = 0u; st0[1] = 0u; st0[2] = 0u; st0[3] = 0u; }
  __syncthreads();
  char* lds = lds_all + PARAM_LDS;
  const int ph_begin = kp.ph_begin, ph_end = kp.ph_end;
  (void)xcd_barrier_post((unsigned*)(kp.ws + OFF_BAR), (volatile LAS unsigned*)(lds_all + 384));
  int ph = 0;
#define PHASER(reps, ...) do { if (ph >= ph_begin && ph < ph_end) { const Params p = load_params(lds_all); for (int rep_ = 0; rep_ < (reps) + (ph == PROBE_PH ? 1 : 0); ++rep_) { __VA_ARGS__; } \
    if (ph + 1 < ph_end) { for (int rs_ = 0; rs_ < R_SYNC; ++rs_) { if (ph == 0) grid.sync(); else xcd_barrier(XcdBarrier{(unsigned*)(p.ws + OFF_BAR), xb_xcc_id(), (volatile LAS unsigned*)(lds_all + 384)}); } } } ++ph; } while (0)
#define PHASE(...) PHASER(1, __VA_ARGS__)
  PHASER(R_PRO, job_wconv(p, lds); job_adaln_partial(p, lds); job_hdn(p, lds); job_peer_conv(p));
  PHASER(R_PRO, job_mod_final(p); job_gbuild(p, lds));
  PHASER(R_PRO, job_init(p));
#pragma unroll 1
  for (int layer = 0; layer < DEPTH; ++layer) {
    const int kind = layer % 3;
    if (kind == 0) {
      const int ia = layer / 3;
      PHASER(R_GEMM, gemm8_job(WSP(bf16_t, OFF_H), 1024, WSP(bf16_t, OFF_W1 + (size_t)ia * SZ_W1), 1024, 1024, 1024, pg8::E8Bf16{WSP(bf16_t, OFF_RA), 1152, nullptr}, EpiBf16{WSP(bf16_t, OFF_RA), 1152}, lds, false, false);
            for (int s = (int)(gridDim.x - 1 - blockIdx.x); s < T / 64; s += gridDim.x)
              gemm_tile<EpiBf16, 2, 1, 1>(WSP(bf16_t, OFF_H), 1024, WSP(bf16_t, OFF_W1 + (size_t)ia * SZ_W1), 1024, 1024, s * 64, 1024, 0, EpiBf16{WSP(bf16_t, OFF_RA), 1152}, lds));
      PHASE(job_mla_norm(p, ia));
      PHASER(R_GEMM, gemm8_job(WSP(bf16_t, OFF_RE), 768, WSP(bf16_t, OFF_WUQ + (size_t)ia * SZ_WUQ), 768, 1536, 768, pg8::E8MlaQ{WSP(bf16_t, OFF_RB)}, EpiMlaQ{WSP(bf16_t, OFF_RB)}, lds, false, layer == DEPTH - 1);
            gemm8_job(WSP(bf16_t, OFF_RE) + (size_t)T * 768, 256, WSP(bf16_t, OFF_WUKV + (size_t)ia * SZ_WUKV), 256, 2048, 256, pg8::E8MlaKV{WSP(bf16_t, OFF_RC), WSP(bf16_t, OFF_RD)}, EpiMlaKV{WSP(bf16_t, OFF_RC), WSP(bf16_t, OFF_RD)}, lds, false, false, 16));
      PHASER(R_ATTN, job_attn_mla(p, lds, layer == DEPTH - 1));
      PHASER(R_GEMM, gemm8_job(WSP(bf16_t, OFF_RF), 1024, WSP(bf16_t, OFF_WOA + (size_t)ia * SZ_WSQ), 1024, 1024, 1024, pg8::E8Resid{WSP(bf16_t, OFF_X), WSP(float, OFF_MOD) + (size_t)layer * 5 * 6144 + 2048, nullptr},
                                EpiResid{WSP(bf16_t, OFF_X), WSP(float, OFF_MOD) + (size_t)layer * 5 * 6144 + 2048, nullptr}, lds, false, layer == DEPTH - 1));
      PHASE(job_ln1(p, layer));
    } else if (kind == 1) {
      PHASER(R_GEMM, gemm8t_job(WSP(bf16_t, OFF_WIN), WSP(bf16_t, OFF_H), 3072, 1024, pg8::E8Bf16{WSP(bf16_t, OFF_RA), T, p.in[16]}, EpiZT{WSP(bf16_t, OFF_RA), T, p.in[16]}, lds));
      PHASER(R_HYENA, job_hyena(p, 0, lds));
      PHASE(job_transpose_y(p, lds));
      PHASER(R_GEMM, gemm8_job(WSP(bf16_t, OFF_RC), 1024, WSP(bf16_t, OFF_WOUT), 1024, 1024, 1024, pg8::E8Resid{WSP(bf16_t, OFF_X), WSP(float, OFF_MOD) + (size_t)layer * 5 * 6144 + 2048, p.in[28]},
                                EpiResid{WSP(bf16_t, OFF_X), WSP(float, OFF_MOD) + (size_t)layer * 5 * 6144 + 2048, p.in[28]}, lds, false, false));
      PHASE(job_ln1(p, layer));
    } else {
      PHASER(R_GEMM, gemm8_job(WSP(bf16_t, OFF_H), 1024, WSP(bf16_t, OFF_WQKV), 1024, 1536, 1024, pg8::E8Bf16{WSP(bf16_t, OFF_RA), 1536, nullptr}, EpiBf16{WSP(bf16_t, OFF_RA), 1536}, lds, true, false));
      PHASE(job_gqa_norm(p));
      PHASER(R_ATTN, job_attn_gqa(p, lds));
      PHASER(R_GEMM, gemm8_job(WSP(bf16_t, OFF_RF), 1024, WSP(bf16_t, OFF_WOC), 1024, 1024, 1024, pg8::E8Resid{WSP(bf16_t, OFF_X), WSP(float, OFF_MOD) + (size_t)layer * 5 * 6144 + 2048, nullptr},
                                EpiResid{WSP(bf16_t, OFF_X), WSP(float, OFF_MOD) + (size_t)layer * 5 * 6144 + 2048, nullptr}, lds, false, layer == DEPTH - 1));
      PHASE(job_ln1(p, layer));
    }
    PHASER(R_GEMM, gemm8d_job(WSP(bf16_t, OFF_H), 1024, WSP(bf16_t, OFF_WQ + (size_t)layer * SZ_WQ), 1024, 2048, 1024, pg8::E8PeerTopk{WSP(bf16_t, OFF_KEYS) + (size_t)layer * 16 * 16384, WSP(float, OFF_RA)},
                               EpiPeerTopk{WSP(bf16_t, OFF_KEYS) + (size_t)layer * 16 * 16384, WSP(float, OFF_RA)}, lds, layer == DEPTH - 1));
    PHASER(R_TOPK, job_topk(p, layer == DEPTH - 1));
    PHASE(job_peer_gather(p, layer));
  }
#undef PHASE
#undef PHASER
}


#ifndef CUT_PHASE
#define CUT_PHASE NPHASES
#endif
#ifndef DUMP_OFF
#define DUMP_OFF OFF_RB
#endif
__global__ void __launch_bounds__(NTHR) dump_x(const Params p) {
  const size_t n4 = (size_t)NBATCH * SEQ * 256;
  for (size_t i = (size_t)blockIdx.x * NTHR + threadIdx.x; i < n4; i += (size_t)gridDim.x * NTHR)
    *(float4*)(p.out + i * 4) = *(const float4*)(WSP(float, DUMP_OFF) + i * 4);
}
extern "C" void kernel_launch(void* const* d_in, const int* in_sizes, int n_in, void* d_out, int out_size, void* d_ws, size_t ws_size, hipStream_t stream) {
  static int grid_blocks = 0;
  if (!grid_blocks) {
    int dev = 0, cus = 0, per_cu = 0;
    (void)hipGetDevice(&dev);
    (void)hipDeviceGetAttribute(&cus, hipDeviceAttributeMultiprocessorCount, dev);
    if (hipFuncSetAttribute((const void*)mega, hipFuncAttributeMaxDynamicSharedMemorySize, LDS_BYTES) != hipSuccess) fprintf(stderr, "kernel_launch: hipFuncSetAttribute failed\n");
    (void)hipOccupancyMaxActiveBlocksPerMultiprocessor(&per_cu, mega, NTHR, LDS_BYTES);
    if (per_cu < 1) { fprintf(stderr, "kernel_launch: occupancy query returned %d\n", per_cu); per_cu = 1; }
    if (per_cu > 1) per_cu = 1;
    grid_blocks = cus * per_cu;
  }
  if (n_in != 38 || WS_TOTAL > ws_size) { fprintf(stderr, "kernel_launch: bad call: n_in %d, workspace need %zu have %zu\n", n_in, (size_t)WS_TOTAL, ws_size); return; }
  Params p; memset(&p, 0, sizeof(p));
  for (int i = 0; i < 38; ++i) p.in[i] = (const float*)d_in[i];
  p.out = (float*)d_out; p.ws = (char*)d_ws;
  (void)hipMemsetAsync((char*)d_ws + OFF_BAR, 0, 16384, stream);
#if ONE_LAUNCH
  p.ph_begin = 0; p.ph_end = NPHASES;
  void* args[] = {(void*)&p};
  hipError_t e = hipLaunchCooperativeKernel((const void*)mega, dim3(grid_blocks), dim3(NTHR), args, LDS_BYTES, stream);
  if (e != hipSuccess) fprintf(stderr, "kernel_launch: cooperative launch failed: %s (grid %d)\n", hipGetErrorString(e), grid_blocks);
#else
  for (int ph = 0; ph < CUT_PHASE; ++ph) {
    p.ph_begin = ph; p.ph_end = ph + 1;
    hipLaunchKernelGGL(mega, dim3(grid_blocks), dim3(NTHR), LDS_BYTES, stream, p);
  }
  if (CUT_PHASE < NPHASES) hipLaunchKernelGGL(dump_x, dim3(1024), dim3(NTHR), 0, stream, p);
#endif
}
```

```cpp
#include <hip/hip_runtime.h>
#include <hip/hip_cooperative_groups.h>
#include <cstdio>
#include <cstdint>
#include <cstring>
namespace cg = cooperative_groups;

#ifndef ONE_LAUNCH
#define ONE_LAUNCH 1
#endif
#ifndef R_GEMM
#define R_GEMM 1
#endif
#ifndef R_ATTN
#define R_ATTN 1
#endif
#ifndef R_HYENA
#define R_HYENA 1
#endif
#ifndef R_TOPK
#define R_TOPK 1
#endif
#ifndef R_GATHER
#define R_GATHER 1
#endif
#ifndef R_SYNC
#define R_SYNC 1
#endif
#ifndef R_PRO
#define R_PRO 1
#endif
#ifndef PROBE_PH
#define PROBE_PH -1
#endif

constexpr int D = 1024, NBATCH = 4, SEQ = 4096, CTXL = 256, RB = 4352, T = 17408, DEPTH = 4;
constexpr float ALPHA = 1.6817928305074290f;
constexpr int NTHR = 512;
constexpr int NPHASES = 37;

typedef unsigned short bf16_t;
#define LAS __attribute__((address_space(3)))
#define GAS __attribute__((address_space(1)))
using bf16x8 = __attribute__((ext_vector_type(8))) short;
using s16x4  = __attribute__((ext_vector_type(4))) short;
using f32x16 = __attribute__((ext_vector_type(16))) float;
using u32x4  = __attribute__((ext_vector_type(4))) unsigned;
using u32x2  = __attribute__((ext_vector_type(2))) unsigned;

typedef __bf16 bf16x2_t __attribute__((ext_vector_type(2)));
typedef float f32x2_t __attribute__((ext_vector_type(2)));
typedef _Float16 h16x2 __attribute__((ext_vector_type(2)));
__device__ __forceinline__ unsigned cvtpk(float lo, float hi) { f32x2_t v = {lo, hi}; bf16x2_t b = __builtin_convertvector(v, bf16x2_t); return __builtin_bit_cast(unsigned, b); }
__device__ __forceinline__ bf16_t f2bf(float x) { __bf16 b = (__bf16)x; return __builtin_bit_cast(unsigned short, b); }
__device__ __forceinline__ unsigned cvtpk_asm(float lo, float hi) { unsigned r; asm volatile("v_cvt_pk_bf16_f32 %0, %1, %2" : "=v"(r) : "v"(lo), "v"(hi)); return r; }
__device__ __forceinline__ float bf2f(bf16_t u) { return __uint_as_float(((unsigned)u) << 16); }
__device__ __forceinline__ float bflo(unsigned w) { return __uint_as_float(w << 16); }
__device__ __forceinline__ float bfhi(unsigned w) { return __uint_as_float(w & 0xffff0000u); }
__device__ __forceinline__ int crow(int r, int hi) { return (r & 3) + 8 * (r >> 2) + 4 * hi; }
__device__ __forceinline__ int xl1(int x) { return __builtin_amdgcn_update_dpp(x, x, 0xB1, 0xF, 0xF, false); }
__device__ __forceinline__ int xl2(int x) { return __builtin_amdgcn_update_dpp(x, x, 0x4E, 0xF, 0xF, false); }
__device__ __forceinline__ int xl4(int x) { const int t = __builtin_amdgcn_update_dpp(x, x, 0x104, 0xF, 0x5, false); return __builtin_amdgcn_update_dpp(t, x, 0x114, 0xF, 0xA, false); }
__device__ __forceinline__ int xl8(int x) { return __builtin_amdgcn_update_dpp(x, x, 0x128, 0xF, 0xF, false); }
__device__ __forceinline__ float xl1f(float x) { return __int_as_float(xl1(__float_as_int(x))); }
__device__ __forceinline__ float xl2f(float x) { return __int_as_float(xl2(__float_as_int(x))); }
__device__ __forceinline__ float xl4f(float x) { return __int_as_float(xl4(__float_as_int(x))); }
__device__ __forceinline__ float xl8f(float x) { return __int_as_float(xl8(__float_as_int(x))); }
__device__ __forceinline__ int sum_x16(int x) { const auto r = __builtin_amdgcn_permlane16_swap((unsigned)x, (unsigned)x, false, false); return (int)r[0] + (int)r[1]; }
__device__ __forceinline__ int sum_x32(int x) { const auto r = __builtin_amdgcn_permlane32_swap((unsigned)x, (unsigned)x, false, false); return (int)r[0] + (int)r[1]; }
__device__ __forceinline__ float sum_x16f(float x) { const auto r = __builtin_amdgcn_permlane16_swap(__float_as_uint(x), __float_as_uint(x), false, false); return __uint_as_float(r[0]) + __uint_as_float(r[1]); }
__device__ __forceinline__ float sum_x32f(float x) { const auto r = __builtin_amdgcn_permlane32_swap(__float_as_uint(x), __float_as_uint(x), false, false); return __uint_as_float(r[0]) + __uint_as_float(r[1]); }
__device__ __forceinline__ float max_x16f(float x) { const auto r = __builtin_amdgcn_permlane16_swap(__float_as_uint(x), __float_as_uint(x), false, false); return fmaxf(__uint_as_float(r[0]), __uint_as_float(r[1])); }
__device__ __forceinline__ float max_x32f(float x) { const auto r = __builtin_amdgcn_permlane32_swap(__float_as_uint(x), __float_as_uint(x), false, false); return fmaxf(__uint_as_float(r[0]), __uint_as_float(r[1])); }
__device__ __forceinline__ float wsum(float v) { v += xl1f(v); v += xl2f(v); v += xl4f(v); v += xl8f(v); v = sum_x16f(v); return sum_x32f(v); }
__device__ __forceinline__ float wmax(float v) { v = fmaxf(v, xl1f(v)); v = fmaxf(v, xl2f(v)); v = fmaxf(v, xl4f(v)); v = fmaxf(v, xl8f(v)); v = max_x16f(v); return max_x32f(v); }
__device__ __forceinline__ int otid() { int t = threadIdx.x; asm volatile("" : "+v"(t)); return t; }
__device__ __forceinline__ float sin_rev(float rev) { return __builtin_amdgcn_sinf(rev); }
__device__ __forceinline__ float cos_rev(float rev) { return __builtin_amdgcn_cosf(rev); }
__device__ __forceinline__ float sin_rad(float x) { return __builtin_amdgcn_sinf(x * 0.15915494309189535f); }

struct Params { const float* in[38]; float* out; char* ws; int ph_begin, ph_end; };
constexpr size_t al256c(size_t x) { return (x + 255) & ~(size_t)255; }
constexpr size_t SZ_W1 = al256c((size_t)1152 * 1024 * 2), SZ_WUQ = al256c((size_t)1536 * 768 * 2), SZ_WUKV = al256c((size_t)2048 * 256 * 2), SZ_WSQ = al256c((size_t)1024 * 1024 * 2),
                 SZ_WQ = al256c((size_t)2048 * 1024 * 2);
constexpr size_t OFF_BAR  = 0;
constexpr size_t OFF_MODP = 16384;
constexpr size_t OFF_MOD  = OFF_MODP + al256c((size_t)8 * 4 * 5 * 6144 * 4);
constexpr size_t OFF_HDN  = OFF_MOD + al256c((size_t)4 * 5 * 6144 * 4);
constexpr size_t OFF_GLAT = OFF_HDN + al256c((size_t)2 * 4096 * 64 * 4);
constexpr size_t OFF_GCTX = OFF_GLAT + al256c((size_t)2 * 1024 * 8336 * 2);
constexpr size_t OFF_W1   = OFF_GCTX + al256c((size_t)2 * 1024 * 656 * 2);
constexpr size_t OFF_WUQ  = OFF_W1 + 2 * SZ_W1;
constexpr size_t OFF_WUKV = OFF_WUQ + 2 * SZ_WUQ;
constexpr size_t OFF_WOA  = OFF_WUKV + 2 * SZ_WUKV;
constexpr size_t OFF_WIN  = OFF_WOA + 2 * SZ_WSQ;
constexpr size_t OFF_WOUT = OFF_WIN + al256c((size_t)3072 * 1024 * 2);
constexpr size_t OFF_WQKV = OFF_WOUT + SZ_WSQ;
constexpr size_t OFF_WOC  = OFF_WQKV + al256c((size_t)1536 * 1024 * 2);
constexpr size_t OFF_WQ   = OFF_WOC + SZ_WSQ;
constexpr size_t OFF_KEYS = OFF_WQ + 4 * SZ_WQ;
constexpr size_t OFF_PU   = OFF_KEYS + al256c((size_t)4 * 16 * 16384 * 2);
constexpr size_t OFF_PV   = OFF_PU + (size_t)4 * 16384 * 1024;
constexpr size_t OFF_SU   = OFF_PV + (size_t)4 * 16384 * 1024;
constexpr size_t OFF_SV   = OFF_SU + (size_t)4 * 16384 * 4;
constexpr size_t OFF_X    = OFF_SV + (size_t)4 * 16384 * 4;
constexpr size_t OFF_H    = OFF_X + (size_t)T * 1024 * 4;
constexpr size_t OFF_Y    = OFF_H + (size_t)T * 1024 * 2;
constexpr size_t OFF_RA   = OFF_Y + (size_t)T * 1024 * 4;
constexpr size_t OFF_RB   = OFF_RA + (size_t)T * 2048 * 4;
constexpr size_t OFF_RC   = OFF_RB + (size_t)T * 2048 * 2;
constexpr size_t OFF_RD   = OFF_RC + (size_t)T * 1536 * 2;
constexpr size_t OFF_RE   = OFF_RD + (size_t)T * 1024 * 2;
constexpr size_t OFF_RF   = OFF_RE + (size_t)T * 1024 * 2;
constexpr size_t OFF_LST  = OFF_RF + (size_t)T * 1024 * 2;
constexpr size_t WS_TOTAL = OFF_LST + al256c((size_t)T * 2 * 4);
#define WSP(type, off) ((type*)(p.ws + (off)))

struct RowInfo { int b, rb, is_ctx, pos, mrow; };
__device__ __forceinline__ RowInfo row_info(int row) {
  RowInfo r; r.b = row / RB; r.rb = row - r.b * RB; r.is_ctx = r.rb < CTXL; r.pos = r.rb - CTXL; r.mrow = r.is_ctx ? 4 : r.b; return r;
}
__device__ __forceinline__ void rope_cs(int pos, int i, int quarter, float& c, float& s) {
  const int j = i < quarter ? i : i - quarter;
  const float inv = exp2f(-13.287712379549449f * (float)j / (float)quarter);
  const float p = (float)(i < quarter ? (pos >> 6) : (pos & 63));
  const float rev = p * inv * 0.15915494309189535f;
  c = cos_rev(rev); s = sin_rev(rev);
}

__device__ __forceinline__ void ce_desc(float& a, float& b) { const float hi = __builtin_fmaxf(a, b), lo = __builtin_fminf(a, b); a = hi; b = lo; }
__device__ __forceinline__ void bmerge16(float (&a)[16]) {
#pragma unroll
  for (int j = 8; j > 0; j >>= 1)
#pragma unroll
    for (int i = 0; i < 16; ++i) if ((i & j) == 0) ce_desc(a[i], a[i | j]);
}
__device__ __forceinline__ void bsort16(float (&a)[16]) {
#pragma unroll
  for (int k = 2; k <= 16; k <<= 1)
#pragma unroll
    for (int j = k >> 1; j > 0; j >>= 1)
#pragma unroll
      for (int i = 0; i < 16; ++i) { const int l = i ^ j; if (l > i) { if ((i & k) == 0 || k == 16) ce_desc(a[i], a[l]); else ce_desc(a[l], a[i]); } }
}
__device__ __forceinline__ void merge_top16(float (&top)[16], const float (&g)[16]) {
#pragma unroll
  for (int i = 0; i < 16; ++i) top[i] = __builtin_fmaxf(top[i], g[15 - i]);
  bmerge16(top);
}
struct EpiPeerTopk { static constexpr bool QUAD = false, TOPK = true, RESID = false; const bf16_t* keys; float* topl;
  __device__ __forceinline__ void operator()(int, int, float) const {} };
template <int WSH, int NI, int NJ>
__device__ __forceinline__ void peer_topk_epilogue(const f32x16 (&acc)[NI][NJ], const EpiPeerTopk& e, int m0, int n0, char* lds) {
  constexpr int BM = (8 >> WSH) * NI * 32;
  const int tid = otid(), lane = tid & 63, wid = tid >> 6, wm = wid >> WSH, wn = wid & ((1 << WSH) - 1), r32 = lane & 31, hi = lane >> 5;
  char* Qs = lds; char* Ks = lds + 65536;
#pragma unroll
  for (int i = 0; i < NI; ++i)
#pragma unroll
    for (int j = 0; j < NJ; ++j)
#pragma unroll
      for (int r = 0; r < 16; ++r) { const int row = wm * (NI * 32) + i * 32 + crow(r, hi), col = wn * (NJ * 32) + j * 32 + r32;
        *(bf16_t*)(Qs + row * 256 + (((col >> 3) ^ (row & 7)) << 4) + (col & 7) * 2) = f2bf(acc[i][j][r]); }
  const bf16_t* kg = e.keys + (size_t)(n0 >> 7) * 16384;
#pragma unroll
  for (int c = 0; c < 4; ++c) { const int id = tid + NTHR * c, row = id >> 4, ch = id & 15; *(u32x4*)(Ks + row * 256 + ((ch ^ (row & 7)) << 4)) = *(const u32x4*)(kg + row * 128 + ch * 8); }
  __syncthreads();
  if (wid * 32 < BM) {
    bf16x8 bq[8];
#pragma unroll
    for (int ks = 0; ks < 8; ++ks) bq[ks] = *(const bf16x8*)(Qs + (wid * 32 + r32) * 256 + (((ks * 2 + hi) ^ (r32 & 7)) << 4));
    float top[16];
#pragma unroll
    for (int kt = 0; kt < 4; ++kt) {
      f32x16 sc = f32x16{};
#pragma unroll
      for (int ks = 0; ks < 8; ++ks) { const bf16x8 a = *(const bf16x8*)(Ks + (kt * 32 + r32) * 256 + (((ks * 2 + hi) ^ (r32 & 7)) << 4)); sc = __builtin_amdgcn_mfma_f32_32x32x16_bf16(a, bq[ks], sc, 0, 0, 0); }
      float g[16];
#pragma unroll
      for (int r = 0; r < 16; ++r) g[r] = __uint_as_float((__float_as_uint(sc[r]) & ~127u) | (unsigned)(kt * 32 + crow(r, hi)));
      bsort16(g);
      if (kt == 0) {
#pragma unroll
        for (int q = 0; q < 16; ++q) top[q] = g[q];
      } else merge_top16(top, g);
    }
    float oth[16];
#pragma unroll
    for (int q = 0; q < 16; ++q) { const auto r_ = __builtin_amdgcn_permlane32_swap(__float_as_uint(top[q]), __float_as_uint(top[q]), false, false); oth[q] = __uint_as_float(hi ? r_[0] : r_[1]); }
    merge_top16(top, oth);
    if (hi == 0) {
      float* dst = e.topl + ((size_t)(m0 + wid * 32 + r32) * 16 + (n0 >> 7)) * 16;
#pragma unroll
      for (int q = 0; q < 4; ++q) *(float4*)(dst + 4 * q) = make_float4(top[4 * q], top[4 * q + 1], top[4 * q + 2], top[4 * q + 3]);
    }
  }
  __syncthreads();
}

struct EpiResid { static constexpr bool QUAD = false, TOPK = false, RESID = true; bf16_t* X; const float* gmod  ; const float* bias;
  __device__ __forceinline__ void operator()(int, int, float) const {} };
template <int WSH, int NI, int NJ>
__device__ __forceinline__ void resid_epilogue(const f32x16 (&acc)[NI][NJ], const EpiResid& e, int m0, int n0) {
  const int tid = otid(), lane = tid & 63, wid = tid >> 6, wm = wid >> WSH, wn = wid & ((1 << WSH) - 1), r32 = lane & 31, hi = lane >> 5;
  const float* g = e.gmod + (size_t)row_info(m0).mrow * 6144;
#pragma unroll
  for (int j = 0; j < NJ; ++j) {
    const int col = n0 + wn * (NJ * 32) + j * 32 + r32;
    const float gj = g[col], bj = e.bias ? e.bias[col] : 0.f;
#pragma unroll
    for (int i = 0; i < NI; ++i) {
      float xv[16];
#pragma unroll
      for (int r = 0; r < 16; ++r) xv[r] = bf2f(e.X[(size_t)(m0 + wm * (NI * 32) + i * 32 + crow(r, hi)) * 1024 + col]);
#pragma unroll
      for (int r = 0; r < 16; ++r) e.X[(size_t)(m0 + wm * (NI * 32) + i * 32 + crow(r, hi)) * 1024 + col] = f2bf(ALPHA * xv[r] + gj * (acc[i][j][r] + bj));
    }
  }
}

__device__ __forceinline__ int gswz(int row, int chunk) { return row * 128 + ((chunk ^ ((row >> 1) & 7)) << 4); }
constexpr int G_ASZ = 256 * 128, G_BSZ = 128 * 128;
template <class Epi, int WSH, int NI, int NJ>
__device__ __forceinline__ void gemm_tile(const bf16_t* __restrict__ A, int lda, const bf16_t* __restrict__ Bt, int ldb, int K, int m0, int n0, int acol0,
                                          const Epi& epi, char* lds) {
  constexpr int BM = (8 >> WSH) * NI * 32, CA = BM / 64;
  constexpr int KH = (BM == 64) ? 2 : 1;
  constexpr int A_ST = KH == 1 ? G_ASZ : KH * BM * 128, B_ST = KH == 1 ? G_BSZ : KH * 128 * 128;
  static_assert((1 << WSH) * NJ * 32 == 128, "BN is 128");
  static_assert(2 * A_ST + 2 * B_ST <= 2 * G_ASZ + 2 * G_BSZ, "LDS");
  const int tid = otid(), lane = tid & 63, wid = tid >> 6, wm = wid >> WSH, wn = wid & ((1 << WSH) - 1), r32 = lane & 31, hi = lane >> 5;
  char* As = lds; char* Bs = lds + 2 * A_ST;
  f32x16 acc[NI][NJ];
#pragma unroll
  for (int i = 0; i < NI; ++i)
#pragma unroll
    for (int j = 0; j < NJ; ++j) acc[i][j] = f32x16{};
  u32x4 ra[KH][CA], rb[KH][2];
  const int srow = tid >> 3, sch = tid & 7;
  const bf16_t* Ap = A + (size_t)(m0 + srow) * lda + acol0 + sch * 8;
  const bf16_t* Bp = Bt + (size_t)(n0 + srow) * ldb + sch * 8;
  const int nk = K / (64 * KH);
#define G_LOAD(kt) do { _Pragma("unroll") for (int h_ = 0; h_ < KH; ++h_) { \
                        _Pragma("unroll") for (int c_ = 0; c_ < CA; ++c_) ra[h_][c_] = *(const u32x4*)(Ap + (size_t)(c_ * 64) * lda + ((kt) * KH + h_) * 64); \
                        _Pragma("unroll") for (int c_ = 0; c_ < 2; ++c_) rb[h_][c_] = *(const u32x4*)(Bp + (size_t)(c_ * 64) * ldb + ((kt) * KH + h_) * 64); } } while (0)
#define G_STORE(buf) do { _Pragma("unroll") for (int h_ = 0; h_ < KH; ++h_) { \
                          _Pragma("unroll") for (int c_ = 0; c_ < CA; ++c_) *(u32x4*)(As + (buf) * A_ST + h_ * (BM * 128) + gswz(srow + c_ * 64, sch)) = ra[h_][c_]; \
                          _Pragma("unroll") for (int c_ = 0; c_ < 2; ++c_) *(u32x4*)(Bs + (buf) * B_ST + h_ * (128 * 128) + gswz(srow + c_ * 64, sch)) = rb[h_][c_]; } } while (0)
  G_LOAD(0); G_STORE(0); __syncthreads();
  for (int kt = 0; kt < nk; ++kt) {
    if (kt + 1 < nk) G_LOAD(kt + 1);
    __builtin_amdgcn_sched_barrier(0);
#pragma unroll
    for (int h = 0; h < KH; ++h) {
      const char* Ab = As + (kt & 1) * A_ST + h * (BM * 128); const char* Bb = Bs + (kt & 1) * B_ST + h * (128 * 128);
#pragma unroll
      for (int ks = 0; ks < 4; ++ks) {
        bf16x8 af[NI], bfr[NJ];
#pragma unroll
        for (int i = 0; i < NI; ++i) af[i] = *(const bf16x8*)(Ab + gswz(wm * (NI * 32) + i * 32 + r32, ks * 2 + hi));
#pragma unroll
        for (int j = 0; j < NJ; ++j) bfr[j] = *(const bf16x8*)(Bb + gswz(wn * (NJ * 32) + j * 32 + r32, ks * 2 + hi));
#pragma unroll
        for (int i = 0; i < NI; ++i)
#pragma unroll
          for (int j = 0; j < NJ; ++j) acc[i][j] = __builtin_amdgcn_mfma_f32_32x32x16_bf16(af[i], bfr[j], acc[i][j], 0, 0, 0);
      }
    }
    __builtin_amdgcn_sched_barrier(0);
    if (kt + 1 < nk) G_STORE((kt + 1) & 1);
    __syncthreads();
  }
#undef G_LOAD
#undef G_STORE
  if constexpr (Epi::TOPK) { peer_topk_epilogue<WSH, NI, NJ>(acc, epi, m0, n0, lds); return; }
  if constexpr (Epi::RESID) { resid_epilogue<WSH, NI, NJ>(acc, epi, m0, n0); return; }
  if constexpr (Epi::QUAD) {
#pragma unroll
    for (int i = 0; i < NI; ++i)
#pragma unroll
      for (int j = 0; j < NJ; ++j)
#pragma unroll
        for (int g = 0; g < 4; ++g) epi.quad(m0 + wm * (NI * 32) + i * 32 + 8 * g + 4 * hi, n0 + wn * (NJ * 32) + j * 32 + r32, acc[i][j][4 * g], acc[i][j][4 * g + 1], acc[i][j][4 * g + 2], acc[i][j][4 * g + 3]);
  } else {
#pragma unroll
    for (int i = 0; i < NI; ++i)
#pragma unroll
      for (int j = 0; j < NJ; ++j)
#pragma unroll
        for (int r = 0; r < 16; ++r) epi(m0 + wm * (NI * 32) + i * 32 + crow(r, hi), n0 + wn * (NJ * 32) + j * 32 + r32, acc[i][j][r]);
  }
}
template <class Epi>
__device__ __forceinline__ void gemm_job(const bf16_t* A, int lda, const bf16_t* Bt, int ldb, int M, int N, int K, bool grouped, bool tok_n, const Epi& epi, char* lds, bool skip_ctx = false) {
  const int ntn = N / 128, ntm = M / 256;
  if ((gridDim.x & 7) == 0) {
    const int xcd = blockIdx.x & 7, local = blockIdx.x >> 3, nloc = gridDim.x >> 3;
    const int ntok = tok_n ? ntn : ntm, nw = tok_n ? ntm : ntn, np = (ntok - xcd + 7) >> 3;
    for (int j = local; j < np * nw; j += nloc) {
      const int pl = j / nw, wt = j - pl * nw, tk = xcd + 8 * pl;
      const int mt = tok_n ? wt : tk, n_t = tok_n ? tk : wt;
      if (!tok_n && (mt % 17) == 0) continue;
      gemm_tile<Epi, 1, 2, 2>(A, lda, Bt, ldb, K, mt * 256, n_t * 128, grouped ? n_t * 128 : 0, epi, lds);
    }
    if (!tok_n && !skip_ctx) {
      const int rb = ((nloc - 1 - local) << 3) | xcd;
      for (int s = rb; s < 16 * ntn; s += gridDim.x) {
        const int cp = s / (4 * ntn), rem = s - cp * (4 * ntn), sub = rem / ntn, n_t = rem - sub * ntn;
        gemm_tile<Epi, 2, 1, 1>(A, lda, Bt, ldb, K, cp * (17 * 256) + sub * 64, n_t * 128, grouped ? n_t * 128 : 0, epi, lds);
      }
    }
  } else {
    const int nt = ntn * ntm;
    for (int it = blockIdx.x; it < nt; it += gridDim.x) {
      const int mt = it / ntn, n_t = it - mt * ntn;
      if (skip_ctx && (mt % 17) == 0) continue;
      gemm_tile<Epi, 1, 2, 2>(A, lda, Bt, ldb, K, mt * 256, n_t * 128, grouped ? n_t * 128 : 0, epi, lds);
    }
  }
}
struct EpiF32 { static constexpr bool QUAD = false, TOPK = false, RESID = false; float* C; int ldc, ncols; const float* bias;
  __device__ __forceinline__ void operator()(int row, int col, float v) const { if (col < ncols) C[(size_t)row * ldc + col] = v + (bias ? bias[col] : 0.f); } };
struct EpiBf16 { static constexpr bool QUAD = false, TOPK = false, RESID = false; bf16_t* C; int ldc;
  __device__ __forceinline__ void operator()(int row, int col, float v) const { C[(size_t)row * ldc + col] = f2bf(v); } };
struct EpiZT { static constexpr bool QUAD = true, TOPK = false, RESID = false; bf16_t* C; int ldt; const float* bias;
  __device__ __forceinline__ void quad(int row0, int col, float a, float b, float c, float d) const { const float bb = bias[col]; u32x2 w = {cvtpk(a + bb, b + bb), cvtpk(c + bb, d + bb)}; *(u32x2*)(C + (size_t)col * ldt + row0) = w; }
  __device__ __forceinline__ void operator()(int, int, float) const {} };
struct EpiMlaQ { static constexpr bool QUAD = false, TOPK = false, RESID = false; bf16_t* Q;
  __device__ __forceinline__ void operator()(int row, int col, float v) const {
    const float partner = xl1f(v);
    const int w = col % 192;
    const RowInfo ri = row_info(row);
    float o = v;
    if (w >= 128 && !ri.is_ctx) { float c, s; rope_cs(ri.pos, (w - 128) >> 1, 16, c, s); o = (col & 1) ? (partner * s + v * c) : (v * c - partner * s); }
    Q[(size_t)row * 1536 + col] = f2bf(o);
  } };
struct EpiMlaKV { static constexpr bool QUAD = false, TOPK = false, RESID = false; bf16_t* Kb; bf16_t* Vb;
  __device__ __forceinline__ void operator()(int row, int col, float v) const {
    const int h = col >> 8, w = col & 255;
    if (w < 128) Kb[(size_t)row * 1024 + h * 128 + w] = f2bf(v); else Vb[(size_t)row * 1024 + h * 128 + (w - 128)] = f2bf(v);
  } };

struct EpiF32T { static constexpr bool QUAD = true, TOPK = false, RESID = false; float* C; int ldt;
  __device__ __forceinline__ void quad(int row0, int col, float a, float b, float c, float d) const { *(float4*)(C + (size_t)col * ldt + row0) = make_float4(a, b, c, d); }
  __device__ __forceinline__ void operator()(int, int, float) const {} };


namespace pg8 {
typedef float f32x4 __attribute__((ext_vector_type(4)));
constexpr int BM = 256, BK = 64, HALF = 128, HTB = HALF * BK * 2  , STAGE_BYTES = 8 * HTB;
__device__ __forceinline__ int lds_byte(int r, int c) { const int st = (r >> 4) * 2 + (c >> 5), rr = r & 15, cc = c & 31, ob = rr * 64 + cc * 2; return st * 1024 + (ob ^ (((ob >> 9) & 1) << 5)); }
__device__ __forceinline__ void stage_rc(int b, int& R, int& C) { const int st = b / 1024, sb = b % 1024, swz = sb ^ (((sb >> 9) & 1) << 5); R = (st >> 1) * 16 + swz / 64; C = (st & 1) * 32 + (swz % 64) / 2; }
__device__ __forceinline__ int perm32(int rho) { const int n = rho >> 4, i = rho & 15; return 8 * (i >> 2) + 4 * n + (i & 3); }
struct Unit { int pm, pn; };
struct Gemm { const bf16_t* A; const bf16_t* Bt; int lda, ldb, K; };
struct LatOrder {
  int nw, tok_n, ctx_main, single, n1;
  __device__ __forceinline__ bool next(int i, Unit& u) const {
    if (single >= 0) { if (i > 0) return false; i = single; }
    int mt, wt;
    if ((gridDim.x & 7) == 0) {
      const int xcd = blockIdx.x & 7, local = blockIdx.x >> 3, nloc = gridDim.x >> 3;
      int j = local + nloc * i; const int nlat = 8 * nw;
      if (n1 > 0 && nloc == 32) {
        const int m = 32 - n1, R = nlat - n1, base = R / m, extra = R - base * m;
        int st, cnt;
        if (local < n1) { st = local; cnt = 1; } else { const int q = local - n1; st = n1 + q * base + (q < extra ? q : extra); cnt = base + (q < extra ? 1 : 0); }
        if (i >= cnt) return false;
        j = st + i;
      }
      if (j < nlat) { const int pl = j / nw; wt = j - pl * nw; const int lp = xcd + 8 * pl; mt = lp + (lp >> 4) + 1; }
      else { if (!ctx_main) return false; const int cu = (j - nlat) * 8 + xcd; if (cu >= 4 * nw) return false; const int cp = cu / nw; wt = cu - cp * nw; mt = 17 * cp; }
    } else {
      const int L = blockIdx.x + gridDim.x * i;
      if (L < 64 * nw) { const int lp = L / nw; wt = L - lp * nw; mt = lp + (lp >> 4) + 1; }
      else { if (!ctx_main) return false; const int cu = L - 64 * nw; if (cu >= 4 * nw) return false; const int cp = cu / nw; wt = cu - cp * nw; mt = 17 * cp; }
    }
    u.pm = tok_n ? wt : mt; u.pn = tok_n ? mt : wt; return true;
  }
};

template <class Epi, class Sched, bool ALIGN_EPI, bool SP2>
__device__ __forceinline__ void gemm_phase(LAS unsigned char* lds, const Gemm g, const Sched& S, const Epi& E) {
    const int tid = otid(), wid = __builtin_amdgcn_readfirstlane(tid >> 6), lane = tid & 63, wr = wid >> 2, wc = wid & 3, fr = lane & 15, fq = lane >> 4;
    int K = g.K; asm volatile("" : "+s"(K));
    const int nt = K / BK;
    unsigned voffA[2], voffB[2];
#pragma unroll
    for (int i = 0; i < 2; ++i) { int R, C; stage_rc(tid * 16 + i * 8192, R, C); const int Rb = Epi::PERM ? ((R & ~31) + perm32(R & 31)) : R;
        voffA[i] = (unsigned)(R * g.lda + C) * 2u; voffB[i] = (unsigned)(Rb * g.ldb + C) * 2u; }
    const size_t kstep = (size_t)(BK * 2);
    const size_t hstepA = (size_t)HALF * g.lda * 2, hstepB = (size_t)HALF * g.ldb * 2;
    const size_t tstepA = 2 * hstepA, tstepB = 2 * hstepB;
    const unsigned ldsw = (unsigned)wid * 1024u;
    const int aoff = lds_byte(wr * 64 + fr, fq * 8), boff = lds_byte(wc * 32 + fr, fq * 8);
#define PG8_SA(b, h) (((b) * 2 + (h)) * HTB)
#define PG8_SB(b, h) ((4 + (b) * 2 + (h)) * HTB)
#define PG8_STAGE(bufoff, gbase, voff) do { _Pragma("unroll") for (int _i = 0; _i < 2; ++_i) \
        __builtin_amdgcn_global_load_lds((const unsigned*)((const char*)(gbase) + (voff)[_i]), (LAS unsigned*)(lds + (bufoff) + ldsw + _i * 8192), 16, 0, 0); } while (0)
#define PG8_LDA(dst, b, h) do { _Pragma("unroll") for (int m = 0; m < 4; ++m) _Pragma("unroll") for (int k = 0; k < 2; ++k) dst[m][k] = *(const LAS bf16x8*)(lds + PG8_SA(b, h) + aoff + m * 2048 + k * 1024); } while (0)
#define PG8_LDB(dst, b, h) do { _Pragma("unroll") for (int n = 0; n < 2; ++n) _Pragma("unroll") for (int k = 0; k < 2; ++k) dst[n][k] = *(const LAS bf16x8*)(lds + PG8_SB(b, h) + boff + n * 2048 + k * 1024); } while (0)
#define PG8_MMA(ai, bj, At, Bt) do { __builtin_amdgcn_s_setprio(1); _Pragma("unroll") for (int m = 0; m < 4; ++m) _Pragma("unroll") for (int n = 0; n < 2; ++n) _Pragma("unroll") for (int k = 0; k < 2; ++k) \
        acc[ai][bj][m][n] = __builtin_amdgcn_mfma_f32_16x16x32_bf16(Bt[n][k], At[m][k], acc[ai][bj][m][n], 0, 0, 0); __builtin_amdgcn_s_setprio(0); } while (0)
#define PG8_WAIT_V(n) asm volatile("s_waitcnt vmcnt(" #n ")" ::: "memory")
#define PG8_WAIT_L(n) asm volatile("s_waitcnt lgkmcnt(" #n ")" ::: "memory")
#define PG8_BAR __builtin_amdgcn_s_barrier()
#define PG8_SCHED __builtin_amdgcn_sched_barrier(0)
    Unit cur, nxt; int ui = 0;
    if (!S.next(0, cur)) return;
    f32x4 acc[2][2][4][2];
#pragma unroll
    for (int a = 0; a < 2; ++a)
#pragma unroll
        for (int b = 0; b < 2; ++b)
#pragma unroll
            for (int m = 0; m < 4; ++m)
#pragma unroll
                for (int n = 0; n < 2; ++n) acc[a][b][m][n] = (f32x4){0.f, 0.f, 0.f, 0.f};
    bf16x8 At[4][2], B0[2][2], B1[2][2];
    const char* cA = (const char*)g.A + (size_t)cur.pm * tstepA; const char* cB = (const char*)g.Bt + (size_t)cur.pn * tstepB;
    if constexpr (SP2) {
        PG8_STAGE(PG8_SB(0, 0), cB, voffB); PG8_STAGE(PG8_SB(0, 1), cB + hstepB, voffB); PG8_STAGE(PG8_SA(0, 0), cA, voffA); PG8_STAGE(PG8_SA(0, 1), cA + hstepA, voffA);
        if (wr == 1) PG8_BAR;
        PG8_WAIT_V(2); PG8_BAR;
        PG8_STAGE(PG8_SB(1, 0), cB + kstep, voffB); PG8_STAGE(PG8_SA(1, 0), cA + kstep, voffA); PG8_STAGE(PG8_SB(1, 1), cB + hstepB + kstep, voffB);
        PG8_WAIT_V(6); PG8_BAR;
    } else {
        PG8_STAGE(PG8_SB(0, 0), cB, voffB); PG8_STAGE(PG8_SA(0, 0), cA, voffA); PG8_STAGE(PG8_SB(0, 1), cB + hstepB, voffB); PG8_STAGE(PG8_SA(0, 1), cA + hstepA, voffA);
        if (wr == 1) PG8_BAR;
        PG8_WAIT_V(4); PG8_BAR;
        PG8_STAGE(PG8_SB(1, 0), cB + kstep, voffB); PG8_STAGE(PG8_SA(1, 0), cA + kstep, voffA); PG8_STAGE(PG8_SB(1, 1), cB + hstepB + kstep, voffB);
        PG8_WAIT_V(6); PG8_BAR;
    }
    for (;;) {
        const bool has_next = S.next(ui + 1, nxt);
        const char* nA = has_next ? (const char*)g.A + (size_t)nxt.pm * tstepA : cA; const char* nB = has_next ? (const char*)g.Bt + (size_t)nxt.pn * tstepB : cB;
        for (int t = 0; t < nt; t += 2) {
            const bool last = (t == nt - 2);
            const char* a1 = cA + (size_t)(t + 1) * kstep;
            const char* a2 = last ? nA : cA + (size_t)(t + 2) * kstep; const char* b2 = last ? nB : cB + (size_t)(t + 2) * kstep;
            const char* a3 = a2 + kstep; const char* b3 = b2 + kstep;
            if constexpr (SP2) {
            PG8_LDB(B0, 0, 0); PG8_LDB(B1, 0, 1); PG8_SCHED; PG8_LDA(At, 0, 0); PG8_STAGE(PG8_SA(1, 1), a1 + hstepA, voffA);
            PG8_WAIT_V(8); PG8_WAIT_L(0); PG8_BAR; PG8_MMA(0, 0, At, B0); PG8_MMA(0, 1, At, B1); PG8_BAR; PG8_SCHED;
            PG8_LDA(At, 0, 1); PG8_STAGE(PG8_SB(0, 0), b2, voffB); PG8_STAGE(PG8_SB(0, 1), b2 + hstepB, voffB); PG8_STAGE(PG8_SA(0, 0), a2, voffA);
            PG8_WAIT_V(8); PG8_WAIT_L(0); PG8_BAR; PG8_MMA(1, 0, At, B0); PG8_MMA(1, 1, At, B1); PG8_BAR; PG8_SCHED;
            PG8_LDB(B0, 1, 0); PG8_LDB(B1, 1, 1); PG8_SCHED; PG8_LDA(At, 1, 0); PG8_STAGE(PG8_SA(0, 1), a2 + hstepA, voffA);
            PG8_WAIT_V(8); PG8_WAIT_L(0); PG8_BAR; PG8_MMA(0, 0, At, B0); PG8_MMA(0, 1, At, B1); PG8_BAR; PG8_SCHED;
            PG8_LDA(At, 1, 1); PG8_STAGE(PG8_SB(1, 0), b3, voffB); PG8_STAGE(PG8_SB(1, 1), b3 + hstepB, voffB); PG8_STAGE(PG8_SA(1, 0), a3, voffA);
            PG8_WAIT_V(8); PG8_WAIT_L(0); PG8_BAR; PG8_MMA(1, 0, At, B0); PG8_MMA(1, 1, At, B1); PG8_BAR; PG8_SCHED;
            } else {
            PG8_LDB(B0, 0, 0); PG8_SCHED; PG8_LDA(At, 0, 0); PG8_STAGE(PG8_SA(1, 1), a1 + hstepA, voffA);
            PG8_WAIT_L(8); PG8_BAR; PG8_WAIT_L(0); PG8_MMA(0, 0, At, B0); PG8_BAR; PG8_SCHED;
            PG8_LDB(B1, 0, 1); PG8_STAGE(PG8_SB(0, 0), b2, voffB);
            PG8_BAR; PG8_WAIT_L(0); PG8_MMA(0, 1, At, B1); PG8_BAR;
            PG8_LDA(At, 0, 1); PG8_STAGE(PG8_SA(0, 0), a2, voffA);
            PG8_BAR; PG8_WAIT_L(0); PG8_MMA(1, 0, At, B0); PG8_BAR; PG8_SCHED;
            PG8_STAGE(PG8_SB(0, 1), b2 + hstepB, voffB);
            PG8_WAIT_V(6); PG8_BAR; PG8_MMA(1, 1, At, B1); PG8_BAR;
            PG8_LDB(B0, 1, 0); PG8_SCHED; PG8_LDA(At, 1, 0); PG8_STAGE(PG8_SA(0, 1), a2 + hstepA, voffA);
            PG8_WAIT_L(8); PG8_BAR; PG8_WAIT_L(0); PG8_MMA(0, 0, At, B0); PG8_BAR; PG8_SCHED;
            PG8_LDB(B1, 1, 1); PG8_STAGE(PG8_SB(1, 0), b3, voffB);
            PG8_BAR; PG8_WAIT_L(0); PG8_MMA(0, 1, At, B1); PG8_BAR;
            PG8_LDA(At, 1, 1); PG8_STAGE(PG8_SA(1, 0), a3, voffA);
            PG8_BAR; PG8_WAIT_L(0); PG8_MMA(1, 0, At, B0); PG8_BAR; PG8_SCHED;
            PG8_STAGE(PG8_SB(1, 1), b3 + hstepB, voffB);
            PG8_WAIT_V(6); PG8_BAR; PG8_MMA(1, 1, At, B1); PG8_BAR;
            }
        }
        if constexpr (ALIGN_EPI) { if (wr == 0) PG8_BAR; }
        if constexpr (!Epi::AFTER_DRAIN) { E(acc, cur, wr, wc, fr, fq); }
        if (!has_next) break;
#pragma unroll
        for (int a = 0; a < 2; ++a)
#pragma unroll
            for (int b = 0; b < 2; ++b)
#pragma unroll
                for (int m = 0; m < 4; ++m)
#pragma unroll
                    for (int n = 0; n < 2; ++n) acc[a][b][m][n] = (f32x4){0.f, 0.f, 0.f, 0.f};
        cur = nxt; cA = nA; cB = nB; ++ui;
        if constexpr (ALIGN_EPI) { if (wr == 1) PG8_BAR; }
    }
    PG8_WAIT_V(0);
    if constexpr (!ALIGN_EPI) { if (wr == 0) PG8_BAR; }
    PG8_BAR;
    if constexpr (Epi::AFTER_DRAIN) { E.fused(acc, cur, wr, wc, fr, fq, (char*)lds, wid, lane); }
#undef PG8_SA
#undef PG8_SB
#undef PG8_STAGE
#undef PG8_LDA
#undef PG8_LDB
#undef PG8_MMA
#undef PG8_WAIT_V
#undef PG8_WAIT_L
#undef PG8_BAR
#undef PG8_SCHED
}

#define PG8_FOR_AM _Pragma("unroll") for (int ai = 0; ai < 2; ++ai) _Pragma("unroll") for (int m = 0; m < 4; ++m)
__device__ __forceinline__ u32x4 pack8(const f32x4& a, const f32x4& b) { u32x4 w; w.x = cvtpk(a[0], a[1]); w.y = cvtpk(a[2], a[3]); w.z = cvtpk(b[0], b[1]); w.w = cvtpk(b[2], b[3]); return w; }
struct E8Resid { static constexpr bool PERM = true, AFTER_DRAIN = false; bf16_t* X; const float* gmod; const float* bias;
  __device__ __forceinline__ void operator()(const f32x4 (&acc)[2][2][4][2], const Unit& u, int wr, int wc, int fr, int fq) const {
    const float* g = gmod + (size_t)row_info(u.pm * BM).mrow * 6144;
    const int col0 = u.pn * BM + wc * 32 + 8 * fq;
    f32x4 gv[2][2], bv[2][2];
#pragma unroll
    for (int bj = 0; bj < 2; ++bj)
#pragma unroll
      for (int n = 0; n < 2; ++n) { gv[bj][n] = *(const f32x4*)(g + col0 + bj * HALF + 4 * n); bv[bj][n] = bias ? *(const f32x4*)(bias + col0 + bj * HALF + 4 * n) : (f32x4){0.f, 0.f, 0.f, 0.f}; }
    PG8_FOR_AM { bf16_t* rowp = X + (size_t)(u.pm * BM + ai * HALF + wr * 64 + m * 16 + fr) * 1024 + col0;
#pragma unroll
      for (int bj = 0; bj < 2; ++bj) { const u32x4 xw = *(const u32x4*)(rowp + bj * HALF);
        const f32x4 x0 = {bflo(xw.x), bfhi(xw.x), bflo(xw.y), bfhi(xw.y)}, x1 = {bflo(xw.z), bfhi(xw.z), bflo(xw.w), bfhi(xw.w)};
        const f32x4 o0 = x0 * ALPHA + gv[bj][0] * (acc[ai][bj][m][0] + bv[bj][0]), o1 = x1 * ALPHA + gv[bj][1] * (acc[ai][bj][m][1] + bv[bj][1]);
        *(u32x4*)(rowp + bj * HALF) = pack8(o0, o1); } }
  } };
struct E8Bf16 { static constexpr bool PERM = true, AFTER_DRAIN = false; bf16_t* C; int ldc; const float* rowbias;
  __device__ __forceinline__ void operator()(const f32x4 (&acc)[2][2][4][2], const Unit& u, int wr, int wc, int fr, int fq) const {
    const int col0 = u.pn * BM + wc * 32 + 8 * fq;
    PG8_FOR_AM { const int row = u.pm * BM + ai * HALF + wr * 64 + m * 16 + fr; const float rb = rowbias ? rowbias[row] : 0.f; bf16_t* rowp = C + (size_t)row * ldc + col0;
#pragma unroll
      for (int bj = 0; bj < 2; ++bj) *(u32x4*)(rowp + bj * HALF) = pack8(acc[ai][bj][m][0] + rb, acc[ai][bj][m][1] + rb); }
  } };
struct E8MlaKV { static constexpr bool PERM = true, AFTER_DRAIN = false; bf16_t* Kb; bf16_t* Vb;
  __device__ __forceinline__ void operator()(const f32x4 (&acc)[2][2][4][2], const Unit& u, int wr, int wc, int fr, int fq) const {
    const int col0 = u.pn * HALF + wc * 32 + 8 * fq;
    PG8_FOR_AM { const size_t off = (size_t)(u.pm * BM + ai * HALF + wr * 64 + m * 16 + fr) * 1024 + col0;
      *(u32x4*)(Kb + off) = pack8(acc[ai][0][m][0], acc[ai][0][m][1]); *(u32x4*)(Vb + off) = pack8(acc[ai][1][m][0], acc[ai][1][m][1]); }
  } };
struct E8MlaQ { static constexpr bool PERM = true, AFTER_DRAIN = false; bf16_t* Q;
  __device__ __forceinline__ void operator()(const f32x4 (&acc)[2][2][4][2], const Unit& u, int wr, int wc, int fr, int fq) const {
    const RowInfo r0 = row_info(u.pm * BM);
    PG8_FOR_AM { const int row = u.pm * BM + ai * HALF + wr * 64 + m * 16 + fr; const int pos = r0.pos + ai * HALF + wr * 64 + m * 16 + fr;
#pragma unroll
      for (int bj = 0; bj < 2; ++bj) { const int col0 = u.pn * BM + bj * HALF + wc * 32 + 8 * fq, w = col0 % 192;
        f32x4 v0 = acc[ai][bj][m][0], v1 = acc[ai][bj][m][1];
        if (w >= 128 && !r0.is_ctx) { const int i0 = (w - 128) >> 1; float c, s;
          rope_cs(pos, i0, 16, c, s);     { const float a = v0[0], b = v0[1]; v0[0] = a * c - b * s; v0[1] = a * s + b * c; }
          rope_cs(pos, i0 + 1, 16, c, s); { const float a = v0[2], b = v0[3]; v0[2] = a * c - b * s; v0[3] = a * s + b * c; }
          rope_cs(pos, i0 + 2, 16, c, s); { const float a = v1[0], b = v1[1]; v1[0] = a * c - b * s; v1[1] = a * s + b * c; }
          rope_cs(pos, i0 + 3, 16, c, s); { const float a = v1[2], b = v1[3]; v1[2] = a * c - b * s; v1[3] = a * s + b * c; } }
        *(u32x4*)(Q + (size_t)row * 1536 + col0) = pack8(v0, v1); } }
  } };
struct E8PeerTopk { static constexpr bool PERM = true, AFTER_DRAIN = true; const bf16_t* keys; float* topl;
  __device__ __forceinline__ void fused(const f32x4 (&acc)[2][2][4][2], const Unit& u, int wr, int wc, int fr, int fq, char* lds, int wid, int lane) const {
    const int r32 = lane & 31, hi = lane >> 5, tid = wid * 64 + lane;
    char* Qs = lds; char* Ks = lds + 65536;
#pragma unroll
    for (int bj = 0; bj < 2; ++bj) {
      const int hs = u.pn * 2 + bj;
      PG8_FOR_AM { const int row = ai * HALF + wr * 64 + m * 16 + fr; *(u32x4*)(Qs + row * 256 + (((wc * 4 + fq) ^ (row & 7)) << 4)) = pack8(acc[ai][bj][m][0], acc[ai][bj][m][1]); }
      const bf16_t* kg = keys + (size_t)hs * 16384;
#pragma unroll
      for (int c = 0; c < 4; ++c) { const int id = tid + NTHR * c, row = id >> 4, ch = id & 15; *(u32x4*)(Ks + row * 256 + ((ch ^ (row & 7)) << 4)) = *(const u32x4*)(kg + row * 128 + ch * 8); }
      __syncthreads();
      {
        bf16x8 bq[8];
#pragma unroll
        for (int ks = 0; ks < 8; ++ks) bq[ks] = *(const bf16x8*)(Qs + (wid * 32 + r32) * 256 + (((ks * 2 + hi) ^ (r32 & 7)) << 4));
        float top[16];
#pragma unroll
        for (int kt = 0; kt < 4; ++kt) {
          f32x16 sc = f32x16{};
#pragma unroll
          for (int ks = 0; ks < 8; ++ks) { const bf16x8 a = *(const bf16x8*)(Ks + (kt * 32 + r32) * 256 + (((ks * 2 + hi) ^ (r32 & 7)) << 4)); sc = __builtin_amdgcn_mfma_f32_32x32x16_bf16(a, bq[ks], sc, 0, 0, 0); }
          float g[16];
#pragma unroll
          for (int r = 0; r < 16; ++r) g[r] = __uint_as_float((__float_as_uint(sc[r]) & ~127u) | (unsigned)(kt * 32 + crow(r, hi)));
          bsort16(g);
          if (kt == 0) {
#pragma unroll
            for (int q = 0; q < 16; ++q) top[q] = g[q];
          } else merge_top16(top, g);
        }
        float oth[16];
#pragma unroll
        for (int q = 0; q < 16; ++q) { const auto r_ = __builtin_amdgcn_permlane32_swap(__float_as_uint(top[q]), __float_as_uint(top[q]), false, false); oth[q] = __uint_as_float(hi ? r_[0] : r_[1]); }
        merge_top16(top, oth);
        if (hi == 0) {
          float* dst = topl + ((size_t)(u.pm * BM + wid * 32 + r32) * 16 + hs) * 16;
#pragma unroll
          for (int q = 0; q < 4; ++q) *(float4*)(dst + 4 * q) = make_float4(top[4 * q], top[4 * q + 1], top[4 * q + 2], top[4 * q + 3]);
        }
      }
      __syncthreads();
    }
  } };
}


template <class Epi>
__device__ __forceinline__ void gemm_ctx_job(const bf16_t* A, int lda, const bf16_t* Bt, int ldb, int N, int K, const Epi& epi, char* lds) {
  const int ntn = N / 128;
  for (int s = blockIdx.x; s < 16 * ntn; s += gridDim.x) {
    const int cp = s / (4 * ntn), rem = s - cp * (4 * ntn), sub = rem / ntn, n_t = rem - sub * ntn;
    gemm_tile<Epi, 2, 1, 1>(A, lda, Bt, ldb, K, cp * (17 * 256) + sub * 64, n_t * 128, 0, epi, lds);
  }
}
template <class E8, class Epi>
__device__ __forceinline__ void gemm8_job(const bf16_t* A, int lda, const bf16_t* Bt, int ldb, int N, int K, const E8& e8, const Epi& epi, char* lds, bool ctx_main, bool skip_ctx, int n1 = 0) {
  const pg8::LatOrder S{N / 256, 0, (ctx_main && !skip_ctx) ? 1 : 0, -1, n1};
  pg8::gemm_phase<E8, pg8::LatOrder, true, true>((LAS unsigned char*)lds, pg8::Gemm{A, Bt, lda, ldb, K}, S, e8);
  __syncthreads();
  if (!ctx_main && !skip_ctx) gemm_ctx_job(A, lda, Bt, ldb, N, K, epi, lds);
}
template <class E8, class Epi>
__device__ __forceinline__ void gemm8t_job(const bf16_t* W, const bf16_t* Act, int N, int K, const E8& e8, const Epi& epi, char* lds) {
  const pg8::LatOrder S{N / 256, 1, 0, -1, 0};
  pg8::gemm_phase<E8, pg8::LatOrder, true, true>((LAS unsigned char*)lds, pg8::Gemm{W, Act, K, K, K}, S, e8);
  __syncthreads();
  gemm_ctx_job(Act, K, W, K, N, K, epi, lds);
}
template <class E8, class Epi>
__device__ __forceinline__ void gemm8d_job(const bf16_t* A, int lda, const bf16_t* Bt, int ldb, int N, int K, const E8& e8, const Epi& epi, char* lds, bool skip_ctx) {
  const int nw = N / 256;
  for (int rnd = 0; rnd * (int)gridDim.x < 64 * nw; ++rnd) {
    const pg8::LatOrder S{nw, 0, 0, rnd, 0};
    pg8::gemm_phase<E8, pg8::LatOrder, false, true>((LAS unsigned char*)lds, pg8::Gemm{A, Bt, lda, ldb, K}, S, e8);
    __syncthreads();
  }
  if (!skip_ctx) gemm_ctx_job(A, lda, Bt, ldb, N, K, epi, lds);
}

#define SBAR() __builtin_amdgcn_sched_barrier(0)
constexpr float ATT_THR = 8.f;
__device__ __forceinline__ void partialSM(f32x16& p0, f32x16& p1, float& m_reg, float& mn, float& alpha, const float C, const float thr_s) {
  float pmax = p0[0];
#pragma unroll
  for (int r = 1; r < 16; ++r) pmax = fmaxf(pmax, p0[r]);
#pragma unroll
  for (int r = 0; r < 16; ++r) pmax = fmaxf(pmax, p1[r]);
  { auto rr = __builtin_amdgcn_permlane32_swap(__float_as_uint(pmax), __float_as_uint(pmax), false, false);
    pmax = fmaxf(__uint_as_float(rr[0]), __uint_as_float(rr[1])); }
  if (__builtin_expect(__all(pmax - m_reg <= thr_s), 1)) { mn = m_reg; alpha = 1.f; }
  else { mn = fmaxf(m_reg, pmax); alpha = __builtin_amdgcn_exp2f((m_reg - mn) * C); m_reg = mn; }
  const float mnC = -mn * C;
#pragma unroll
  for (int r = 0; r < 16; ++r) p0[r] = fmaf(p0[r], C, mnC);
#pragma unroll
  for (int r = 0; r < 16; ++r) p1[r] = fmaf(p1[r], C, mnC);
#pragma unroll
  for (int r = 0; r < 16; ++r) p0[r] = __builtin_amdgcn_exp2f(p0[r]);
}
__device__ __forceinline__ void finishSM(f32x16& p0, f32x16& p1, float alpha, float& l_reg, bf16x8& pa0, bf16x8& pa1, bf16x8& pa2, bf16x8& pa3) {
#pragma unroll
  for (int r = 0; r < 16; ++r) p1[r] = __builtin_amdgcn_exp2f(p1[r]);
  float ps = 0;
#pragma unroll
  for (int r = 0; r < 16; ++r) ps += p0[r];
#pragma unroll
  for (int r = 0; r < 16; ++r) ps += p1[r];
  { auto rr = __builtin_amdgcn_permlane32_swap(__float_as_uint(ps), __float_as_uint(ps), false, false);
    ps = __uint_as_float(rr[0]) + __uint_as_float(rr[1]); }
  l_reg = l_reg * alpha + ps;
#define PK4(P, BASE, OUT) do { unsigned a0 = cvtpk_asm(P[BASE + 0], P[BASE + 1]), a1 = cvtpk_asm(P[BASE + 2], P[BASE + 3]);   \
    unsigned b0 = cvtpk_asm(P[BASE + 4], P[BASE + 5]), b1 = cvtpk_asm(P[BASE + 6], P[BASE + 7]);                              \
    auto r0 = __builtin_amdgcn_permlane32_swap(a0, b0, false, false); auto r1 = __builtin_amdgcn_permlane32_swap(a1, b1, false, false); \
    u32x4 w = {r0[0], r1[0], r0[1], r1[1]}; OUT = *reinterpret_cast<bf16x8*>(&w); } while (0)
  PK4(p0, 0, pa0); PK4(p0, 8, pa1); PK4(p1, 0, pa2); PK4(p1, 8, pa3);
#undef PK4
}
template <int DQ>
__device__ __forceinline__ void qkt(f32x16& p0, f32x16& p1, const char* Ks, const char* KRs, const bf16x8* qr, const bf16x8* qrope  , int r32, int hi) {
  p0 = f32x16{}; p1 = f32x16{};
  const int sw = (r32 & 7) << 4;
#pragma unroll
  for (int d0 = 0; d0 < 8; ++d0) { const int cb = (d0 * 32 + hi * 16) ^ sw;
    bf16x8 b0 = *reinterpret_cast<const bf16x8*>(Ks + r32 * 256 + cb);
    bf16x8 b1 = *reinterpret_cast<const bf16x8*>(Ks + (32 + r32) * 256 + cb);
    p0 = __builtin_amdgcn_mfma_f32_32x32x16_bf16(b0, qr[d0], p0, 0, 0, 0);
    p1 = __builtin_amdgcn_mfma_f32_32x32x16_bf16(b1, qr[d0], p1, 0, 0, 0); }
  if constexpr (DQ == 192) {
#pragma unroll
    for (int d0 = 0; d0 < 4; ++d0) { const int cb = (d0 * 32 + hi * 16) ^ sw;
      bf16x8 b0 = *reinterpret_cast<const bf16x8*>(KRs + r32 * 128 + cb);
      bf16x8 b1 = *reinterpret_cast<const bf16x8*>(KRs + (32 + r32) * 128 + cb);
      const bf16x8 qf = qrope[d0 * 64];
      p0 = __builtin_amdgcn_mfma_f32_32x32x16_bf16(b0, qf, p0, 0, 0, 0);
      p1 = __builtin_amdgcn_mfma_f32_32x32x16_bf16(b1, qf, p1, 0, 0, 0); }
  }
}
__device__ __forceinline__ int v_st(int k, int c) { const int kk = (k & ~0xC) | ((k & 4) << 1) | ((k & 8) >> 1); return ((kk >> 3) * 4 + (c >> 5)) * 512 + ((kk & 7) * 32 + (c & 31)) * 2; }
__device__ __forceinline__ int v_rd_base(int lane) { return ((lane & 3) << 3) | (((lane >> 2) & 3) << 6) | (((lane >> 4) & 1) << 5) | (((lane >> 5) & 1) << 8); }
constexpr int v_rd_off(int d0, int ks, int half) { return d0 * 512 + ks * 4096 + half * 2048; }
template <int OFF> __device__ __forceinline__ s16x4 tr_read(int vb) {
  s16x4 r; asm volatile("ds_read_b64_tr_b16 %0, %1 offset:%2" : "=&v"(r) : "v"(vb), "i"(OFF) : "memory"); return r;
}
template <int D0> __device__ __forceinline__ void pv_one(f32x16& od, int vb, bf16x8 pa0, bf16x8 pa1, bf16x8 pa2, bf16x8 pa3) {
  const s16x4 l0 = tr_read<v_rd_off(D0, 0, 0)>(vb), h0 = tr_read<v_rd_off(D0, 0, 1)>(vb), l1 = tr_read<v_rd_off(D0, 1, 0)>(vb), h1 = tr_read<v_rd_off(D0, 1, 1)>(vb);
  const s16x4 l2 = tr_read<v_rd_off(D0, 2, 0)>(vb), h2 = tr_read<v_rd_off(D0, 2, 1)>(vb), l3 = tr_read<v_rd_off(D0, 3, 0)>(vb), h3 = tr_read<v_rd_off(D0, 3, 1)>(vb);
  asm volatile("s_waitcnt lgkmcnt(0)" ::: "memory"); SBAR();
#define PKV(L, H) (bf16x8){L[0], L[1], L[2], L[3], H[0], H[1], H[2], H[3]}
  od = __builtin_amdgcn_mfma_f32_32x32x16_bf16(pa0, PKV(l0, h0), od, 0, 0, 0);
  od = __builtin_amdgcn_mfma_f32_32x32x16_bf16(pa1, PKV(l1, h1), od, 0, 0, 0);
  od = __builtin_amdgcn_mfma_f32_32x32x16_bf16(pa2, PKV(l2, h2), od, 0, 0, 0);
  od = __builtin_amdgcn_mfma_f32_32x32x16_bf16(pa3, PKV(l3, h3), od, 0, 0, 0);
#undef PKV
}
__device__ __forceinline__ void pv_d0(f32x16* o, int vb, bf16x8 pa0, bf16x8 pa1, bf16x8 pa2, bf16x8 pa3) {
  pv_one<0>(o[0], vb, pa0, pa1, pa2, pa3); pv_one<1>(o[1], vb, pa0, pa1, pa2, pa3); pv_one<2>(o[2], vb, pa0, pa1, pa2, pa3); pv_one<3>(o[3], vb, pa0, pa1, pa2, pa3);
}
constexpr int ATT_LDS = 2 * 16384 + 2 * 16384 + 2 * 8192 + 2048 + 32768;
template <int DQ, int LDQ, int LDK, int LDKR, int LDV, int LDO, int SDEPTH>
__device__ __forceinline__ void attn_body(const bf16_t* __restrict__ Qb, const bf16_t* __restrict__ Kh, const bf16_t* __restrict__ Krh, const bf16_t* __restrict__ Vh,
                                          bf16_t* __restrict__ Ob, int seq, char* lds) {
  constexpr int SHM_V = 16384, SHM_K = 16384, SHM_KR = 8192;
  constexpr bool ROPE = DQ == 192;
  constexpr float scale = ROPE ? 0.07216878364870322f : 0.08838834764831845f;
  constexpr float C = scale * 1.4426950408889634f, thr_s = ATT_THR / scale;
  const int tid = otid();
  const int wid = tid >> 6, lane = tid & 63, r32 = lane & 31, hi = lane >> 5;
  char* V_lds = lds; char* K_lds = lds + 2 * SHM_V; char* KR_lds = K_lds + 2 * SHM_K;
  float* ws = (float*)(KR_lds + 2 * SHM_KR) + wid * 64; float* li_l = ws; float* al_l = ws + 32;
  float m_reg = -1e30f, l_reg = 0; f32x16 o[4] = {}; bf16x8 qr[8];
  const bf16_t* Qw = Qb + (long)(wid * 32 + r32) * LDQ + hi * 8;
#pragma unroll
  for (int d0 = 0; d0 < 8; ++d0) qr[d0] = *reinterpret_cast<const bf16x8*>(Qw + d0 * 16);
  bf16x8* qrope = (bf16x8*)(KR_lds + 2 * SHM_KR + 2048) + wid * 256 + lane;
  if constexpr (ROPE) {
#pragma unroll
    for (int d0 = 0; d0 < 4; ++d0) qrope[d0 * 64] = *reinterpret_cast<const bf16x8*>(Qw + 128 + d0 * 16);
  }
  const int sr = tid >> 4, sc = tid & 15;
  const unsigned voffK = (unsigned)(sr * LDK + sc * 8) * 2u, voffV = (unsigned)(sr * LDV + sc * 8) * 2u, voffKR = (unsigned)((tid >> 3) * LDKR + (tid & 7) * 8) * 2u;
  const int kst0 = sr * 256 + ((sc * 16) ^ ((sr & 7) << 4)), vst0 = v_st(sr, sc * 8), vst1 = v_st(32 + sr, sc * 8);
  const int krst = (tid >> 3) * 128 + (((tid & 7) * 16) ^ (((tid >> 3) & 7) << 4));
  const int vb0 = (int)(uintptr_t)V_lds + v_rd_base(lane);
  struct { bf16x8 v0, v1, k0, k1, kr; } sr_[SDEPTH];
#define SLOAD(i, kk) do { const char* vb_ = (const char*)Vh + (size_t)(kk) * (LDV * 2); const char* kb_ = (const char*)Kh + (size_t)(kk) * (LDK * 2); \
    sr_[i].v0 = *reinterpret_cast<const bf16x8*>(vb_ + voffV); sr_[i].v1 = *reinterpret_cast<const bf16x8*>(vb_ + voffV + 32 * LDV * 2); \
    sr_[i].k0 = *reinterpret_cast<const bf16x8*>(kb_ + voffK); sr_[i].k1 = *reinterpret_cast<const bf16x8*>(kb_ + voffK + 32 * LDK * 2); \
    if constexpr (ROPE) sr_[i].kr = *reinterpret_cast<const bf16x8*>((const char*)Krh + (size_t)(kk) * (LDKR * 2) + voffKR); } while (0)
#define SWRITE(b, i) do { *(bf16x8*)(V_lds + (b) * SHM_V + vst0) = sr_[i].v0; *(bf16x8*)(V_lds + (b) * SHM_V + vst1) = sr_[i].v1; \
    *(bf16x8*)(K_lds + (b) * SHM_K + kst0) = sr_[i].k0; *(bf16x8*)(K_lds + (b) * SHM_K + kst0 + 8192) = sr_[i].k1; \
    if constexpr (ROPE) *(bf16x8*)(KR_lds + (b) * SHM_KR + krst) = sr_[i].kr; } while (0)
#define SWAIT() do { if constexpr (SDEPTH == 2) { if constexpr (ROPE) asm volatile("s_waitcnt vmcnt(5)" ::: "memory"); else asm volatile("s_waitcnt vmcnt(4)" ::: "memory"); } \
    else asm volatile("s_waitcnt vmcnt(0)" ::: "memory"); } while (0)
#define RESC(a) do { if (__any((a) < 1.f)) { if (hi == 0) al_l[r32] = (a); asm volatile("s_waitcnt lgkmcnt(0)" ::: "memory"); \
    _Pragma("unroll") for (int d = 0; d < 4; ++d) _Pragma("unroll") for (int r = 0; r < 16; ++r) o[d][r] *= al_l[crow(r, hi)]; } } while (0)
  f32x16 pA0, pA1, pB0, pB1; float mnA, mnB, alA, alB; bf16x8 pa0, pa1, pa2, pa3; const int NT = seq / 64;
  constexpr int SE = 0, SO = SDEPTH - 1;
  SLOAD(SE, 0); asm volatile("s_waitcnt vmcnt(0)" ::: "memory"); SWRITE(0, SE); __syncthreads();
  qkt<DQ>(pA0, pA1, K_lds, KR_lds, qr, qrope, r32, hi); partialSM(pA0, pA1, m_reg, mnA, alA, C, thr_s);
  SLOAD(SO, 64); if constexpr (SDEPTH == 2) { if (2 < NT) SLOAD(SE, 2 * 64); }
  SWAIT(); SWRITE(1, SO); __syncthreads();
  for (int j = 1; j + 1 < NT; j += 2) {
    SBAR(); qkt<DQ>(pB0, pB1, K_lds + SHM_K, KR_lds + SHM_KR, qr, qrope, r32, hi);
    finishSM(pA0, pA1, alA, l_reg, pa0, pa1, pa2, pa3); SBAR();
    SLOAD(SO, (j + SDEPTH) * 64); SBAR();
    pv_d0(o, vb0, pa0, pa1, pa2, pa3); partialSM(pB0, pB1, m_reg, mnB, alB, C, thr_s);
    __syncthreads(); SWAIT(); SWRITE(0, SE);
    RESC(alB); __syncthreads();
    SBAR(); qkt<DQ>(pA0, pA1, K_lds, KR_lds, qr, qrope, r32, hi);
    finishSM(pB0, pB1, alB, l_reg, pa0, pa1, pa2, pa3); SBAR();
    if (SDEPTH == 1 || j + 3 < NT) SLOAD(SE, (j + 1 + SDEPTH) * 64); SBAR();
    pv_d0(o, vb0 + SHM_V, pa0, pa1, pa2, pa3); partialSM(pA0, pA1, m_reg, mnA, alA, C, thr_s);
    __syncthreads(); SWAIT(); SWRITE(1, SO);
    RESC(alA); __syncthreads();
  }
  SBAR(); qkt<DQ>(pB0, pB1, K_lds + SHM_K, KR_lds + SHM_KR, qr, qrope, r32, hi);
  finishSM(pA0, pA1, alA, l_reg, pa0, pa1, pa2, pa3); SBAR();
  pv_d0(o, vb0, pa0, pa1, pa2, pa3); partialSM(pB0, pB1, m_reg, mnB, alB, C, thr_s);
  __syncthreads(); RESC(alB);
  finishSM(pB0, pB1, alB, l_reg, pa0, pa1, pa2, pa3); SBAR();
  pv_d0(o, vb0 + SHM_V, pa0, pa1, pa2, pa3);
  if (hi == 0) li_l[r32] = l_reg; asm volatile("s_waitcnt lgkmcnt(0)" ::: "memory");
  bf16_t* Ow = Ob + (long)(wid * 32) * LDO + r32;
#pragma unroll
  for (int r = 0; r < 16; ++r) { const int orow = crow(r, hi); const float rl = __builtin_amdgcn_rcpf(li_l[orow]);
#pragma unroll
    for (int d0 = 0; d0 < 4; ++d0) Ow[(long)orow * LDO + d0 * 32] = f2bf(o[d0][r] * rl); }
#undef SLOAD
#undef SWRITE
#undef SWAIT
#undef RESC
  __syncthreads();
}

__device__ __forceinline__ void ln_row_finish(float (&r)[16], int cA, int cB, const float* lnw, const float* lnb, bf16_t* Xrow  , bf16_t* Hrow, const float* sh, const float* sc, float* orow, float* stat_out = nullptr) {
  float s = 0.f;
#pragma unroll
  for (int i = 0; i < 16; ++i) s += r[i];
  const float mean = wsum(s) * (1.f / 1024.f);
  float q = 0.f;
#pragma unroll
  for (int i = 0; i < 16; ++i) { r[i] -= mean; q += r[i] * r[i]; }
  const float rstd = rsqrtf(wsum(q) * (1.f / 1024.f) + 1e-5f);
  if (stat_out) *(float2*)stat_out = make_float2(mean, rstd);
#pragma unroll
  for (int hf = 0; hf < 2; ++hf) {
    const int c0 = hf ? cB : cA;
    float xn[8];
#pragma unroll
    for (int i = 0; i < 8; ++i) xn[i] = r[hf * 8 + i] * rstd * lnw[c0 + i] + lnb[c0 + i];
    if (Xrow) { u32x4 xw = {cvtpk(xn[0], xn[1]), cvtpk(xn[2], xn[3]), cvtpk(xn[4], xn[5]), cvtpk(xn[6], xn[7])}; *(u32x4*)(Xrow + c0) = xw; }
    if (orow) { *(float4*)(orow + c0) = make_float4(xn[0], xn[1], xn[2], xn[3]); *(float4*)(orow + c0 + 4) = make_float4(xn[4], xn[5], xn[6], xn[7]); }
    if (Hrow) {
      float hv[8];
#pragma unroll
      for (int i = 0; i < 8; ++i) hv[i] = xn[i] * (1.f + sc[c0 + i]) + sh[c0 + i];
      u32x4 w = {cvtpk(hv[0], hv[1]), cvtpk(hv[2], hv[3]), cvtpk(hv[4], hv[5]), cvtpk(hv[6], hv[7])};
      *(u32x4*)(Hrow + c0) = w;
    }
  }
}

struct WDesc { const float* src; bf16_t* dst; int K, N, Npad; };
constexpr int wd_tiles_of(int K, int Npad) { return (K / 64) * (Npad / 64); }
constexpr int WT_MLA = wd_tiles_of(1024, 768) + wd_tiles_of(1024, 384) + wd_tiles_of(768, 1536) + wd_tiles_of(256, 2048) + wd_tiles_of(1024, 1024);
constexpr int WT_HY = wd_tiles_of(1024, 3072) + wd_tiles_of(1024, 1024), WT_GQA = wd_tiles_of(1024, 1536) + wd_tiles_of(1024, 1024), WT_PQ = wd_tiles_of(1024, 2048);
constexpr int WD_TILES = 2 * WT_MLA + WT_HY + WT_GQA + 4 * WT_PQ;
__device__ __forceinline__ void wconv_desc(const Params& p, int it, WDesc& w, int& k0, int& n0) {
  int lt = it;
  if (lt < 2 * WT_MLA) {
    const int i = lt / WT_MLA; lt -= i * WT_MLA;
    if (lt < wd_tiles_of(1024, 768)) w = WDesc{p.in[8] + (size_t)i * 1024 * 768, WSP(bf16_t, OFF_W1 + (size_t)i * SZ_W1), 1024, 768, 768};
    else if ((lt -= wd_tiles_of(1024, 768)) < wd_tiles_of(1024, 384)) w = WDesc{p.in[11] + (size_t)i * 1024 * 320, WSP(bf16_t, OFF_W1 + (size_t)i * SZ_W1) + (size_t)768 * 1024, 1024, 320, 384};
    else if ((lt -= wd_tiles_of(1024, 384)) < wd_tiles_of(768, 1536)) w = WDesc{p.in[10] + (size_t)i * 768 * 1536, WSP(bf16_t, OFF_WUQ + (size_t)i * SZ_WUQ), 768, 1536, 1536};
    else if ((lt -= wd_tiles_of(768, 1536)) < wd_tiles_of(256, 2048)) w = WDesc{p.in[13] + (size_t)i * 256 * 2048, WSP(bf16_t, OFF_WUKV + (size_t)i * SZ_WUKV), 256, 2048, 2048};
    else { lt -= wd_tiles_of(256, 2048); w = WDesc{p.in[14] + (size_t)i * 1024 * 1024, WSP(bf16_t, OFF_WOA + (size_t)i * SZ_WSQ), 1024, 1024, 1024}; }
  } else if ((lt -= 2 * WT_MLA) < WT_HY) {
    if (lt < wd_tiles_of(1024, 3072)) w = WDesc{p.in[15], WSP(bf16_t, OFF_WIN), 1024, 3072, 3072};
    else { lt -= wd_tiles_of(1024, 3072); w = WDesc{p.in[27], WSP(bf16_t, OFF_WOUT), 1024, 1024, 1024}; }
  } else if ((lt -= WT_HY) < WT_GQA) {
    if (lt < wd_tiles_of(1024, 1536)) w = WDesc{p.in[29], WSP(bf16_t, OFF_WQKV), 1024, 1536, 1536};
    else { lt -= wd_tiles_of(1024, 1536); w = WDesc{p.in[32], WSP(bf16_t, OFF_WOC), 1024, 1024, 1024}; }
  } else {
    lt -= WT_GQA; const int l = lt / WT_PQ; lt -= l * WT_PQ;
    w = WDesc{p.in[33] + (size_t)l * 1024 * 2048, WSP(bf16_t, OFF_WQ + (size_t)l * SZ_WQ), 1024, 2048, 2048};
  }
  const int tn = w.Npad / 64, kt = lt / tn, nt = lt - kt * tn; k0 = kt * 64; n0 = nt * 64;
}
constexpr int WB = 4;
static_assert(WD_TILES % WB == 0, "wconv batches");
__device__ __forceinline__ void job_wconv(const Params& p, char* lds) {
  float* tile = (float*)lds;
  const int tid = otid();
  for (int it = blockIdx.x * WB; it < WD_TILES; it += gridDim.x * WB) {
    float4 v4[WB][2];
#pragma unroll
    for (int b = 0; b < WB; ++b) {
      WDesc w; int k0, n0; wconv_desc(p, it + b, w, k0, n0);
#pragma unroll
      for (int i = 0; i < 2; ++i) { const int e = tid + NTHR * i, k = e >> 4, n = (e & 15) * 4; v4[b][i] = (n0 + n < w.N) ? *(const float4*)(w.src + (size_t)(k0 + k) * w.N + n0 + n) : make_float4(0.f, 0.f, 0.f, 0.f); }
    }
#pragma unroll
    for (int b = 0; b < WB; ++b)
#pragma unroll
      for (int i = 0; i < 2; ++i) { const int e = tid + NTHR * i, k = e >> 4, n = (e & 15) * 4; float* tb = tile + b * (64 * 65); tb[k * 65 + n] = v4[b][i].x; tb[k * 65 + n + 1] = v4[b][i].y; tb[k * 65 + n + 2] = v4[b][i].z; tb[k * 65 + n + 3] = v4[b][i].w; }
    __syncthreads();
#pragma unroll
    for (int b = 0; b < WB; ++b) {
      WDesc w; int k0, n0; wconv_desc(p, it + b, w, k0, n0);
      const float* tb = tile + b * (64 * 65);
      const int n = tid >> 3, kc = (tid & 7) * 8;
      u32x4 o = {cvtpk(tb[kc * 65 + n], tb[(kc + 1) * 65 + n]), cvtpk(tb[(kc + 2) * 65 + n], tb[(kc + 3) * 65 + n]), cvtpk(tb[(kc + 4) * 65 + n], tb[(kc + 5) * 65 + n]), cvtpk(tb[(kc + 6) * 65 + n], tb[(kc + 7) * 65 + n])};
      *(u32x4*)(w.dst + (size_t)(n0 + n) * w.K + k0 + kc) = o;
    }
    __syncthreads();
  }
}
__device__ __forceinline__ void job_peer_conv(const Params& p) {
  const int tid = otid();
  const size_t gt = (size_t)blockIdx.x * NTHR + tid, gs = (size_t)gridDim.x * NTHR;
  const size_t nk8 = (size_t)4 * 16 * 16384 / 8;
  for (size_t i = gt; i < nk8; i += gs) {
    const size_t e = i * 8; const int blk = (int)(e >> 14), off = (int)(e & 16383); const int l = blk >> 4, h = (blk >> 1) & 7, side = blk & 1;
    const float* src = (side ? p.in[35] : p.in[34]) + ((size_t)(l * 8 + h) << 14) + off;
    const float4 a = *(const float4*)src, b = *(const float4*)(src + 4);
    u32x4 w = {cvtpk(a.x, a.y), cvtpk(a.z, a.w), cvtpk(b.x, b.y), cvtpk(b.z, b.w)};
    *(u32x4*)(WSP(bf16_t, OFF_KEYS) + e) = w;
  }
}
__device__ __forceinline__ void peer_conv_tables(const Params& p, int la, int lb) {
  const int tid = otid();
  const int lane = tid & 63, wg = blockIdx.x * 8 + (tid >> 6), nw = gridDim.x * 8;
  const int NR = (lb - la) * 16384;
  for (int r0 = wg; r0 < 2 * NR; r0 += 4 * nw) {
    float4 x[4][4];
#pragma unroll
    for (int u = 0; u < 4; ++u) { const int r = r0 + u * nw; if (r < 2 * NR) {
      const int isv = r >= NR, row = la * 16384 + (isv ? r - NR : r);
      const float* src = (isv ? p.in[37] : p.in[36]) + (size_t)row * 1024 + lane * 16;
#pragma unroll
      for (int j = 0; j < 4; ++j) x[u][j] = *(const float4*)(src + 4 * j); } }
#pragma unroll
    for (int u = 0; u < 4; ++u) { const int r = r0 + u * nw; if (r < 2 * NR) {
      const int isv = r >= NR, row = la * 16384 + (isv ? r - NR : r);
      float am = 0.f;
#pragma unroll
      for (int j = 0; j < 4; ++j) am = fmaxf(am, fmaxf(fmaxf(fabsf(x[u][j].x), fabsf(x[u][j].y)), fmaxf(fabsf(x[u][j].z), fabsf(x[u][j].w))));
      am = wmax(am);
      u32x4 w; float isc;
      if (isv) {
        int e = (int)((__float_as_uint(am) >> 23) & 255u) - 127; e = e < -100 ? -100 : (e > 100 ? 100 : e);
        const int k = 7 - e;
        const float sc = __uint_as_float((unsigned)(k + 127) << 23); isc = __uint_as_float((unsigned)(127 - k) << 23);
#pragma unroll
        for (int j = 0; j < 4; ++j) { int q = 0; q = __builtin_amdgcn_cvt_pk_fp8_f32(x[u][j].x * sc, x[u][j].y * sc, q, false); q = __builtin_amdgcn_cvt_pk_fp8_f32(x[u][j].z * sc, x[u][j].w * sc, q, true); w[j] = (unsigned)q; }
      } else {
        const float sc = am > 0.f ? 127.f / am : 0.f; isc = am * (1.f / 127.f);
#pragma unroll
        for (int j = 0; j < 4; ++j) { const int q0 = (int)__builtin_rintf(x[u][j].x * sc), q1 = (int)__builtin_rintf(x[u][j].y * sc), q2 = (int)__builtin_rintf(x[u][j].z * sc), q3 = (int)__builtin_rintf(x[u][j].w * sc);
          w[j] = ((unsigned)q0 & 255u) | (((unsigned)q1 & 255u) << 8) | (((unsigned)q2 & 255u) << 16) | ((unsigned)q3 << 24); }
      }
      *(u32x4*)(WSP(unsigned char, OFF_PU) + (size_t)row * 2048 + (isv ? 1024 : 0) + lane * 16) = w;
      if (lane == 0) (isv ? WSP(float, OFF_SV) : WSP(float, OFF_SU))[row] = isc;
    } }
  }
}
__device__ __forceinline__ void job_adaln_partial(const Params& p, char* lds) {
  float* sl = (float*)lds;
  float* red = (float*)lds + 1024;
  const int tid = otid();
  for (int it = blockIdx.x; it < 768; it += gridDim.x) {
    const int l = it / 192, rem = it - l * 192, cgp = rem >> 3, ks = rem & 7;
    const int cq = tid & 63, kg = tid >> 6;
    float4 wv[16];
#pragma unroll
    for (int i = 0; i < 16; ++i) wv[i] = *(const float4*)(p.in[4] + ((size_t)l * 1024 + ks * 128 + kg * 16 + i) * 6144 + cgp * 256 + cq * 4);
    __builtin_amdgcn_sched_barrier(0);
    for (int e = tid; e < 640; e += NTHR) { const int r = e >> 7, k = e & 127; const float v = (r < 4) ? p.in[1][r * 1024 + ks * 128 + k] : p.in[3][ks * 128 + k]; sl[e] = v / (1.f + __expf(-v)); }
    __syncthreads();
    float4 acc[5];
#pragma unroll
    for (int r = 0; r < 5; ++r) acc[r] = make_float4(0.f, 0.f, 0.f, 0.f);
#pragma unroll
    for (int i = 0; i < 16; ++i) {
      const int k = kg * 16 + i;
      const float4 w = wv[i];
#pragma unroll
      for (int r = 0; r < 5; ++r) { const float sv = sl[r * 128 + k]; acc[r].x += sv * w.x; acc[r].y += sv * w.y; acc[r].z += sv * w.z; acc[r].w += sv * w.w; }
    }
#pragma unroll
    for (int r = 0; r < 5; ++r) *(float4*)(red + (kg * 5 + r) * 256 + cq * 4) = acc[r];
    __syncthreads();
    for (int e = tid; e < 1280; e += NTHR) {
      const int r = e >> 8, col = e & 255; float s = 0.f;
#pragma unroll
      for (int g = 0; g < 8; ++g) s += red[(g * 5 + r) * 256 + col];
      WSP(float, OFF_MODP)[((size_t)(ks * 4 + l) * 5 + r) * 6144 + cgp * 256 + col] = s;
    }
    __syncthreads();
  }
}
__device__ __forceinline__ void job_hdn(const Params& p, char* lds) {
  float* h1s = (float*)lds;
  const int tid = otid(), tl = tid >> 6, r = tid & 63;
  for (int it = blockIdx.x; it < 544; it += gridDim.x) {
    const int s = it < 512 ? 0 : 1, chunk = it - s * 512, L = s ? 256 : 4096, tau = chunk * 8 + tl;
    float a1 = p.in[20][r] + ((float)tau / (float)(L - 1)) * p.in[19][r];
#pragma unroll 4
    for (int k = 0; k < 16; ++k) {
      const float f = 1e-4f + (float)k * ((15.f - 1e-4f) / 15.f);
      const float rev = f * (float)tau / (float)L;
      a1 += cos_rev(rev) * p.in[19][(1 + k) * 64 + r] - sin_rev(rev) * p.in[19][(17 + k) * 64 + r];
    }
    h1s[tl * 64 + r] = sin_rad(p.in[21][r] * a1);
    __syncthreads();
    float a2 = p.in[23][r];
    for (int q = 0; q < 64; ++q) a2 += h1s[tl * 64 + q] * p.in[22][q * 64 + r];
    WSP(float, OFF_HDN)[((size_t)s * 4096 + tau) * 64 + r] = sin_rad(p.in[24][r] * a2);
    __syncthreads();
  }
}
__device__ __forceinline__ void job_mod_final(const Params& p) {
  for (int e = blockIdx.x * NTHR + otid(); e < 4 * 5 * 6144; e += gridDim.x * NTHR) {
    const int l = e / 30720, rem = e - l * 30720, col = rem % 6144;
    float s = p.in[5][l * 6144 + col];
#pragma unroll
    for (int ks = 0; ks < 8; ++ks) s += WSP(float, OFF_MODP)[(size_t)ks * 4 * 30720 + e];
    WSP(float, OFF_MOD)[e] = s;
  }
}
__device__ __forceinline__ void job_gbuild(const Params& p, char* lds) {
  float* hd = (float*)lds;
  const int tid = otid();
  for (int it = blockIdx.x; it < 1024 + 64; it += gridDim.x) {
    const int s = it < 1024 ? 0 : 1, li = it - s * 1024, L = s ? 256 : 4096, tt = li >> 3, ct = li & 7;
    const int col = ct * 512 + tid, o = col >> 11, dir = (col >> 10) & 1, d = col & 1023;
    float w3c[64];
#pragma unroll
    for (int r = 0; r < 64; ++r) w3c[r] = p.in[25][r * 4096 + col];
    for (int e = tid; e < 2048; e += NTHR) hd[e] = WSP(float, OFF_HDN)[((size_t)s * 4096 + tt * 32) * 64 + e];
    __syncthreads();
    const float delta = 3.0701134573253945f + 12.280453829301578f * ((float)d / 1023.f);
    const float bias_o = p.in[26][o * 1024 + d];
    const int FCNs = 2 * L + 144, OFFs = L + 64;
    bf16_t* st = (bf16_t*)(lds + 8192);
    for (int j = 0; j < 32; ++j) {
      const int tau = tt * 32 + j;
      float f = 0.f;
#pragma unroll
      for (int r = 0; r < 64; ++r) f += hd[j * 64 + r] * w3c[r];
      const float t01 = (float)tau / (float)(L - 1);
      float val = f * (__expf(-t01 * delta) + 0.05f);
      if (dir == 0 && tau == 0) val += bias_o;
      st[j * 514 + tid] = f2bf(val);
    }
    __syncthreads();
    bf16_t* Gbase = (s ? WSP(bf16_t, OFF_GCTX) : WSP(bf16_t, OFF_GLAT));
    for (int e = tid; e < 512 * 32; e += NTHR) {
      const int cl = e >> 5, i = e & 31, colg = ct * 512 + cl, og = colg >> 11, dirg = (colg >> 10) & 1, dg = colg & 1023;
      bf16_t* Gp = Gbase + (size_t)(og * 1024 + dg) * FCNs;
      if (dirg == 0) Gp[OFFs - tt * 32 - 31 + i] = st[(31 - i) * 514 + cl];
      else if (tt * 32 + i > 0) Gp[OFFs + tt * 32 + i] = st[i * 514 + cl];
    }
    if (tt == 0) {
      bf16_t* Gp = Gbase + (size_t)(o * 1024 + d) * FCNs;
      if (dir == 0) { for (int w = 0; w <= 64; ++w) Gp[w] = 0; } else { for (int w = 2 * L + 64; w < FCNs; ++w) Gp[w] = 0; }
    }
    __syncthreads();
  }
}
__device__ __forceinline__ void job_init(const Params& p) {
  const size_t n4 = (size_t)T * 256;
  for (size_t i = (size_t)blockIdx.x * NTHR + otid(); i < n4; i += (size_t)gridDim.x * NTHR) {
    const int row = (int)(i >> 8), c = (int)(i & 255) * 4;
    const RowInfo ri = row_info(row);
    const float* src = ri.is_ctx ? p.in[2] + ((size_t)(ri.b * CTXL + ri.rb) * 1024 + c) : p.in[0] + ((size_t)(ri.b * SEQ + ri.pos) * 1024 + c);
    const float4 v = *(const float4*)src;
    { u32x2 xw = {cvtpk(v.x, v.y), cvtpk(v.z, v.w)}; *(u32x2*)(WSP(bf16_t, OFF_X) + (size_t)row * 1024 + c) = xw; }
    const float* md = WSP(float, OFF_MOD) + (size_t)ri.mrow * 6144;
    const float4 sh = *(const float4*)(md + c), sc = *(const float4*)(md + 1024 + c);
    u32x2 w = {cvtpk(v.x * (1.f + sc.x) + sh.x, v.y * (1.f + sc.y) + sh.y), cvtpk(v.z * (1.f + sc.z) + sh.z, v.w * (1.f + sc.w) + sh.w)};
    *(u32x2*)(WSP(bf16_t, OFF_H) + (size_t)row * 1024 + c) = w;
  }
}
__device__ __forceinline__ void job_mla_norm(const Params& p, int ia) {
  const int lane = otid() & 63, wg = blockIdx.x * 8 + (otid() >> 6), nw = gridDim.x * 8;
  const bf16_t* C1 = WSP(bf16_t, OFF_RA); bf16_t* CQN = WSP(bf16_t, OFF_RE); bf16_t* CKVN = WSP(bf16_t, OFF_RE) + (size_t)T * 768; bf16_t* KPE = WSP(bf16_t, OFF_RC) + (size_t)T * 1024;
  const float* qn = p.in[9] + ia * 768; const float* kn = p.in[12] + ia * 256;
  for (int row0 = wg; row0 < T; row0 += 2 * nw) {
    u32x2 vq[2][3], kvq[2]; unsigned xpq[2];
#pragma unroll
    for (int u = 0; u < 2; ++u) { const int row = row0 + u * nw; if (row < T) { const bf16_t* cr = C1 + (size_t)row * 1152;
#pragma unroll
      for (int j = 0; j < 3; ++j) vq[u][j] = *(const u32x2*)(cr + (j * 64 + lane) * 4);
      kvq[u] = *(const u32x2*)(cr + 768 + lane * 4); xpq[u] = *(const unsigned*)(cr + 1024 + 2 * (lane & 31)); } }
#pragma unroll
    for (int u = 0; u < 2; ++u) { const int row = row0 + u * nw; if (row < T) {
    float4 v[3]; float ss = 0.f;
#pragma unroll
    for (int j = 0; j < 3; ++j) { v[j] = make_float4(bflo(vq[u][j][0]), bfhi(vq[u][j][0]), bflo(vq[u][j][1]), bfhi(vq[u][j][1])); ss += v[j].x * v[j].x + v[j].y * v[j].y + v[j].z * v[j].z + v[j].w * v[j].w; }
    const float rq = rsqrtf(wsum(ss) * (1.f / 768.f) + 1e-6f);
#pragma unroll
    for (int j = 0; j < 3; ++j) { const int c = (j * 64 + lane) * 4; const float4 g = *(const float4*)(qn + c);
      u32x2 w = {cvtpk(v[j].x * rq * g.x, v[j].y * rq * g.y), cvtpk(v[j].z * rq * g.z, v[j].w * rq * g.w)}; *(u32x2*)(CQN + (size_t)row * 768 + c) = w; }
    const float4 kv = make_float4(bflo(kvq[u][0]), bfhi(kvq[u][0]), bflo(kvq[u][1]), bfhi(kvq[u][1]));
    const float rk = rsqrtf(wsum(kv.x * kv.x + kv.y * kv.y + kv.z * kv.z + kv.w * kv.w) * (1.f / 256.f) + 1e-6f);
    { const float4 g = *(const float4*)(kn + lane * 4);
      u32x2 w = {cvtpk(kv.x * rk * g.x, kv.y * rk * g.y), cvtpk(kv.z * rk * g.z, kv.w * rk * g.w)}; *(u32x2*)(CKVN + (size_t)row * 256 + lane * 4) = w; }
    if (lane < 32) {
      const float x0 = bflo(xpq[u]), x1 = bfhi(xpq[u]);
      const RowInfo ri = row_info(row);
      float o0 = x0, o1 = x1;
      if (!ri.is_ctx) { float c, s; rope_cs(ri.pos, lane, 16, c, s); o0 = x0 * c - x1 * s; o1 = x0 * s + x1 * c; }
      *(unsigned*)(KPE + (size_t)row * 64 + 2 * lane) = cvtpk(o0, o1);
    }
    } }
  }
}
__device__ __forceinline__ void job_gqa_norm(const Params& p) {
  const int lane = otid() & 63, wg = blockIdx.x * 8 + (otid() >> 6), nw = gridDim.x * 8;
  const bf16_t* QKV = WSP(bf16_t, OFF_RA); bf16_t* Qb = WSP(bf16_t, OFF_RB); bf16_t* Kb = WSP(bf16_t, OFF_RC); bf16_t* Vb = WSP(bf16_t, OFF_RD);
  for (int row = wg; row < T; row += nw) {
    const bf16_t* cr = QKV + (size_t)row * 1536;
    const RowInfo ri = row_info(row);
    float rc = 1.f, rs = 0.f;
    if (!ri.is_ctx) rope_cs(ri.pos, lane, 32, rc, rs);
    float2 xpa[10];
#pragma unroll
    for (int hh = 0; hh < 10; ++hh) { const unsigned w_ = *(const unsigned*)(cr + hh * 128 + 2 * lane); xpa[hh] = make_float2(bflo(w_), bfhi(w_)); }
    const u32x2 vraw = *(const u32x2*)(cr + 1280 + lane * 4);
#pragma unroll
    for (int hh = 0; hh < 10; ++hh) {
      const float2 xp = xpa[hh];
      const float rinv = rsqrtf(wsum(xp.x * xp.x + xp.y * xp.y) * (1.f / 128.f) + 1e-6f);
      const float2 g = *(const float2*)((hh < 8 ? p.in[30] : p.in[31]) + 2 * lane);
      const float x0 = xp.x * rinv * g.x, x1 = xp.y * rinv * g.y;
      const unsigned w = cvtpk(x0 * rc - x1 * rs, x0 * rs + x1 * rc);
      if (hh < 8) *(unsigned*)(Qb + (size_t)row * 1024 + hh * 128 + 2 * lane) = w; else *(unsigned*)(Kb + (size_t)row * 256 + (hh - 8) * 128 + 2 * lane) = w;
    }
    *(u32x2*)(Vb + (size_t)row * 256 + lane * 4) = vraw;
  }
}
__device__ __forceinline__ void job_ln1(const Params& p, int layer) {
  const bool skip_ctx = layer == DEPTH - 1;
  const int lane = otid() & 63, wg = blockIdx.x * 8 + (otid() >> 6), nw = gridDim.x * 8;
  const float* lnw = p.in[6] + (size_t)(layer * 2) * 1024; const float* lnb = p.in[7] + (size_t)(layer * 2) * 1024;
  for (int row0 = wg; row0 < T; row0 += 2 * nw) {
    u32x4 xv[2][2];
#pragma unroll
    for (int u = 0; u < 2; ++u) { const int row = row0 + u * nw; if (row < T && !(skip_ctx && row_info(row).is_ctx)) {
      const bf16_t* Xr = WSP(bf16_t, OFF_X) + (size_t)row * 1024;
      xv[u][0] = *(const u32x4*)(Xr + lane * 8); xv[u][1] = *(const u32x4*)(Xr + 512 + lane * 8); } }
#pragma unroll
    for (int u = 0; u < 2; ++u) { const int row = row0 + u * nw; if (row < T && !(skip_ctx && row_info(row).is_ctx)) {
      const RowInfo ri = row_info(row);
      const float* md = WSP(float, OFF_MOD) + ((size_t)layer * 5 + ri.mrow) * 6144;
      float r[16];
#pragma unroll
      for (int q = 0; q < 4; ++q) { r[2 * q] = bflo(xv[u][0][q]); r[2 * q + 1] = bfhi(xv[u][0][q]); r[8 + 2 * q] = bflo(xv[u][1][q]); r[8 + 2 * q + 1] = bfhi(xv[u][1][q]); }
      ln_row_finish(r, lane * 8, 512 + lane * 8, lnw, lnb, nullptr, WSP(bf16_t, OFF_H) + (size_t)row * 1024, md + 3072, md + 4096, nullptr, WSP(float, OFF_LST) + (size_t)row * 2);
    } }
  }
}
__device__ __forceinline__ void job_attn_mla(const Params& p, char* lds, bool skip_ctx, int conv_la) {
  const bf16_t* Qb = WSP(bf16_t, OFF_RB); const bf16_t* Kb = WSP(bf16_t, OFF_RC); const bf16_t* KPE = WSP(bf16_t, OFF_RC) + (size_t)T * 1024; const bf16_t* Vb = WSP(bf16_t, OFF_RD); bf16_t* AO = WSP(bf16_t, OFF_RF);
  const int grp = (int)(blockIdx.x >> 3) % 3; int kitem = 0;
  for (int it0 = blockIdx.x; it0 < (skip_ctx ? 512 : 544); it0 += gridDim.x, ++kitem) {
    if (conv_la >= 0 && kitem == grp) peer_conv_tables(p, conv_la, conv_la + 2);
    int it = it0;
    if ((gridDim.x & 7) == 0 && gridDim.x == 256 && it0 < 512) { const int xcd = it0 & 7, j = ((it0 & 255) >> 3) + 32 * (it0 >> 8); it = (xcd * 4 + (j >> 4)) * 16 + (j & 15); }
    int b, h, q0, seq;
    if (it < 512) { b = it >> 7; h = (it >> 4) & 7; q0 = b * RB + CTXL + (it & 15) * 256; seq = RB; } else { const int j = it - 512; b = j >> 3; h = j & 7; q0 = b * RB; seq = CTXL; }
    attn_body<192, 1536, 1024, 64, 1024, 1024, 1>(Qb + (size_t)q0 * 1536 + h * 192, Kb + (size_t)b * RB * 1024 + h * 128, KPE + (size_t)b * RB * 64, Vb + (size_t)b * RB * 1024 + h * 128,
                                                   AO + (size_t)q0 * 1024 + h * 128, seq, lds);
  }
  if (conv_la >= 0 && grp >= kitem) peer_conv_tables(p, conv_la, conv_la + 2);
}
__device__ __forceinline__ void job_attn_gqa(const Params& p, char* lds, int conv_la) {
  const bf16_t* Qb = WSP(bf16_t, OFF_RB); const bf16_t* Kb = WSP(bf16_t, OFF_RC); const bf16_t* Vb = WSP(bf16_t, OFF_RD); bf16_t* AO = WSP(bf16_t, OFF_RF);
  const int grp = (int)(blockIdx.x >> 3) % 3; int kitem = 0;
  for (int it0 = blockIdx.x; it0 < 544; it0 += gridDim.x, ++kitem) {
    if (conv_la >= 0 && kitem == grp) peer_conv_tables(p, conv_la, conv_la + 2);
    int it = it0;
    if ((gridDim.x & 7) == 0 && gridDim.x == 256 && it0 < 512) { const int xcd = it0 & 7, j = ((it0 & 255) >> 3) + 32 * (it0 >> 8); it = (xcd * 4 + (j >> 4)) * 16 + (j & 15); }
    int b, h, q0, seq;
    if (it < 512) { b = it >> 7; h = (it >> 4) & 7; q0 = b * RB + CTXL + (it & 15) * 256; seq = RB; } else { const int j = it - 512; b = j >> 3; h = j & 7; q0 = b * RB; seq = CTXL; }
    attn_body<128, 1024, 256, 64, 256, 1024, 1>(Qb + (size_t)q0 * 1024 + h * 128, Kb + (size_t)b * RB * 256 + (h >> 2) * 128, nullptr, Vb + (size_t)b * RB * 256 + (h >> 2) * 128,
                                                 AO + (size_t)q0 * 1024 + h * 128, seq, lds);
  }
  if (conv_la >= 0 && grp >= kitem) peer_conv_tables(p, conv_la, conv_la + 2);
}
constexpr int HY_FCN = 8352, HY_BS = 72, HY_VEN = 78 * HY_BS + 48;
static_assert(HY_FCN % 128 == 32 && HY_VEN % 128 == 32, "bank-spreading strides");
constexpr int HY_LDS = 4 * HY_FCN * 2 + 2 * 4 * HY_VEN * 2;
__device__ __forceinline__ float hy_short(const bf16_t* zr, int t, int L, float w0, float w1, float w2, float cb) {
  float v = cb + w1 * bf2f(zr[t]);
  if (t > 0) v += w0 * bf2f(zr[t - 1]);
  if (t + 1 < L) v += w2 * bf2f(zr[t + 1]);
  return v;
}
struct SeqPre { u32x4 zc[5]; unsigned zl[5], zr[5]; };
__device__ __forceinline__ void hy_seq_load(const Params& p, SeqPre& s, int ch, int L, int nb, int seq0) {
  const bf16_t* ZT = WSP(bf16_t, OFF_RA);
  const int cpb = (nb + 14) * 8, tid = otid();
#pragma unroll
  for (int i = 0; i < 5; ++i) {
    const int e = tid + NTHR * i, b = e / cpb, ci = e - b * cpb, t0 = ci * 8 - 7 * 64;
    s.zc[i] = (u32x4){0u, 0u, 0u, 0u}; s.zl[i] = 0u; s.zr[i] = 0u;
    if (e < 4 * cpb && t0 >= 0 && t0 < L) {
      const bf16_t* zr = ZT + (size_t)ch * T + b * RB + seq0;
      s.zc[i] = *(const u32x4*)(zr + t0);
      if (t0 > 0) s.zl[i] = zr[t0 - 1];
      if (t0 + 8 < L) s.zr[i] = zr[t0 + 8];
    }
  }
}
__device__ __forceinline__ void hy_seq_store(const Params& p, const SeqPre& s, bf16_t* dst, int ch, int L, int nb) {
  const float w0 = p.in[17][ch], w1 = p.in[17][3072 + ch], w2 = p.in[17][6144 + ch], cb = p.in[18][ch];
  const int cpb = (nb + 14) * 8, tid = otid();
#pragma unroll
  for (int i = 0; i < 5; ++i) {
    const int e = tid + NTHR * i, b = e / cpb, ci = e - b * cpb, t0 = ci * 8 - 7 * 64, lo = (ci >> 3) * HY_BS + (ci & 7) * 8;
    if (e < 4 * cpb) {
      u32x4 w = {0u, 0u, 0u, 0u};
      if (t0 >= 0 && t0 < L) {
        const u32x4 zc = s.zc[i];
        float z[10];
        z[0] = bflo(s.zl[i]); z[9] = bflo(s.zr[i]);
        z[1] = bflo(zc[0]); z[2] = bfhi(zc[0]); z[3] = bflo(zc[1]); z[4] = bfhi(zc[1]); z[5] = bflo(zc[2]); z[6] = bfhi(zc[2]); z[7] = bflo(zc[3]); z[8] = bfhi(zc[3]);
        float o[8];
#pragma unroll
        for (int k = 0; k < 8; ++k) o[k] = cb + w0 * z[k] + w1 * z[k + 1] + w2 * z[k + 2];
        w = (u32x4){cvtpk(o[0], o[1]), cvtpk(o[2], o[3]), cvtpk(o[4], o[5]), cvtpk(o[6], o[7])};
      }
      *(u32x4*)(dst + (size_t)b * HY_VEN + lo) = w;
    }
  }
}
struct FilPre { u32x4 cur[3], prv[3]; };
__device__ __forceinline__ void hy_fil_load(FilPre& f, const bf16_t* Gp, int L) {
  const int nch = (2 * L + 144) / 8, tid = otid();
#pragma unroll
  for (int i = 0; i < 3; ++i) {
    const int c = tid + NTHR * i;
    f.cur[i] = (u32x4){0u, 0u, 0u, 0u}; f.prv[i] = (u32x4){0u, 0u, 0u, 0u};
    if (c < nch) { f.cur[i] = *(const u32x4*)(Gp + c * 8); if (c > 0) f.prv[i] = *(const u32x4*)(Gp + c * 8 - 8); }
  }
}
__device__ __forceinline__ void hy_fil_store(const FilPre& f, bf16_t* FC, int L) {
  const int nch = (2 * L + 144) / 8, tid = otid();
#pragma unroll
  for (int i = 0; i < 3; ++i) {
    const int c = tid + NTHR * i;
    if (c < nch) {
      const u32x4 cur = f.cur[i]; const unsigned W3 = f.prv[i][3], W2 = f.prv[i][2];
      const u32x4 c1 = {__builtin_amdgcn_alignbyte(cur[0], W3, 2), __builtin_amdgcn_alignbyte(cur[1], cur[0], 2), __builtin_amdgcn_alignbyte(cur[2], cur[1], 2), __builtin_amdgcn_alignbyte(cur[3], cur[2], 2)};
      const u32x4 c2 = {W3, cur[0], cur[1], cur[2]};
      const u32x4 c3 = {__builtin_amdgcn_alignbyte(W3, W2, 2), __builtin_amdgcn_alignbyte(cur[0], W3, 2), __builtin_amdgcn_alignbyte(cur[1], cur[0], 2), __builtin_amdgcn_alignbyte(cur[2], cur[1], 2)};
      *(u32x4*)(FC + c * 8) = cur; *(u32x4*)(FC + HY_FCN + c * 8) = c1; *(u32x4*)(FC + 2 * HY_FCN + c * 8) = c2; *(u32x4*)(FC + 3 * HY_FCN + c * 8) = c3;
    }
  }
}
__device__ __forceinline__ void hy_conv(f32x16 (&acc)[2], const bf16_t* FC, const bf16_t* SRC, int nb, int q, int r32, int hi) {
  acc[0] = f32x16{}; acc[1] = f32x16{};
  const int OFFL = nb * 64 + 64, s = r32 & 3, al = r32 >> 2, bb = r32 & 3;
  const int mlo = 8 * q - (nb - 1), mhi = (8 * q + 7 < nb - 1) ? 8 * q + 7 : nb - 1;
  const bf16_t* fbase = FC + (size_t)s * HY_FCN + (8 * hi - r32 + OFFL + s);
  const bf16_t* vbase = SRC + (size_t)bb * HY_VEN + (8 * q + al + 7) * HY_BS + 8 * hi;
  typedef const volatile __attribute__((address_space(3))) s16x4* lds_v64;
  bf16x8 Wc[6], Bc[4], Wn[6], Bn[4];
#define HY_LOADM(W_, B_, mm) do { _Pragma("unroll") for (int x_ = 0; x_ < 6; ++x_) { const bf16_t* fp_ = fbase - 16 * (4 * (mm) + x_ - 3); const s16x4 lo_ = *(lds_v64)fp_, hh_ = *(lds_v64)(fp_ + 4); \
      W_[x_] = (bf16x8){lo_[0], lo_[1], lo_[2], lo_[3], hh_[0], hh_[1], hh_[2], hh_[3]}; } \
    _Pragma("unroll") for (int ks_ = 0; ks_ < 4; ++ks_) B_[ks_] = *(const bf16x8*)(vbase - (mm) * HY_BS + ks_ * 16); } while (0)
#define HY_MMA(W_, B_) do { _Pragma("unroll") for (int ks_ = 0; ks_ < 4; ++ks_) _Pragma("unroll") for (int it_ = 0; it_ < 2; ++it_) acc[it_] = __builtin_amdgcn_mfma_f32_32x32x16_bf16(W_[2 * it_ - ks_ + 3], B_[ks_], acc[it_], 0, 0, 0); \
    _Pragma("unroll") for (int i_ = 0; i_ < 8; ++i_) { __builtin_amdgcn_sched_group_barrier(0x008, 1, 0); __builtin_amdgcn_sched_group_barrier(0x100, 2, 0); } } while (0)
  HY_LOADM(Wc, Bc, mlo);
  int m = mlo;
  for (; m + 1 <= mhi; m += 2) {
    HY_LOADM(Wn, Bn, m + 1); HY_MMA(Wc, Bc);
    const int m2 = m + 2 <= mhi ? m + 2 : mhi;
    HY_LOADM(Wc, Bc, m2); HY_MMA(Wn, Bn);
  }
  if (m <= mhi) {
#pragma unroll
    for (int ks = 0; ks < 4; ++ks)
#pragma unroll
      for (int it = 0; it < 2; ++it) acc[it] = __builtin_amdgcn_mfma_f32_32x32x16_bf16(Wc[2 * it - ks + 3], Bc[ks], acc[it], 0, 0, 0);
  }
#undef HY_MMA
#undef HY_LOADM
}
__device__ __forceinline__ void hy_item(int it, int& s, int& d, int& L, int& nb, int& seq0) { s = it < 1024 ? 0 : 1; d = it & 1023; L = s ? 256 : 4096; nb = L >> 6; seq0 = s ? 0 : CTXL; }
__device__ __forceinline__ const bf16_t* hy_gptr(const Params& p, int s, int d, int L, int o) { return (s ? WSP(bf16_t, OFF_GCTX) : WSP(bf16_t, OFF_GLAT)) + (size_t)(o * 1024 + d) * (2 * L + 144); }
__device__ __forceinline__ void job_hyena(const Params& p, int ib, char* lds) {
  bf16_t* FC = (bf16_t*)lds; bf16_t* VE = FC + 4 * HY_FCN; bf16_t* ZE = VE + 4 * HY_VEN;
  bf16_t* YT = WSP(bf16_t, OFF_RB);
  const int tid = otid(), lane = tid & 63, q = tid >> 6, r32 = lane & 31, hi = lane >> 5;
  SeqPre pa, pb; FilPre pf;
  int s, d, L, nb, seq0;
  if ((int)blockIdx.x < 2048) { hy_item(blockIdx.x, s, d, L, nb, seq0); hy_seq_load(p, pa, 2048 + d, L, nb, seq0); hy_seq_load(p, pb, d, L, nb, seq0); hy_fil_load(pf, hy_gptr(p, s, d, L, 0), L); }
  for (int it = blockIdx.x; it < 2048; it += gridDim.x) {
    hy_item(it, s, d, L, nb, seq0);
    hy_seq_store(p, pa, VE, 2048 + d, L, nb);
    hy_seq_store(p, pb, ZE, d, L, nb);
    hy_fil_store(pf, FC, L);
    __syncthreads();
    hy_seq_load(p, pa, 1024 + d, L, nb, seq0);
    hy_fil_load(pf, hy_gptr(p, s, d, L, 1), L);
    const bool active = 8 * q < nb;
    f32x16 acc[2];
    if (active) {
      hy_conv(acc, FC, VE, nb, q, r32, hi);
      const int a = 8 * q + (r32 >> 2), bb = r32 & 3;
      if (a < nb) {
#pragma unroll
        for (int i2 = 0; i2 < 2; ++i2)
#pragma unroll
          for (int r = 0; r < 16; ++r) { bf16_t* zp = ZE + (size_t)bb * HY_VEN + (a + 7) * HY_BS + i2 * 32 + crow(r, hi); *zp = f2bf(bf2f(*zp) * acc[i2][r]); }
      }
    }
    __syncthreads();
    hy_seq_store(p, pa, VE, 1024 + d, L, nb);
    hy_fil_store(pf, FC, L);
    __syncthreads();
    { const int nit = it + gridDim.x;
      if (nit < 2048) { int s2, d2, L2, nb2, sq2; hy_item(nit, s2, d2, L2, nb2, sq2); hy_seq_load(p, pa, 2048 + d2, L2, nb2, sq2); hy_seq_load(p, pb, d2, L2, nb2, sq2); hy_fil_load(pf, hy_gptr(p, s2, d2, L2, 0), L2); } }
    if (active) {
      hy_conv(acc, FC, ZE, nb, q, r32, hi);
      const int a = 8 * q + (r32 >> 2), bb = r32 & 3;
      if (a < nb) {
#pragma unroll
        for (int i2 = 0; i2 < 2; ++i2)
#pragma unroll
          for (int r = 0; r < 16; ++r) { bf16_t* vp = VE + (size_t)bb * HY_VEN + (a + 7) * HY_BS + i2 * 32 + crow(r, hi); *vp = f2bf(bf2f(*vp) * acc[i2][r]); }
      }
    }
    __syncthreads();
    for (int e = tid; e < 4 * (L / 8); e += NTHR) {
      const int b = e / (L / 8), t0 = (e - b * (L / 8)) * 8;
      *(u32x4*)(YT + (size_t)d * T + b * RB + seq0 + t0) = *(const u32x4*)(VE + (size_t)b * HY_VEN + (7 + (t0 >> 6)) * HY_BS + (t0 & 63));
    }
    __syncthreads();
  }
}
__device__ __forceinline__ void job_transpose_y(const Params& p, char* lds) {
  bf16_t* tile = (bf16_t*)lds;
  const bf16_t* YT = WSP(bf16_t, OFF_RB); bf16_t* Ytr = WSP(bf16_t, OFF_RC);
  const int tid = otid();
  for (int it = blockIdx.x; it < 16 * 68; it += gridDim.x) {
    const int dt = it / 68, tt = it - dt * 68, d0 = dt * 64, t0 = tt * 256;
    u32x4 v[4];
#pragma unroll
    for (int i = 0; i < 4; ++i) { const int e = tid + NTHR * i, dr = e >> 5, c = e & 31; v[i] = *(const u32x4*)(YT + (size_t)(d0 + dr) * T + t0 + c * 8); }
#pragma unroll
    for (int i = 0; i < 4; ++i) { const int e = tid + NTHR * i, dr = e >> 5, c = e & 31; *(u32x4*)(tile + dr * 264 + c * 8) = v[i]; }
    __syncthreads();
#pragma unroll
    for (int i = 0; i < 4; ++i) {
      const int e = tid + NTHR * i, tr = e >> 3, c = e & 7;
      unsigned short q[8];
#pragma unroll
      for (int k = 0; k < 8; ++k) q[k] = tile[(c * 8 + k) * 264 + tr];
      u32x4 w = {(unsigned)q[0] | ((unsigned)q[1] << 16), (unsigned)q[2] | ((unsigned)q[3] << 16), (unsigned)q[4] | ((unsigned)q[5] << 16), (unsigned)q[6] | ((unsigned)q[7] << 16)};
      *(u32x4*)(Ytr + (size_t)(t0 + tr) * 1024 + d0 + c * 8) = w;
    }
    __syncthreads();
  }
}
__device__ __forceinline__ void job_topk(const Params& p, bool skip_ctx) {
  const float* TL = WSP(float, OFF_RA);
  const float NEG = -3.0e38f;
  for (int item = blockIdx.x * NTHR + otid(); item < T * 8; item += gridDim.x * NTHR) {
    const int t = item >> 3, h = item & 7;
    if (skip_ctx && row_info(t).is_ctx) continue;
    float L1[16], L2[16], L3[16];
    { const float4* s = (const float4*)(TL + (size_t)item * 32);
#pragma unroll
      for (int q = 0; q < 4; ++q) { const float4 a = s[q], b = s[4 + q]; L1[4 * q] = a.x; L1[4 * q + 1] = a.y; L1[4 * q + 2] = a.z; L1[4 * q + 3] = a.w; L2[4 * q] = b.x; L2[4 * q + 1] = b.y; L2[4 * q + 2] = b.z; L2[4 * q + 3] = b.w; } }
    {
      float c[4][16];
      int n = 0;
#pragma unroll
      for (int i = 0; i < 16; ++i)
#pragma unroll
        for (int j = 0; j < 16; ++j)
          if ((i + 1) * (j + 1) <= 16) {
            const float sum = __uint_as_float(__float_as_uint(L1[i]) & ~127u) + __uint_as_float(__float_as_uint(L2[j]) & ~127u);
            c[n >> 4][n & 15] = __uint_as_float((__float_as_uint(sum) & ~255u) | (unsigned)(i * 16 + j));
            ++n;
          }
#pragma unroll
      for (int q = 50; q < 64; ++q) c[q >> 4][q & 15] = NEG;
      bsort16(c[0]); bsort16(c[1]); bsort16(c[2]); bsort16(c[3]);
#pragma unroll
      for (int q = 0; q < 16; ++q) L3[q] = c[0][q];
      merge_top16(L3, c[1]); merge_top16(L3, c[2]); merge_top16(L3, c[3]);
    }
    float ev[16]; float den = 0.f;
    const float mx = __uint_as_float(__float_as_uint(L3[0]) & ~255u);
#pragma unroll
    for (int k = 0; k < 16; ++k) { ev[k] = __expf(__uint_as_float(__float_as_uint(L3[k]) & ~255u) - mx); den += ev[k]; }
    const float rden = 1.f / den;
    int* ip = WSP(int, OFF_RC) + ((size_t)t * 8 + h) * 16; float* gp = WSP(float, OFF_RC + (size_t)T * 128 * 4) + ((size_t)t * 8 + h) * 16;
#pragma unroll
    for (int k = 0; k < 16; ++k) {
      const unsigned code = __float_as_uint(L3[k]) & 255u; const int ii = code >> 4, jj = code & 15;
      unsigned b1 = 0, b2 = 0;
#pragma unroll
      for (int i = 0; i < 16; ++i) { b1 = (ii == i) ? __float_as_uint(L1[i]) : b1; b2 = (jj == i) ? __float_as_uint(L2[i]) : b2; }
      ip[k] = (int)((b1 & 127u) * 128u + (b2 & 127u));
      gp[k] = ev[k] * rden;
    }
  }
}
__device__ __forceinline__ float gelu_as(float v) {
  const float t = __builtin_amdgcn_rcpf(fabsf(v) * 0.2316418882f + 1.0f);
  float q = t * 0.5307027145f + (-0.7265760135f); q = q * t + 0.7107068705f; q = q * t + (-0.142248368f); q = q * t + 0.127414796f; q = q * t;
  const float m = v * (q * __builtin_amdgcn_exp2f(v * v * (-0.72134752044f)));
  return v < 0.f ? m : v - m;
}
__device__ __forceinline__ void job_peer_gather(const Params& p, int layer) {
  const int lane = otid() & 63, wg = blockIdx.x * 8 + (otid() >> 6), nw = gridDim.x * 8;
  const unsigned char* U = WSP(unsigned char, OFF_PU) + (size_t)layer * 16384 * 2048;
  const float* SU = WSP(float, OFF_SU) + layer * 16384; const float* SV = WSP(float, OFF_SV) + layer * 16384;
  const float* lnw = p.in[6] + (size_t)(layer * 2 + 1) * 1024; const float* lnb = p.in[7] + (size_t)(layer * 2 + 1) * 1024;
  const float* lnw0 = p.in[6] + (size_t)(layer * 2) * 1024; const float* lnb0 = p.in[7] + (size_t)(layer * 2) * 1024;
  const bool last = layer == DEPTH - 1;
  const int NV = last ? NBATCH * SEQ : T;
#define VROW(v) (last ? (((v) >> 12) * RB + CTXL + ((v) & 4095)) : (v))
  const int nfull = NV / nw, nrem = NV - nfull * nw, xper = nrem / (int)gridDim.x, wv = otid() >> 6;
  const int nmine = nfull + ((nrem % (int)gridDim.x) == 0 && wv < xper ? 1 : 0) + ((nrem % (int)gridDim.x) != 0 && wg < nrem ? 1 : 0);
#define VIDX(k) ((k) < nfull ? wg + (k) * nw : (((nrem % (int)gridDim.x) == 0) ? nfull * nw + (int)blockIdx.x * xper + wv : nfull * nw + wg))
  int nidx0 = 0, nidx1 = 0; float ng0 = 0.f, ng1 = 0.f, nsu0 = 0.f, nsu1 = 0.f, nsv0 = 0.f, nsv1 = 0.f; u32x4 nha = {0u, 0u, 0u, 0u}, nhb = {0u, 0u, 0u, 0u};
  int nh8[4] = {0, 0, 0, 0}; float nsh = 0.f;
#define GQUANT() do { float hv_[16]; _Pragma("unroll") for (int i_ = 0; i_ < 4; ++i_) { hv_[2 * i_] = bflo(nha[i_]); hv_[2 * i_ + 1] = bfhi(nha[i_]); hv_[8 + 2 * i_] = bflo(nhb[i_]); hv_[8 + 2 * i_ + 1] = bfhi(nhb[i_]); } \
    float am_ = 0.f; _Pragma("unroll") for (int i_ = 0; i_ < 16; ++i_) am_ = fmaxf(am_, fabsf(hv_[i_])); \
    am_ = wmax(am_); \
    const float qs_ = am_ > 0.f ? 127.f / am_ : 0.f; nsh = am_ * (1.f / 127.f); \
    _Pragma("unroll") for (int i_ = 0; i_ < 4; ++i_) { const int q0_ = (int)__builtin_rintf(hv_[4 * i_] * qs_), q1_ = (int)__builtin_rintf(hv_[4 * i_ + 1] * qs_), q2_ = (int)__builtin_rintf(hv_[4 * i_ + 2] * qs_), q3_ = (int)__builtin_rintf(hv_[4 * i_ + 3] * qs_); \
      nh8[i_] = (int)(((unsigned)q0_ & 255u) | (((unsigned)q1_ & 255u) << 8) | (((unsigned)q2_ & 255u) << 16) | ((unsigned)q3_ << 24)); } } while (0)
  if (nmine > 0) {
    const int wg_ = VROW(VIDX(0));
    nidx0 = WSP(int, OFF_RC)[(size_t)wg_ * 128 + lane]; nidx1 = WSP(int, OFF_RC)[(size_t)wg_ * 128 + 64 + lane];
    ng0 = WSP(float, OFF_RC + (size_t)T * 128 * 4)[(size_t)wg_ * 128 + lane]; ng1 = WSP(float, OFF_RC + (size_t)T * 128 * 4)[(size_t)wg_ * 128 + 64 + lane];
    nha = *(const u32x4*)(WSP(bf16_t, OFF_H) + (size_t)wg_ * 1024 + lane * 16); nhb = *(const u32x4*)(WSP(bf16_t, OFF_H) + (size_t)wg_ * 1024 + lane * 16 + 8);
    nsu0 = SU[nidx0]; nsu1 = SU[nidx1]; nsv0 = SV[nidx0]; nsv1 = SV[nidx1];
    GQUANT();
  }
  for (int kk = 0; kk < nmine; ++kk) {
    const int vr = VIDX(kk), row = VROW(vr);
    const RowInfo ri = row_info(row);
    const int h8[4] = {nh8[0], nh8[1], nh8[2], nh8[3]}; const float shq = nsh;
    float out[16];
    const int myidx0 = nidx0, myidx1 = nidx1;
    const float mysu0 = nsu0 * shq, mysu1 = nsu1 * shq, mygv0 = ng0, mygv1 = ng1, mysv0 = nsv0, mysv1 = nsv1;
    bf16_t* Xr = WSP(bf16_t, OFF_X) + (size_t)row * 1024;
    float4 xr[4];
    { const u32x4 xa = *(const u32x4*)(Xr + lane * 16), xb = *(const u32x4*)(Xr + lane * 16 + 8);
      xr[0] = make_float4(bflo(xa[0]), bfhi(xa[0]), bflo(xa[1]), bfhi(xa[1])); xr[1] = make_float4(bflo(xa[2]), bfhi(xa[2]), bflo(xa[3]), bfhi(xa[3]));
      xr[2] = make_float4(bflo(xb[0]), bfhi(xb[0]), bflo(xb[1]), bfhi(xb[1])); xr[3] = make_float4(bflo(xb[2]), bfhi(xb[2]), bflo(xb[3]), bfhi(xb[3])); }
    const bool hasn = kk + 1 < nmine; const int nvr = hasn ? VIDX(kk + 1) : 0, nrow = VROW(nvr);
    if (hasn) {
      nidx0 = WSP(int, OFF_RC)[(size_t)nrow * 128 + lane]; nidx1 = WSP(int, OFF_RC)[(size_t)nrow * 128 + 64 + lane];
      ng0 = WSP(float, OFF_RC + (size_t)T * 128 * 4)[(size_t)nrow * 128 + lane]; ng1 = WSP(float, OFF_RC + (size_t)T * 128 * 4)[(size_t)nrow * 128 + 64 + lane];
      nha = *(const u32x4*)(WSP(bf16_t, OFF_H) + (size_t)nrow * 1024 + lane * 16); nhb = *(const u32x4*)(WSP(bf16_t, OFF_H) + (size_t)nrow * 1024 + lane * 16 + 8);
    }
#pragma unroll 1
    for (int rep_ = 0; rep_ < R_GATHER; ++rep_) {
    h16x2 outh[8];
#pragma unroll
    for (int i = 0; i < 8; ++i) outh[i] = (h16x2){(_Float16)0.f, (_Float16)0.f};
#pragma unroll 1
    for (int e0 = 0; e0 < 128; e0 += 8) {
      u32x4 uq[8], vq[8];
#pragma unroll
      for (int qq = 0; qq < 8; ++qq) {
        const int e = e0 + qq;
        const int id = __builtin_amdgcn_readlane(e0 < 64 ? myidx0 : myidx1, e & 63);
        const unsigned char* rp = U + (size_t)id * 2048 + lane * 16; uq[qq] = *(const u32x4*)rp; vq[qq] = *(const u32x4*)(rp + 1024);
      }
      int d[8];
#pragma unroll
      for (int qq = 0; qq < 8; ++qq) {
        int a = 0;
#pragma unroll
        for (int i = 0; i < 4; ++i) a = __builtin_amdgcn_sdot4((int)uq[qq][i], h8[i], a, false);
        d[qq] = a;
      }
      { const bool up = lane & 1;
#pragma unroll
        for (int j = 0; j < 4; ++j) { const int snd = up ? d[j] : d[j + 4], kp = up ? d[j + 4] : d[j]; d[j] = kp + xl1(snd); } }
      { const bool up = lane & 2;
#pragma unroll
        for (int j = 0; j < 2; ++j) { const int snd = up ? d[j] : d[j + 2], kp = up ? d[j + 2] : d[j]; d[j] = kp + xl2(snd); } }
      { const bool up = lane & 4; const int snd = up ? d[0] : d[1], kp = up ? d[1] : d[0]; d[0] = kp + xl4(snd); }
      int toti = d[0];
      toti += xl8(toti); toti = sum_x16(toti); toti = sum_x32(toti);
      const int ex = ((lane & 1) << 2) | (lane & 2) | ((lane >> 2) & 1);
      const float su_l = __shfl(e0 < 64 ? mysu0 : mysu1, (e0 + ex) & 63), gv_l = __shfl(e0 < 64 ? mygv0 : mygv1, (e0 + ex) & 63);
      const float cf_l = gv_l * gelu_as((float)toti * su_l);
#pragma unroll
      for (int qq = 0; qq < 8; ++qq) {
        const float cf = __uint_as_float(__builtin_amdgcn_readlane(__float_as_uint(cf_l), ((qq >> 2) & 1) | (((qq >> 1) & 1) << 1) | ((qq & 1) << 2)));
        const float svq = __uint_as_float(__builtin_amdgcn_readlane(__float_as_uint(e0 < 64 ? mysv0 : mysv1), (e0 + qq) & 63));
        const h16x2 cfh = {(_Float16)cf, (_Float16)cf};
#pragma unroll
        for (int i = 0; i < 4; ++i) { const h16x2 lo = __builtin_amdgcn_cvt_scalef32_pk_f16_fp8((int)vq[qq][i], svq, false), hi = __builtin_amdgcn_cvt_scalef32_pk_f16_fp8((int)vq[qq][i], svq, true);
          outh[2 * i] = __builtin_elementwise_fma(cfh, lo, outh[2 * i]); outh[2 * i + 1] = __builtin_elementwise_fma(cfh, hi, outh[2 * i + 1]); }
      }
    }
#pragma unroll
    for (int i = 0; i < 4; ++i) { out[4 * i] = (float)outh[2 * i][0]; out[4 * i + 1] = (float)outh[2 * i][1]; out[4 * i + 2] = (float)outh[2 * i + 1][0]; out[4 * i + 3] = (float)outh[2 * i + 1][1]; }
    }
    if (hasn) { nsu0 = SU[nidx0]; nsu1 = SU[nidx1]; nsv0 = SV[nidx0]; nsv1 = SV[nidx1]; GQUANT(); }
    const float* md = WSP(float, OFF_MOD) + ((size_t)layer * 5 + ri.mrow) * 6144;
    float r[16];
    { const int c0 = lane * 16;
      const float2 st1 = *(const float2*)(WSP(float, OFF_LST) + (size_t)row * 2);
#pragma unroll
      for (int i = 0; i < 4; ++i) { const float4 g4 = *(const float4*)(md + 5120 + c0 + 4 * i), w4 = *(const float4*)(lnw0 + c0 + 4 * i), b4 = *(const float4*)(lnb0 + c0 + 4 * i);
        r[4 * i] = ALPHA * ((xr[i].x - st1.x) * st1.y * w4.x + b4.x) + g4.x * out[4 * i]; r[4 * i + 1] = ALPHA * ((xr[i].y - st1.x) * st1.y * w4.y + b4.y) + g4.y * out[4 * i + 1];
        r[4 * i + 2] = ALPHA * ((xr[i].z - st1.x) * st1.y * w4.z + b4.z) + g4.z * out[4 * i + 2]; r[4 * i + 3] = ALPHA * ((xr[i].w - st1.x) * st1.y * w4.w + b4.w) + g4.w * out[4 * i + 3]; } }
    const float* mdn = WSP(float, OFF_MOD) + ((size_t)(last ? layer : layer + 1) * 5 + ri.mrow) * 6144;
    float* orow = (last && !ri.is_ctx) ? p.out + ((size_t)(ri.b * SEQ + ri.pos)) * 1024 : nullptr;
    ln_row_finish(r, lane * 16, lane * 16 + 8, lnw, lnb, Xr, last ? nullptr : WSP(bf16_t, OFF_H) + (size_t)row * 1024, mdn, mdn + 1024, orow);
  }
#undef GQUANT
#undef VROW
#undef VIDX
}

#define XB_TMO      128
#define XB_XCNT(j)  (256  + 64 * (j))
#define XB_XSUB(j)  (1280 + 64 * (j))
#define XB_XGEN(j)  (2304 + 64 * (j))
#define XB_TOP      3328
#define XB_TOPGEN   3392
#define XCD_BAR_WORDS 3456
#define XB_SPIN_CAP (1u << 22)
__device__ __forceinline__ unsigned xb_ld(unsigned* p)              { return __hip_atomic_load(p, __ATOMIC_RELAXED, __HIP_MEMORY_SCOPE_AGENT); }
__device__ __forceinline__ unsigned xb_add(unsigned* p, unsigned v) { return __hip_atomic_fetch_add(p, v, __ATOMIC_RELAXED, __HIP_MEMORY_SCOPE_AGENT); }
__device__ __forceinline__ unsigned xb_xcc_id() { return (unsigned)__builtin_amdgcn_s_getreg((3 << 11) | 20) & 0xFu; }
#define XB_SPIN(cond, bar) do { unsigned _sp = 0; while (cond) { __builtin_amdgcn_s_sleep(1); \
    if ((++_sp & 255u) == 0u) { if (xb_ld(&(bar)[XB_TMO])) break; if (_sp > XB_SPIN_CAP) { atomicAdd(&(bar)[XB_TMO], 1u); break; } } } } while (0)
struct XcdBarrier { unsigned* bar; unsigned x; volatile LAS unsigned* st; };
__device__ __forceinline__ XcdBarrier xcd_barrier_post(unsigned* bar, volatile LAS unsigned* st) {
  XcdBarrier b; b.bar = bar; b.x = xb_xcc_id(); b.st = st;
  if (threadIdx.x == 0) (void)xb_add(&bar[XB_XCNT(b.x)], 1u);
  return b;
}
__device__ __forceinline__ void xcd_barrier_complete(unsigned* bar, unsigned x, unsigned& nloc, unsigned& nx) {
  const unsigned G = gridDim.x * gridDim.y * gridDim.z;
  unsigned sum, cnt, mine, sp = 0u;
  for (;;) {
    sum = 0u; cnt = 0u; mine = 0u;
#pragma unroll
    for (unsigned j = 0; j < 16; ++j) { const unsigned c = xb_ld(&bar[XB_XCNT(j)]); sum += c; cnt += (c > 0u) ? 1u : 0u; mine = (j == x) ? c : mine; }
    if (sum == G) break;
    __builtin_amdgcn_s_sleep(1);
    if ((++sp & 255u) == 0u) { if (xb_ld(&bar[XB_TMO])) break; if (sp > XB_SPIN_CAP) { atomicAdd(&bar[XB_TMO], 1u); break; } }
  }
  nloc = mine > 0u ? mine : 1u; nx = cnt > 0u ? cnt : 1u;
}
__device__ __forceinline__ void xcd_barrier(const XcdBarrier& b) {
  asm volatile("s_waitcnt vmcnt(0)" ::: "memory");
  __syncthreads();
  if (threadIdx.x == 0) {
    unsigned* bar = b.bar;
    __builtin_amdgcn_s_waitcnt(0);
    unsigned nloc = b.st[0], nx = b.st[1];
    if (nloc == 0u) { xcd_barrier_complete(bar, b.x, nloc, nx); b.st[0] = nloc; b.st[1] = nx; }
    const unsigned old = xb_add(&bar[XB_XSUB(b.x)], 1u);
    const unsigned gen = old / nloc;
    if (old + 1u == (gen + 1u) * nloc) {
      __builtin_amdgcn_fence(__ATOMIC_RELEASE, "agent");
      asm volatile("s_waitcnt vmcnt(0)" ::: "memory");
      const unsigned og = xb_add(&bar[XB_TOP], 1u);
      const unsigned tg = og / nx;
      if (og + 1u == (tg + 1u) * nx) xb_add(&bar[XB_TOPGEN], 1u);
      else XB_SPIN(xb_ld(&bar[XB_TOPGEN]) == tg, bar);
      __builtin_amdgcn_fence(__ATOMIC_ACQUIRE, "agent");
      xb_add(&bar[XB_XGEN(b.x)], 1u);
      asm volatile("s_waitcnt vmcnt(0)" ::: "memory");
    } else {
      XB_SPIN(xb_ld(&bar[XB_XGEN(b.x)]) == gen, bar);
      __builtin_amdgcn_fence(__ATOMIC_ACQUIRE, "agent");
      asm volatile("s_waitcnt vmcnt(0)" ::: "memory");
    }
  }
  __syncthreads();
}

constexpr int PARAM_LDS = 512;
constexpr int LDS_BYTES = PARAM_LDS + HY_LDS;
static_assert(HY_LDS >= ATT_LDS && HY_LDS >= 2 * G_ASZ + 2 * G_BSZ, "LDS budget");
static_assert(sizeof(Params) <= PARAM_LDS && sizeof(Params) == 41 * 8, "Params layout");
__device__ __forceinline__ Params load_params(const char* lds) {
  int off = 0; asm volatile("" : "+v"(off));
  const unsigned* lp = (const unsigned*)(lds + off);
  Params p;
#pragma unroll
  for (int k = 0; k < 38; ++k) {
    const unsigned lo = __builtin_amdgcn_readfirstlane(lp[2 * k]), hi = __builtin_amdgcn_readfirstlane(lp[2 * k + 1]);
    p.in[k] = (const float*)(const float GAS*)(((unsigned long long)hi << 32) | lo);
  }
  { const unsigned lo = __builtin_amdgcn_readfirstlane(lp[76]), hi = __builtin_amdgcn_readfirstlane(lp[77]); p.out = (float*)(float GAS*)(((unsigned long long)hi << 32) | lo); }
  { const unsigned lo = __builtin_amdgcn_readfirstlane(lp[78]), hi = __builtin_amdgcn_readfirstlane(lp[79]); p.ws = (char*)(char GAS*)(((unsigned long long)hi << 32) | lo); }
  p.ph_begin = 0; p.ph_end = 0;
  return p;
}
__global__ void __launch_bounds__(NTHR) mega(const Params kp) {
  extern __shared__ __attribute__((aligned(16))) char lds_all[];
  cg::grid_group grid = cg::this_grid();
  if (threadIdx.x == 0) {
    unsigned long long* lp = (unsigned long long*)lds_all;
#pragma unroll
    for (int k = 0; k < 38; ++k) lp[k] = (unsigned long long)kp.in[k];
    lp[38] = (unsigned long long)kp.out; lp[39] = (unsigned long long)kp.ws;
  }
  if (threadIdx.x == 0) { volatile LAS unsigned* st0 = (volatile LAS unsigned*)(lds_all + 384); st0[0] = 0u; st0[1] = 0u; st0[2] = 0u; st0[3] = 0u; }
  __syncthreads();
  char* lds = lds_all + PARAM_LDS;
  const int ph_begin = kp.ph_begin, ph_end = kp.ph_end;
  (void)xcd_barrier_post((unsigned*)(kp.ws + OFF_BAR), (volatile LAS unsigned*)(lds_all + 384));
  int ph = 0;
#define PHASER(reps, ...) do { if (ph >= ph_begin && ph < ph_end) { const Params p = load_params(lds_all); for (int rep_ = 0; rep_ < (reps) + (ph == PROBE_PH ? 1 : 0); ++rep_) { __VA_ARGS__; } \
    if (ph + 1 < ph_end) { for (int rs_ = 0; rs_ < R_SYNC; ++rs_) { if (ph == 0) grid.sync(); else xcd_barrier(XcdBarrier{(unsigned*)(p.ws + OFF_BAR), xb_xcc_id(), (volatile LAS unsigned*)(lds_all + 384)}); } } } ++ph; } while (0)
#define PHASE(...) PHASER(1, __VA_ARGS__)
  PHASER(R_PRO, job_wconv(p, lds); job_adaln_partial(p, lds); job_hdn(p, lds); job_peer_conv(p));
  PHASER(R_PRO, job_mod_final(p); job_gbuild(p, lds));
  PHASER(R_PRO, job_init(p));
#pragma unroll 1
  for (int layer = 0; layer < DEPTH; ++layer) {
    const int kind = layer % 3;
    if (kind == 0) {
      const int ia = layer / 3;
      PHASER(R_GEMM, gemm8_job(WSP(bf16_t, OFF_H), 1024, WSP(bf16_t, OFF_W1 + (size_t)ia * SZ_W1), 1024, 1024, 1024, pg8::E8Bf16{WSP(bf16_t, OFF_RA), 1152, nullptr}, EpiBf16{WSP(bf16_t, OFF_RA), 1152}, lds, false, false);
            for (int s = (int)(gridDim.x - 1 - blockIdx.x); s < T / 64; s += gridDim.x)
              gemm_tile<EpiBf16, 2, 1, 1>(WSP(bf16_t, OFF_H), 1024, WSP(bf16_t, OFF_W1 + (size_t)ia * SZ_W1), 1024, 1024, s * 64, 1024, 0, EpiBf16{WSP(bf16_t, OFF_RA), 1152}, lds));
      PHASE(job_mla_norm(p, ia));
      PHASER(R_GEMM, gemm8_job(WSP(bf16_t, OFF_RE), 768, WSP(bf16_t, OFF_WUQ + (size_t)ia * SZ_WUQ), 768, 1536, 768, pg8::E8MlaQ{WSP(bf16_t, OFF_RB)}, EpiMlaQ{WSP(bf16_t, OFF_RB)}, lds, false, layer == DEPTH - 1);
            gemm8_job(WSP(bf16_t, OFF_RE) + (size_t)T * 768, 256, WSP(bf16_t, OFF_WUKV + (size_t)ia * SZ_WUKV), 256, 2048, 256, pg8::E8MlaKV{WSP(bf16_t, OFF_RC), WSP(bf16_t, OFF_RD)}, EpiMlaKV{WSP(bf16_t, OFF_RC), WSP(bf16_t, OFF_RD)}, lds, false, false, 16));
      PHASER(R_ATTN, job_attn_mla(p, lds, layer == DEPTH - 1, layer == 0 ? 0 : -1));
      PHASER(R_GEMM, gemm8_job(WSP(bf16_t, OFF_RF), 1024, WSP(bf16_t, OFF_WOA + (size_t)ia * SZ_WSQ), 1024, 1024, 1024, pg8::E8Resid{WSP(bf16_t, OFF_X), WSP(float, OFF_MOD) + (size_t)layer * 5 * 6144 + 2048, nullptr},
                                EpiResid{WSP(bf16_t, OFF_X), WSP(float, OFF_MOD) + (size_t)layer * 5 * 6144 + 2048, nullptr}, lds, false, layer == DEPTH - 1));
      PHASE(job_ln1(p, layer));
    } else if (kind == 1) {
      PHASER(R_GEMM, gemm8t_job(WSP(bf16_t, OFF_WIN), WSP(bf16_t, OFF_H), 3072, 1024, pg8::E8Bf16{WSP(bf16_t, OFF_RA), T, p.in[16]}, EpiZT{WSP(bf16_t, OFF_RA), T, p.in[16]}, lds));
      PHASER(R_HYENA, job_hyena(p, 0, lds));
      PHASE(job_transpose_y(p, lds));
      PHASER(R_GEMM, gemm8_job(WSP(bf16_t, OFF_RC), 1024, WSP(bf16_t, OFF_WOUT), 1024, 1024, 1024, pg8::E8Resid{WSP(bf16_t, OFF_X), WSP(float, OFF_MOD) + (size_t)layer * 5 * 6144 + 2048, p.in[28]},
                                EpiResid{WSP(bf16_t, OFF_X), WSP(float, OFF_MOD) + (size_t)layer * 5 * 6144 + 2048, p.in[28]}, lds, false, false));
      PHASE(job_ln1(p, layer));
    } else {
      PHASER(R_GEMM, gemm8_job(WSP(bf16_t, OFF_H), 1024, WSP(bf16_t, OFF_WQKV), 1024, 1536, 1024, pg8::E8Bf16{WSP(bf16_t, OFF_RA), 1536, nullptr}, EpiBf16{WSP(bf16_t, OFF_RA), 1536}, lds, true, false));
      PHASE(job_gqa_norm(p));
      PHASER(R_ATTN, job_attn_gqa(p, lds, 2));
      PHASER(R_GEMM, gemm8_job(WSP(bf16_t, OFF_RF), 1024, WSP(bf16_t, OFF_WOC), 1024, 1024, 1024, pg8::E8Resid{WSP(bf16_t, OFF_X), WSP(float, OFF_MOD) + (size_t)layer * 5 * 6144 + 2048, nullptr},
                                EpiResid{WSP(bf16_t, OFF_X), WSP(float, OFF_MOD) + (size_t)layer * 5 * 6144 + 2048, nullptr}, lds, false, layer == DEPTH - 1));
      PHASE(job_ln1(p, layer));
    }
    PHASER(R_GEMM, gemm8d_job(WSP(bf16_t, OFF_H), 1024, WSP(bf16_t, OFF_WQ + (size_t)layer * SZ_WQ), 1024, 2048, 1024, pg8::E8PeerTopk{WSP(bf16_t, OFF_KEYS) + (size_t)layer * 16 * 16384, WSP(float, OFF_RA)},
                               EpiPeerTopk{WSP(bf16_t, OFF_KEYS) + (size_t)layer * 16 * 16384, WSP(float, OFF_RA)}, lds, layer == DEPTH - 1));
    PHASER(R_TOPK, job_topk(p, layer == DEPTH - 1));
    PHASE(job_peer_gather(p, layer));
  }
#undef PHASE
#undef PHASER
}


#ifndef CUT_PHASE
#define CUT_PHASE NPHASES
#endif
#ifndef DUMP_OFF
#define DUMP_OFF OFF_RB
#endif
__global__ void __launch_bounds__(NTHR) dump_x(const Params p) {
  const size_t n4 = (size_t)NBATCH * SEQ * 256;
  for (size_t i = (size_t)blockIdx.x * NTHR + threadIdx.x; i < n4; i += (size_t)gridDim.x * NTHR)
    *(float4*)(p.out + i * 4) = *(const float4*)(WSP(float, DUMP_OFF) + i * 4);
}
extern "C" void kernel_launch(void* const* d_in, const int* in_sizes, int n_in, void* d_out, int out_size, void* d_ws, size_t ws_size, hipStream_t stream) {
  static int grid_blocks = 0;
  if (!grid_blocks) {
    int dev = 0, cus = 0, per_cu = 0;
    (void)hipGetDevice(&dev);
    (void)hipDeviceGetAttribute(&cus, hipDeviceAttributeMultiprocessorCount, dev);
    if (hipFuncSetAttribute((const void*)mega, hipFuncAttributeMaxDynamicSharedMemorySize, LDS_BYTES) != hipSuccess) fprintf(stderr, "kernel_launch: hipFuncSetAttribute failed\n");
    (void)hipOccupancyMaxActiveBlocksPerMultiprocessor(&per_cu, mega, NTHR, LDS_BYTES);
    if (per_cu < 1) { fprintf(stderr, "kernel_launch: occupancy query returned %d\n", per_cu); per_cu = 1; }
    if (per_cu > 1) per_cu = 1;
    grid_blocks = cus * per_cu;
  }
  if (n_in != 38 || WS_TOTAL > ws_size) { fprintf(stderr, "kernel_launch: bad call: n_in %d, workspace need %zu have %zu\n", n_in, (size_t)WS_TOTAL, ws_size); return; }
  Params p; memset(&p, 0, sizeof(p));
  for (int i = 0; i < 38; ++i) p.in[i] = (const float*)d_in[i];
  p.out = (float*)d_out; p.ws = (char*)d_ws;
  (void)hipMemsetAsync((char*)d_ws + OFF_BAR, 0, 16384, stream);
#if ONE_LAUNCH
  p.ph_begin = 0; p.ph_end = NPHASES;
  void* args[] = {(void*)&p};
  hipError_t e = hipLaunchCooperativeKernel((const void*)mega, dim3(grid_blocks), dim3(NTHR), args, LDS_BYTES, stream);
  if (e != hipSuccess) fprintf(stderr, "kernel_launch: cooperative launch failed: %s (grid %d)\n", hipGetErrorString(e), grid_blocks);
#else
  for (int ph = 0; ph < CUT_PHASE; ++ph) {
    p.ph_begin = ph; p.ph_end = ph + 1;
    hipLaunchKernelGGL(mega, dim3(grid_blocks), dim3(NTHR), LDS_BYTES, stream, p);
  }
  if (CUT_PHASE < NPHASES) hipLaunchKernelGGL(dump_x, dim3(1024), dim3(NTHR), 0, stream, p);
#endif
}
```
